# Optimizing an MI355X kernel written in HIP

```python
import jax
import jax.numpy as jnp
from jax import lax
import numpy as np

D_MODEL = 1024
BATCH = 8
SEQ = 4096
DEPTH = 1

MIX_WIDTH = D_MODEL
HG_WIDTH = MIX_WIDTH // 2
HG_HEAD_DIM = 128
HG_HEADS = HG_WIDTH // HG_HEAD_DIM
HG_EXPAND = 128
HG_FDIM = HG_HEADS * HG_EXPAND
HG_CHUNK = 64
ATT_WIDTH = MIX_WIDTH - HG_WIDTH
ATT_HEAD_DIM = 64
ATT_HEADS = ATT_WIDTH // ATT_HEAD_DIM
DILATED_PAIRS = ((128, 1), (512, 4), (2048, 16))
ATT_BLOCK = 128
D_FF = ((8 * D_MODEL + 3 * 256 - 1) // (3 * 256)) * 256
RMS_EPS = 1e-6
IN_SIZES = (HG_FDIM, HG_FDIM, HG_WIDTH, HG_WIDTH, ATT_WIDTH, ATT_WIDTH, ATT_WIDTH)
IN_WIDTH = HG_FDIM * 2 + HG_WIDTH * 2 + ATT_WIDTH * 3

kernel_name = 'hybrid_hgrn2_dilated_attn_adaln_block'


def rms_norm(x, g):
    xf = x.astype(jnp.float32)
    y = xf * lax.rsqrt(jnp.mean(xf * xf, axis=-1, keepdims=True) + RMS_EPS)
    return (y * g.astype(jnp.float32)).astype(x.dtype)


def modulate(h, shift, scale):
    return h * (1 + scale[:, None, :]) + shift[:, None, :]


def hgrn2_mixer(q, f_raw, i, g, lb, onorm_g):
    B, S = q.shape[0], q.shape[1]
    nc = S // HG_CHUNK
    lb = lb.reshape(HG_HEADS, HG_EXPAND)
    f = lb + (1.0 - lb) * jax.nn.sigmoid(f_raw.astype(jnp.float32))
    k = 1.0 - f
    log_f = jnp.log(f)
    qf = jax.nn.silu(q.astype(jnp.float32))
    vf = i.astype(jnp.float32)

    def chunks(t):
        return t.reshape(B, nc, HG_CHUNK, HG_HEADS, t.shape[-1]).transpose(1, 0, 3, 2, 4)

    qc, kc, vc = chunks(qf), chunks(k), chunks(vf)
    bc = jnp.cumsum(chunks(log_f), axis=3)
    causal = jnp.tril(jnp.ones((HG_CHUNK, HG_CHUNK), dtype=bool))

    def step(state, inp):
        q_c, k_c, v_c, b_c = inp
        o_inter = jnp.einsum('bhtk,bhkv->bhtv', q_c * jnp.exp(b_c), state)
        diff = b_c[:, :, :, None, :] - b_c[:, :, None, :, :]
        decay = jnp.where(causal[:, :, None], jnp.exp(jnp.minimum(diff, 0.0)), 0.0)
        scores = jnp.einsum('bhtk,bhsk,bhtsk->bhts', q_c, k_c, decay)
        o_intra = jnp.einsum('bhts,bhsv->bhtv', scores, v_c)
        b_last = b_c[:, :, -1, :]
        k_dec = k_c * jnp.exp(b_last[:, :, None, :] - b_c)
        state = jnp.exp(b_last)[..., None] * state + jnp.einsum('bhsk,bhsv->bhkv', k_dec, v_c)
        return state, o_inter + o_intra

    state0 = jnp.zeros((B, HG_HEADS, HG_EXPAND, HG_HEAD_DIM), jnp.float32)
    _, o = lax.scan(step, state0, (qc, kc, vc, bc))
    o = o.transpose(1, 0, 3, 2, 4).reshape(B, S, HG_HEADS, HG_HEAD_DIM)
    o = rms_norm(o, onorm_g) * jax.nn.silu(g.astype(jnp.float32))
    return o.reshape(B, S, HG_WIDTH).astype(q.dtype)


def dilated_branch(q, k, v, window, dil):
    B, H, S, E = q.shape
    span = window // dil
    seg = dil * ATT_BLOCK
    s_pad = -(-S // seg) * seg
    m = s_pad // dil
    nb = m // ATT_BLOCK

    def to_blocks(t):
        t = jnp.pad(t, ((0, 0), (0, 0), (0, s_pad - S), (0, 0)))
        t = t.reshape(B, H, m, dil, E).transpose(0, 1, 3, 2, 4)
        return t.reshape(B, H, dil, nb, ATT_BLOCK, E)

    def with_prev(t):
        prev = jnp.pad(t[:, :, :, :-1], ((0, 0), (0, 0), (0, 0), (1, 0), (0, 0), (0, 0)))
        return jnp.concatenate([prev, t], axis=4)

    qb = to_blocks(q)
    kb = with_prev(to_blocks(k))
    vb = with_prev(to_blocks(v))
    s = jnp.einsum('bhrnqe,bhrnke->bhrnqk', qb, kb).astype(jnp.float32)
    qi = jnp.arange(ATT_BLOCK)[:, None]
    kj = jnp.arange(2 * ATT_BLOCK)[None, :]
    dist = ATT_BLOCK + qi - kj
    band = (dist >= 0) & (dist <= span)
    real = (jnp.arange(nb) > 0)[:, None, None] | (kj >= ATT_BLOCK)[None]
    mask = band[None] & real
    s = jnp.where(mask, s, -jnp.inf)
    s_max = jnp.max(s, axis=-1, keepdims=True)
    p = jnp.exp(s - s_max)
    l = jnp.sum(p, axis=-1, keepdims=True)
    o = jnp.einsum('bhrnqk,bhrnke->bhrnqe', p, vb.astype(jnp.float32)) / l
    lse = (s_max + jnp.log(l))[..., 0]
    o = o.reshape(B, H, dil, m, E).transpose(0, 1, 3, 2, 4).reshape(B, H, s_pad, E)[:, :, :S]
    lse = lse.reshape(B, H, dil, m).transpose(0, 1, 3, 2).reshape(B, H, s_pad)[:, :, :S]
    return o, lse


def dilated_attention(q, k, v):
    B, S = q.shape[0], q.shape[1]
    qh = q.transpose(0, 2, 1, 3) * (ATT_HEAD_DIM ** -0.5)
    kh = k.transpose(0, 2, 1, 3)
    vh = v.transpose(0, 2, 1, 3)
    outs, lses = zip(*[dilated_branch(qh, kh, vh, w, d) for (w, d) in DILATED_PAIRS])
    weights = jax.nn.softmax(jnp.stack(lses), axis=0)
    o = jnp.sum(weights[..., None] * jnp.stack(outs), axis=0)
    return o.transpose(0, 2, 1, 3).reshape(B, S, ATT_WIDTH).astype(q.dtype)


def setup_inputs(seed: int = 0) -> dict:
    key = jax.random.key(seed)
    ks = jax.random.split(key, 14)

    def nrm(k, shape, scale):
        return jax.random.normal(k, shape, jnp.float32) * scale

    return {
        'x': nrm(ks[0], (BATCH, SEQ, D_MODEL), 1.0),
        'c': nrm(ks[1], (BATCH, D_MODEL), 1.0),
        'w_ada': nrm(ks[2], (DEPTH, D_MODEL, 6 * D_MODEL), D_MODEL ** -0.5),
        'b_ada': nrm(ks[3], (DEPTH, 6 * D_MODEL), 0.01),
        'norm1_g': 1.0 + nrm(ks[4], (DEPTH, D_MODEL), 0.01),
        'w_in': nrm(ks[5], (DEPTH, D_MODEL, IN_WIDTH), D_MODEL ** -0.5),
        'hg_lb_logits': nrm(ks[6], (DEPTH + 1, HG_FDIM), 0.1),
        'hg_onorm_g': 1.0 + nrm(ks[7], (DEPTH, HG_HEAD_DIM), 0.01),
        'att_onorm_g': 1.0 + nrm(ks[8], (DEPTH, ATT_WIDTH), 0.01),
        'w_out': nrm(ks[9], (DEPTH, MIX_WIDTH, D_MODEL), MIX_WIDTH ** -0.5),
        'norm2_g': 1.0 + nrm(ks[10], (DEPTH, D_MODEL), 0.01),
        'w_gate_up': nrm(ks[11], (DEPTH, D_MODEL, 2 * D_FF), D_MODEL ** -0.5),
        'w_down': nrm(ks[12], (DEPTH, D_FF, D_MODEL), D_FF ** -0.5),
        'final_g': 1.0 + nrm(ks[13], (D_MODEL,), 0.01),
    }


def reference(x, c, w_ada, b_ada, norm1_g, w_in, hg_lb_logits, hg_onorm_g, att_onorm_g,
              w_out, norm2_g, w_gate_up, w_down, final_g):
    B, S = x.shape[0], x.shape[1]
    lower_bounds = jnp.cumsum(jax.nn.softmax(hg_lb_logits.astype(jnp.float32), axis=0), axis=0)
    c_act = jax.nn.silu(c)
    split_at = np.cumsum(IN_SIZES)[:-1].tolist()
    for l in range(DEPTH):
        mod = c_act @ w_ada[l] + b_ada[l]
        shift1, scale1, gate1, shift2, scale2, gate2 = jnp.split(mod, 6, axis=-1)
        h = modulate(rms_norm(x, norm1_g[l]), shift1, scale1)
        hq, hf, hi, hgt, aq, ak, av = jnp.split(h @ w_in[l], split_at, axis=-1)
        hg_out = hgrn2_mixer(
            hq.reshape(B, S, HG_HEADS, HG_EXPAND),
            hf.reshape(B, S, HG_HEADS, HG_EXPAND),
            hi.reshape(B, S, HG_HEADS, HG_HEAD_DIM),
            hgt.reshape(B, S, HG_HEADS, HG_HEAD_DIM),
            lower_bounds[l], hg_onorm_g[l])
        att = dilated_attention(
            aq.reshape(B, S, ATT_HEADS, ATT_HEAD_DIM),
            ak.reshape(B, S, ATT_HEADS, ATT_HEAD_DIM),
            av.reshape(B, S, ATT_HEADS, ATT_HEAD_DIM))
        att_out = rms_norm(att, att_onorm_g[l])
        mix = jnp.concatenate([hg_out, att_out], axis=-1) @ w_out[l]
        x = x + gate1[:, None, :] * mix
        h = modulate(rms_norm(x, norm2_g[l]), shift2, scale2)
        a, u = jnp.split(h @ w_gate_up[l], 2, axis=-1)
        x = x + gate2[:, None, :] * ((jax.nn.silu(a) * u) @ w_down[l])
    return rms_norm(x, final_g)
```

```cpp
#include <hip/hip_runtime.h>
#include <stdint.h>

namespace v0 {
constexpr int B = 8, S = 4096, D = 1024, T = B * S, INW = 3584, DFF = 2816, NMOD = 6144;
constexpr float EPS = 1e-6f;
typedef unsigned short bf16_t;
__device__ __forceinline__ bf16_t f2bf(float f) { unsigned u = __float_as_uint(f); return (bf16_t)((u + 0x7fffu + ((u >> 16) & 1u)) >> 16); }
__device__ __forceinline__ float bf2f(bf16_t h) { return __uint_as_float(((unsigned)h) << 16); }
__device__ __forceinline__ float siluf(float x) { return x / (1.f + expf(-x)); }
__device__ __forceinline__ float sigmf(float x) { return 1.f / (1.f + expf(-x)); }

__global__ void k_mod(const float* c, const float* w_ada, const float* b_ada, const float* lbl, float* mod, float* lb) {
    const int n = blockIdx.x * 256 + threadIdx.x, b = blockIdx.y;
    float acc = 0.f;
    for (int k = 0; k < D; ++k) acc += siluf(c[b * D + k]) * w_ada[(size_t)k * NMOD + n];
    mod[b * NMOD + n] = acc + b_ada[n];
    if (blockIdx.y == 0 && blockIdx.x < 2) {
        const int j = blockIdx.x * 256 + threadIdx.x;
        const float a = lbl[j], bb = lbl[512 + j], m = fmaxf(a, bb), ea = expf(a - m), eb = expf(bb - m);
        lb[j] = ea / (ea + eb);
    }
}

__global__ __launch_bounds__(256) void k_xn(const float* x, const float* g, const float* mod, int shift_off, int scale_off, float* out) {
    const int row = blockIdx.x * 4 + (threadIdx.x >> 6), lane = threadIdx.x & 63, b = row / S;
    const float* xr = x + (size_t)row * D;
    float v[16]; float ss = 0.f;
#pragma unroll
    for (int i = 0; i < 16; ++i) { v[i] = xr[lane + 64 * i]; ss += v[i] * v[i]; }
#pragma unroll
    for (int o = 32; o > 0; o >>= 1) ss += __shfl_xor(ss, o);
    const float rstd = rsqrtf(ss / D + EPS);
#pragma unroll
    for (int i = 0; i < 16; ++i) { const int k = lane + 64 * i; out[(size_t)row * D + k] = v[i] * rstd * g[k] * (1.f + mod[b * NMOD + scale_off + k]) + mod[b * NMOD + shift_off + k]; }
}

struct GOut { int kind; bf16_t* c16; float* c32; const float* res; const float* mod; int gate_off; int ldc; };
template <int ABF, int DUAL> __global__ __launch_bounds__(256) void k_gemm(const void* Ap, const float* W, int M, int N, int K, int ldw, GOut o) {
    __shared__ float As[16][132]; __shared__ float Ws[16][132];
    const int tid = threadIdx.x, tx = tid & 15, ty = tid >> 4;
    const int m0 = blockIdx.y * 128, n0 = blockIdx.x * (DUAL ? 64 : 128);
    float acc[8][8];
#pragma unroll
    for (int i = 0; i < 8; ++i)
#pragma unroll
        for (int j = 0; j < 8; ++j) acc[i][j] = 0.f;
    const int ar = tid >> 1, ak = (tid & 1) * 8, wk = tid >> 4, wc = (tid & 15) * 8;
    const int wcol = DUAL ? (wc < 64 ? n0 + wc : N + n0 + (wc - 64)) : n0 + wc;
    for (int k0 = 0; k0 < K; k0 += 16) {
        float a[8], w[8];
        if (ABF) { const bf16_t* A = (const bf16_t*)Ap;
#pragma unroll
            for (int i = 0; i < 8; ++i) a[i] = bf2f(A[(size_t)(m0 + ar) * K + k0 + ak + i]); }
        else { const float* A = (const float*)Ap;
#pragma unroll
            for (int i = 0; i < 8; ++i) a[i] = A[(size_t)(m0 + ar) * K + k0 + ak + i]; }
#pragma unroll
        for (int i = 0; i < 8; ++i) w[i] = W[(size_t)(k0 + wk) * ldw + wcol + i];
        __syncthreads();
#pragma unroll
        for (int i = 0; i < 8; ++i) As[ak + i][ar] = a[i];
#pragma unroll
        for (int i = 0; i < 8; ++i) Ws[wk][wc + i] = w[i];
        __syncthreads();
#pragma unroll
        for (int kk = 0; kk < 16; ++kk) {
            float av[8], bv[8];
#pragma unroll
            for (int i = 0; i < 4; ++i) { av[i] = As[kk][ty * 4 + i]; av[4 + i] = As[kk][64 + ty * 4 + i]; bv[i] = Ws[kk][tx * 4 + i]; bv[4 + i] = Ws[kk][64 + tx * 4 + i]; }
#pragma unroll
            for (int i = 0; i < 8; ++i)
#pragma unroll
                for (int j = 0; j < 8; ++j) acc[i][j] += av[i] * bv[j];
        }
    }
#pragma unroll
    for (int i = 0; i < 8; ++i) {
        const int m = m0 + (i < 4 ? ty * 4 + i : 64 + ty * 4 + (i - 4)); const int b = m / S;
        if (DUAL) {
#pragma unroll
            for (int j = 0; j < 4; ++j) { const int n = n0 + tx * 4 + j; o.c16[(size_t)m * o.ldc + n] = f2bf(siluf(acc[i][j]) * acc[i][4 + j]); }
        } else {
#pragma unroll
            for (int j = 0; j < 8; ++j) { const int n = n0 + (j < 4 ? tx * 4 + j : 64 + tx * 4 + (j - 4));
                if (o.kind == 0) o.c16[(size_t)m * o.ldc + n] = f2bf(acc[i][j]);
                else o.c32[(size_t)m * o.ldc + n] = o.res[(size_t)m * o.ldc + n] + o.mod[b * NMOD + o.gate_off + n] * acc[i][j]; }
        }
    }
}

__global__ __launch_bounds__(128) void k_hgrn(const bf16_t* Y, const float* lb, const float* onorm, float* mixin) {
    const int b = blockIdx.x >> 2, h = blockIdx.x & 3, tid = threadIdx.x;
    __shared__ float qs[128], fs[128], red[2];
    float Sreg[128];
#pragma unroll
    for (int k = 0; k < 128; ++k) Sreg[k] = 0.f;
    const float lbv = lb[h * 128 + tid], gon = onorm[tid];
    for (int t = 0; t < S; ++t) {
        const bf16_t* y = Y + (size_t)(b * S + t) * INW;
        const float qv = siluf(bf2f(y[h * 128 + tid])), fv = lbv + (1.f - lbv) * sigmf(bf2f(y[512 + h * 128 + tid]));
        const float vv = bf2f(y[1024 + h * 128 + tid]), gv = bf2f(y[1536 + h * 128 + tid]);
        __syncthreads();
        qs[tid] = qv; fs[tid] = fv;
        __syncthreads();
        float o = 0.f;
#pragma unroll
        for (int k = 0; k < 128; ++k) { const float f = fs[k]; Sreg[k] = f * Sreg[k] + (1.f - f) * vv; o += qs[k] * Sreg[k]; }
        float ss = o * o;
#pragma unroll
        for (int off = 32; off > 0; off >>= 1) ss += __shfl_xor(ss, off);
        if ((tid & 63) == 0) red[tid >> 6] = ss;
        __syncthreads();
        const float rstd = rsqrtf((red[0] + red[1]) * (1.f / 128.f) + EPS);
        mixin[(size_t)(b * S + t) * D + h * 128 + tid] = o * rstd * gon * siluf(gv);
    }
}

__global__ __launch_bounds__(256) void k_attn(const bf16_t* Y, float* att) {
    __shared__ float ps[4][392];
    const int w = threadIdx.x >> 6, lane = threadIdx.x & 63;
    const int gid = blockIdx.x * 4 + w; const int t = gid % S, h = (gid / S) % 8, b = gid / (S * 8);
    const bf16_t* base = Y + (size_t)b * S * INW;
    float q[64];
    { const bf16_t* qp = base + (size_t)t * INW + 2048 + h * 64;
#pragma unroll
      for (int e = 0; e < 64; ++e) q[e] = bf2f(qp[e]) * 0.125f; }
    float sc[7]; float m = -INFINITY;
#pragma unroll
    for (int r = 0; r < 7; ++r) {
        const int s = r * 64 + lane; float v = -INFINITY;
        if (s < 387) { const int i = s / 129, j = s % 129, d = (i == 0) ? 1 : (i == 1 ? 4 : 16); const int pos = t - j * d;
            if (pos >= 0) { const uint4* kp = (const uint4*)(base + (size_t)pos * INW + 2560 + h * 64); float a = 0.f;
#pragma unroll
                for (int c = 0; c < 8; ++c) { const uint4 u = kp[c];
                    a += q[c * 8 + 0] * __uint_as_float(u.x << 16) + q[c * 8 + 1] * __uint_as_float(u.x & 0xffff0000u);
                    a += q[c * 8 + 2] * __uint_as_float(u.y << 16) + q[c * 8 + 3] * __uint_as_float(u.y & 0xffff0000u);
                    a += q[c * 8 + 4] * __uint_as_float(u.z << 16) + q[c * 8 + 5] * __uint_as_float(u.z & 0xffff0000u);
                    a += q[c * 8 + 6] * __uint_as_float(u.w << 16) + q[c * 8 + 7] * __uint_as_float(u.w & 0xffff0000u); }
                v = a; } }
        sc[r] = v; m = fmaxf(m, v);
    }
#pragma unroll
    for (int off = 32; off > 0; off >>= 1) m = fmaxf(m, __shfl_xor(m, off));
    float l = 0.f;
#pragma unroll
    for (int r = 0; r < 7; ++r) { const int s = r * 64 + lane; const float p = (sc[r] == -INFINITY) ? 0.f : expf(sc[r] - m); l += p; if (s < 392) ps[w][s] = p; }
#pragma unroll
    for (int off = 32; off > 0; off >>= 1) l += __shfl_xor(l, off);
    __syncthreads();
    float o = 0.f;
    for (int s = 0; s < 387; ++s) { const int i = s / 129, j = s % 129, d = (i == 0) ? 1 : (i == 1 ? 4 : 16); const int pos = t - j * d;
        if (pos >= 0) o += ps[w][s] * bf2f(base[(size_t)pos * INW + 3072 + h * 64 + lane]); }
    att[(size_t)(b * S + t) * 512 + h * 64 + lane] = o / l;
}

__global__ __launch_bounds__(256) void k_attnorm(const float* att, const float* g, float* mixin) {
    const int row = blockIdx.x * 4 + (threadIdx.x >> 6), lane = threadIdx.x & 63;
    float v[8]; float ss = 0.f;
#pragma unroll
    for (int i = 0; i < 8; ++i) { v[i] = att[(size_t)row * 512 + lane + 64 * i]; ss += v[i] * v[i]; }
#pragma unroll
    for (int o = 32; o > 0; o >>= 1) ss += __shfl_xor(ss, o);
    const float rstd = rsqrtf(ss / 512.f + EPS);
#pragma unroll
    for (int i = 0; i < 8; ++i) mixin[(size_t)row * D + 512 + lane + 64 * i] = v[i] * rstd * g[lane + 64 * i];
}

__global__ __launch_bounds__(256) void k_final(float* xo, const float* g) {
    const int row = blockIdx.x * 4 + (threadIdx.x >> 6), lane = threadIdx.x & 63;
    float* xr = xo + (size_t)row * D; float v[16]; float ss = 0.f;
#pragma unroll
    for (int i = 0; i < 16; ++i) { v[i] = xr[lane + 64 * i]; ss += v[i] * v[i]; }
#pragma unroll
    for (int o = 32; o > 0; o >>= 1) ss += __shfl_xor(ss, o);
    const float rstd = rsqrtf(ss / D + EPS);
#pragma unroll
    for (int i = 0; i < 16; ++i) xr[lane + 64 * i] = v[i] * rstd * g[lane + 64 * i];
}
}

extern "C" void kernel_launch(void* const* d_in, const int* in_sizes, int n_in, void* d_out, int out_size, void* d_ws, size_t ws_size, hipStream_t stream) {
    using namespace v0;
    const float* x = (const float*)d_in[0]; const float* c = (const float*)d_in[1]; const float* w_ada = (const float*)d_in[2]; const float* b_ada = (const float*)d_in[3];
    const float* norm1_g = (const float*)d_in[4]; const float* w_in = (const float*)d_in[5]; const float* lbl = (const float*)d_in[6]; const float* hg_onorm = (const float*)d_in[7];
    const float* att_onorm = (const float*)d_in[8]; const float* w_out = (const float*)d_in[9]; const float* norm2_g = (const float*)d_in[10]; const float* w_gu = (const float*)d_in[11];
    const float* w_down = (const float*)d_in[12]; const float* final_g = (const float*)d_in[13];
    float* out = (float*)d_out; unsigned char* ws = (unsigned char*)d_ws;
    constexpr size_t MiB = 1u << 20;
    float* mod = (float*)ws; float* lb = (float*)(ws + 512 * 1024);
    bf16_t* Y = (bf16_t*)(ws + 1 * MiB);
    float* ATT = (float*)(ws + 225 * MiB);
    float* MIXIN = (float*)(ws + 289 * MiB);
    float* H2 = (float*)(ws + 1 * MiB);
    bf16_t* HID = (bf16_t*)(ws + 129 * MiB);
    k_mod<<<dim3(24, 8), 256, 0, stream>>>(c, w_ada, b_ada, lbl, mod, lb);
    k_xn<<<T / 4, 256, 0, stream>>>(x, norm1_g, mod, 0, 1024, out);
    { GOut o{0, Y, nullptr, nullptr, nullptr, 0, INW}; k_gemm<0, 0><<<dim3(INW / 128, T / 128), 256, 0, stream>>>(out, w_in, T, INW, D, INW, o); }
    k_hgrn<<<32, 128, 0, stream>>>(Y, lb, hg_onorm, MIXIN);
    k_attn<<<T * 8 / 4, 256, 0, stream>>>(Y, ATT);
    k_attnorm<<<T / 4, 256, 0, stream>>>(ATT, att_onorm, MIXIN);
    { GOut o{1, nullptr, out, x, mod, 2048, D}; k_gemm<0, 0><<<dim3(D / 128, T / 128), 256, 0, stream>>>(MIXIN, w_out, T, D, D, D, o); }
    k_xn<<<T / 4, 256, 0, stream>>>(out, norm2_g, mod, 3072, 4096, H2);
    { GOut o{2, HID, nullptr, nullptr, nullptr, 0, DFF}; k_gemm<0, 1><<<dim3(DFF / 64, T / 128), 256, 0, stream>>>(H2, w_gu, T, DFF, D, 2 * DFF, o); }
    { GOut o{3, nullptr, out, out, mod, 5120, D}; k_gemm<1, 0><<<dim3(D / 128, T / 128), 256, 0, stream>>>(HID, w_down, T, D, DFF, D, o); }
    k_final<<<T / 4, 256, 0, stream>>>(out, final_g);
}
```

```cpp
#include <hip/hip_runtime.h>
#include <cstdio>
#include <cstdint>
namespace pg8 {
#define PG8_LAS __attribute__((address_space(3)))
typedef unsigned short bf16_t;
typedef short bf16x8 __attribute__((ext_vector_type(8)));
typedef float f32x4 __attribute__((ext_vector_type(4)));
typedef unsigned u32x4 __attribute__((ext_vector_type(4)));
constexpr int BM = 256, BK = 64, HALF = 128, HTB = HALF * BK * 2  , STAGE_BYTES = 8 * HTB, NXCD = 8, WGM = 8;

__host__ __device__ __forceinline__ int lds_byte(int r, int c) { const int st = (r >> 4) * 2 + (c >> 5), rr = r & 15, cc = c & 31, ob = rr * 64 + cc * 2; return st * 1024 + (ob ^ (((ob >> 9) & 1) << 5)); }
__host__ __device__ __forceinline__ void stage_rc(int b, int& R, int& C) { const int st = b / 1024, sb = b % 1024, swz = sb ^ (((sb >> 9) & 1) << 5); R = (st >> 1) * 16 + swz / 64; C = (st & 1) * 32 + (swz % 64) / 2; }
__host__ __device__ __forceinline__ int perm32(int rho) { const int n = rho >> 4, i = rho & 15; return 8 * (i >> 2) + 4 * n + (i & 3); }

struct Unit { int pm, pn; };
struct Gemm { const bf16_t* A; const bf16_t* Bt; int M, N, K; };

struct StaticOrder {
    int nM, nN, nwg, G, c;
    __host__ __device__ void init(int M, int N, int G_, int c_) { nM = M / BM; nN = N / BM; nwg = nM * nN; G = G_; c = c_; }
    __host__ __device__ bool next(int i, Unit& u) const {
        const long L = (long)i * G + c; if (L >= nwg) return false;
        int wgid = (int)L; { const int q = nwg / NXCD, r = nwg % NXCD, xcd = wgid % NXCD, off = wgid / NXCD; wgid = (xcd < r ? xcd * (q + 1) : r * (q + 1) + (xcd - r) * q) + off; }
        const int nig = WGM * nN, gid = wgid / nig, fm = gid * WGM, gsz = (nM - fm) < WGM ? (nM - fm) : WGM;
        u.pm = fm + ((wgid % nig) % gsz); u.pn = (wgid % nig) / gsz; return true;
    }
    __device__ __forceinline__ void a_ready(const Unit&) const {}
    __device__ __forceinline__ void done(const Unit&) const {}
};

__device__ __forceinline__ unsigned cvt_pk_bf16(float lo, float hi) { unsigned r; asm volatile("v_cvt_pk_bf16_f32 %0, %1, %2" : "=v"(r) : "v"(lo), "v"(hi)); return r; }
typedef float f32x2 __attribute__((ext_vector_type(2)));
template <class Epi, class Sched, bool ALIGN_EPI = false, bool SP2 = false>
__device__ __forceinline__ void gemm_phase(PG8_LAS unsigned char* lds, const Gemm g, const Sched& S, const Epi& E, const int wid_in  ) {
    int lane_o; asm volatile("v_mbcnt_lo_u32_b32 %0, -1, 0\n\tv_mbcnt_hi_u32_b32 %0, -1, %0" : "=&v"(lane_o));
    const int wid = wid_in, lane = lane_o, tid = wid * 64 + lane, wr = wid >> 2, wc = wid & 3, fr = lane & 15, fq = lane >> 4;
    const int K = g.K, nt = K / BK;
    unsigned voffA[2], voffB[2];
#pragma unroll
    for (int i = 0; i < 2; ++i) { int R, C; stage_rc(tid * 16 + i * 8192, R, C); const int Rb = Epi::PERM ? ((R & ~31) + perm32(R & 31)) : R;
        voffA[i] = (unsigned)(R * K + C) * 2u; voffB[i] = (unsigned)(Rb * K + C) * 2u; }
    const size_t kstep = (size_t)(BK * 2);
    const size_t hstep = (size_t)HALF * K * 2;
    const size_t tstep = 2 * hstep;
    const unsigned ldsw = (unsigned)wid * 1024u;
    const int aoff = lds_byte(wr * 64 + fr, fq * 8), boff = lds_byte(wc * 32 + fr, fq * 8);
#define PG8_SA(b, h) (((b) * 2 + (h)) * HTB)
#define PG8_SB(b, h) ((4 + (b) * 2 + (h)) * HTB)
#define PG8_STAGE(bufoff, gbase, voff) do { _Pragma("unroll") for (int _i = 0; _i < 2; ++_i) \
        __builtin_amdgcn_global_load_lds((const unsigned*)((const char*)(gbase) + (voff)[_i]), (PG8_LAS unsigned*)(lds + (bufoff) + ldsw + _i * 8192), 16, 0, 0); } while (0)
#define PG8_LDA(dst, b, h) do { _Pragma("unroll") for (int m = 0; m < 4; ++m) _Pragma("unroll") for (int k = 0; k < 2; ++k) dst[m][k] = *(const PG8_LAS bf16x8*)(lds + PG8_SA(b, h) + aoff + m * 2048 + k * 1024); } while (0)
#define PG8_LDB(dst, b, h) do { _Pragma("unroll") for (int n = 0; n < 2; ++n) _Pragma("unroll") for (int k = 0; k < 2; ++k) dst[n][k] = *(const PG8_LAS bf16x8*)(lds + PG8_SB(b, h) + boff + n * 2048 + k * 1024); } while (0)
#define PG8_MMA(ai, bj, At, Bt) do { __builtin_amdgcn_s_setprio(1); _Pragma("unroll") for (int m = 0; m < 4; ++m) _Pragma("unroll") for (int n = 0; n < 2; ++n) _Pragma("unroll") for (int k = 0; k < 2; ++k) \
        acc[ai][bj][m][n] = __builtin_amdgcn_mfma_f32_16x16x32_bf16(Bt[n][k], At[m][k], acc[ai][bj][m][n], 0, 0, 0); __builtin_amdgcn_s_setprio(0); } while (0)
#define PG8_WAIT_V(n) asm volatile("s_waitcnt vmcnt(" #n ")" ::: "memory")
#define PG8_WAIT_L(n) asm volatile("s_waitcnt lgkmcnt(" #n ")" ::: "memory")
#define PG8_BAR __builtin_amdgcn_s_barrier()
#define PG8_SCHED __builtin_amdgcn_sched_barrier(0)
    Unit cur, nxt; int ui = 0;
    if (!S.next(0, cur)) return;
    f32x4 acc[2][2][4][2];
#pragma unroll
    for (int a = 0; a < 2; ++a)
#pragma unroll
        for (int b = 0; b < 2; ++b)
#pragma unroll
            for (int m = 0; m < 4; ++m)
#pragma unroll
                for (int n = 0; n < 2; ++n) acc[a][b][m][n] = (f32x4){0.f, 0.f, 0.f, 0.f};
    bf16x8 At[4][2], B0[2][2], B1[2][2];
    const char* cA = (const char*)g.A + (size_t)cur.pm * tstep; const char* cB = (const char*)g.Bt + (size_t)cur.pn * tstep;
    S.a_ready(cur);
    if constexpr (SP2) {
        PG8_STAGE(PG8_SB(0, 0), cB, voffB); PG8_STAGE(PG8_SB(0, 1), cB + hstep, voffB); PG8_STAGE(PG8_SA(0, 0), cA, voffA); PG8_STAGE(PG8_SA(0, 1), cA + hstep, voffA);
        if (wr == 1) PG8_BAR;
        PG8_WAIT_V(2); PG8_BAR;
        PG8_STAGE(PG8_SB(1, 0), cB + kstep, voffB); PG8_STAGE(PG8_SA(1, 0), cA + kstep, voffA); PG8_STAGE(PG8_SB(1, 1), cB + hstep + kstep, voffB);
        PG8_WAIT_V(6); PG8_BAR;
    } else {
        PG8_STAGE(PG8_SB(0, 0), cB, voffB); PG8_STAGE(PG8_SA(0, 0), cA, voffA); PG8_STAGE(PG8_SB(0, 1), cB + hstep, voffB); PG8_STAGE(PG8_SA(0, 1), cA + hstep, voffA);
        if (wr == 1) PG8_BAR;
        PG8_WAIT_V(4); PG8_BAR;
        PG8_STAGE(PG8_SB(1, 0), cB + kstep, voffB); PG8_STAGE(PG8_SA(1, 0), cA + kstep, voffA); PG8_STAGE(PG8_SB(1, 1), cB + hstep + kstep, voffB);
        PG8_WAIT_V(6); PG8_BAR;
    }
    for (;;) {
        const bool has_next = S.next(ui + 1, nxt);
        const char* nA = has_next ? (const char*)g.A + (size_t)nxt.pm * tstep : cA; const char* nB = has_next ? (const char*)g.Bt + (size_t)nxt.pn * tstep : cB;
        for (int t = 0; t < nt; t += 2) {
            const bool last = (t == nt - 2);
            const char* a1 = cA + (size_t)(t + 1) * kstep;
            const char* a2 = last ? nA : cA + (size_t)(t + 2) * kstep; const char* b2 = last ? nB : cB + (size_t)(t + 2) * kstep;
            const char* a3 = a2 + kstep; const char* b3 = b2 + kstep;
            if (last && has_next) S.a_ready(nxt);
            if constexpr (SP2) {
            PG8_LDB(B0, 0, 0); PG8_LDB(B1, 0, 1); PG8_SCHED; PG8_LDA(At, 0, 0); PG8_STAGE(PG8_SA(1, 1), a1 + hstep, voffA);
            PG8_WAIT_V(8); PG8_WAIT_L(0); PG8_BAR; PG8_MMA(0, 0, At, B0); PG8_MMA(0, 1, At, B1); PG8_BAR; PG8_SCHED;
            PG8_LDA(At, 0, 1); PG8_STAGE(PG8_SB(0, 0), b2, voffB); PG8_STAGE(PG8_SB(0, 1), b2 + hstep, voffB); PG8_STAGE(PG8_SA(0, 0), a2, voffA);
            PG8_WAIT_V(8); PG8_WAIT_L(0); PG8_BAR; PG8_MMA(1, 0, At, B0); PG8_MMA(1, 1, At, B1); PG8_BAR; PG8_SCHED;
            PG8_LDB(B0, 1, 0); PG8_LDB(B1, 1, 1); PG8_SCHED; PG8_LDA(At, 1, 0); PG8_STAGE(PG8_SA(0, 1), a2 + hstep, voffA);
            PG8_WAIT_V(8); PG8_WAIT_L(0); PG8_BAR; PG8_MMA(0, 0, At, B0); PG8_MMA(0, 1, At, B1); PG8_BAR; PG8_SCHED;
            PG8_LDA(At, 1, 1); PG8_STAGE(PG8_SB(1, 0), b3, voffB); PG8_STAGE(PG8_SB(1, 1), b3 + hstep, voffB); PG8_STAGE(PG8_SA(1, 0), a3, voffA);
            PG8_WAIT_V(8); PG8_WAIT_L(0); PG8_BAR; PG8_MMA(1, 0, At, B0); PG8_MMA(1, 1, At, B1); PG8_BAR; PG8_SCHED;
            } else {
            PG8_LDB(B0, 0, 0); PG8_SCHED; PG8_LDA(At, 0, 0); PG8_STAGE(PG8_SA(1, 1), a1 + hstep, voffA);
            PG8_WAIT_L(8); PG8_BAR; PG8_WAIT_L(0); PG8_MMA(0, 0, At, B0); PG8_BAR; PG8_SCHED;
            PG8_LDB(B1, 0, 1); PG8_STAGE(PG8_SB(0, 0), b2, voffB);
            PG8_BAR; PG8_WAIT_L(0); PG8_MMA(0, 1, At, B1); PG8_BAR;
            PG8_LDA(At, 0, 1); PG8_STAGE(PG8_SA(0, 0), a2, voffA);
            PG8_BAR; PG8_WAIT_L(0); PG8_MMA(1, 0, At, B0); PG8_BAR; PG8_SCHED;
            PG8_STAGE(PG8_SB(0, 1), b2 + hstep, voffB);
            PG8_WAIT_V(6); PG8_BAR; PG8_MMA(1, 1, At, B1); PG8_BAR;
            PG8_LDB(B0, 1, 0); PG8_SCHED; PG8_LDA(At, 1, 0); PG8_STAGE(PG8_SA(0, 1), a2 + hstep, voffA);
            PG8_WAIT_L(8); PG8_BAR; PG8_WAIT_L(0); PG8_MMA(0, 0, At, B0); PG8_BAR; PG8_SCHED;
            PG8_LDB(B1, 1, 1); PG8_STAGE(PG8_SB(1, 0), b3, voffB);
            PG8_BAR; PG8_WAIT_L(0); PG8_MMA(0, 1, At, B1); PG8_BAR;
            PG8_LDA(At, 1, 1); PG8_STAGE(PG8_SA(1, 0), a3, voffA);
            PG8_BAR; PG8_WAIT_L(0); PG8_MMA(1, 0, At, B0); PG8_BAR; PG8_SCHED;
            PG8_STAGE(PG8_SB(1, 1), b3 + hstep, voffB);
            PG8_WAIT_V(6); PG8_BAR; PG8_MMA(1, 1, At, B1); PG8_BAR;
            }
        }
        if constexpr (ALIGN_EPI) { if (wr == 0) PG8_BAR; }
        if constexpr (!Epi::AFTER_DRAIN) { E(acc, cur, wr, wc, fr, fq); S.done(cur); }
        if (!has_next) break;
#pragma unroll
        for (int a = 0; a < 2; ++a)
#pragma unroll
            for (int b = 0; b < 2; ++b)
#pragma unroll
                for (int m = 0; m < 4; ++m)
#pragma unroll
                    for (int n = 0; n < 2; ++n) acc[a][b][m][n] = (f32x4){0.f, 0.f, 0.f, 0.f};
        cur = nxt; cA = nA; cB = nB; ++ui;
        if constexpr (ALIGN_EPI) { if (wr == 1) PG8_BAR; }
    }
    PG8_WAIT_V(0);
    if constexpr (!ALIGN_EPI) { if (wr == 0) PG8_BAR; }
    PG8_BAR;
    if constexpr (Epi::AFTER_DRAIN) { E.fused(acc, cur, wr, wc, fr, fq, lds, wid, lane); S.done(cur); }
#undef PG8_SA
#undef PG8_SB
#undef PG8_STAGE
#undef PG8_LDA
#undef PG8_LDB
#undef PG8_MMA
#undef PG8_WAIT_V
#undef PG8_WAIT_L
#undef PG8_BAR
#undef PG8_SCHED
}
}
#define GAS __attribute__((address_space(1)))
#define LAS __attribute__((address_space(3)))
typedef unsigned short bf16;
typedef unsigned v4u __attribute__((ext_vector_type(4)));
typedef float f32x4 __attribute__((ext_vector_type(4)));
typedef short bf16x8 __attribute__((ext_vector_type(8)));
typedef GAS unsigned gu32;
typedef GAS unsigned long long gu64;
#define RLX_AGENT __ATOMIC_RELAXED, __HIP_MEMORY_SCOPE_AGENT
#define LDS_WAIT() asm volatile("s_waitcnt lgkmcnt(0)" ::: "memory")
#define VM_WAIT() asm volatile("s_waitcnt vmcnt(0)" ::: "memory")
__device__ __forceinline__ unsigned long long rt() { return __builtin_amdgcn_s_memrealtime(); }
__device__ __forceinline__ unsigned f2bf(float f) { unsigned u = __builtin_bit_cast(unsigned, f); return (u + 0x7fffu + ((u >> 16) & 1u)) >> 16; }
__device__ __forceinline__ unsigned pk2(float lo, float hi) { return f2bf(lo) | (f2bf(hi) << 16); }
#define XB_TMO      128
#define XB_XCNT(j)  (256  + 64 * (j))
#define XB_XSUB(j)  (1280 + 64 * (j))
#define XB_XGEN(j)  (2304 + 64 * (j))
#define XB_TOP      3328
#define XB_TOPGEN   3392
#define XCD_BAR_WORDS 3456
#define XB_SPIN_CAP (1u << 24)

__device__ __forceinline__ unsigned xb_ld(unsigned* p)              { return __hip_atomic_load(p, __ATOMIC_RELAXED, __HIP_MEMORY_SCOPE_AGENT); }
__device__ __forceinline__ unsigned xb_add(unsigned* p, unsigned v) { return __hip_atomic_fetch_add(p, v, __ATOMIC_RELAXED, __HIP_MEMORY_SCOPE_AGENT); }
__device__ __forceinline__ unsigned xb_xcc_id() { return (unsigned)__builtin_amdgcn_s_getreg((3 << 11) | 20) & 0xFu; }
#define XB_SPIN(cond, bar) do { unsigned _sp = 0; while (cond) { __builtin_amdgcn_s_sleep(1); \
    if ((++_sp & 255u) == 0u) { if (xb_ld(&(bar)[XB_TMO])) break; if (_sp > XB_SPIN_CAP) { atomicAdd(&(bar)[XB_TMO], 1u); break; } } } } while (0)

struct XcdBarrier {
    unsigned* bar; unsigned x;
    volatile LAS unsigned* st;
};

__device__ __forceinline__ XcdBarrier xcd_barrier_post(unsigned* bar, volatile LAS unsigned* st) {
    XcdBarrier b; b.bar = bar; b.x = xb_xcc_id(); b.st = st;
    if (threadIdx.x == 0) (void)xb_add(&bar[XB_XCNT(b.x)], 1u);
    return b;
}
__device__ __forceinline__ void xcd_barrier_complete(unsigned* bar, unsigned x, unsigned& nloc, unsigned& nx) {
    const unsigned G = gridDim.x * gridDim.y * gridDim.z;
    unsigned sum, cnt, mine, sp = 0u;
    for (;;) {
        sum = 0u; cnt = 0u; mine = 0u;
#pragma unroll
        for (unsigned j = 0; j < 16; ++j) { const unsigned c = xb_ld(&bar[XB_XCNT(j)]); sum += c; cnt += (c > 0u) ? 1u : 0u; mine = (j == x) ? c : mine; }
        if (sum == G) break;
        __builtin_amdgcn_s_sleep(1);
        if ((++sp & 255u) == 0u) { if (xb_ld(&bar[XB_TMO])) break; if (sp > XB_SPIN_CAP) { atomicAdd(&bar[XB_TMO], 1u); break; } }
    }
    nloc = mine > 0u ? mine : 1u; nx = cnt > 0u ? cnt : 1u;
}

__device__ __forceinline__ void xcd_barrier(const XcdBarrier& b) {
    asm volatile("s_waitcnt vmcnt(0)" ::: "memory");
    __syncthreads();
    if (threadIdx.x == 0) {
        unsigned* bar = b.bar;
        __builtin_amdgcn_s_waitcnt(0);
        unsigned nloc = b.st[0], nx = b.st[1];
        if (nloc == 0u) { xcd_barrier_complete(bar, b.x, nloc, nx); b.st[0] = nloc; b.st[1] = nx; }
        const unsigned old = xb_add(&bar[XB_XSUB(b.x)], 1u);
        const unsigned gen = old / nloc;
        if (old + 1u == (gen + 1u) * nloc) {
            __builtin_amdgcn_fence(__ATOMIC_RELEASE, "agent");
            asm volatile("s_waitcnt vmcnt(0)" ::: "memory");
            const unsigned og = xb_add(&bar[XB_TOP], 1u);
            const unsigned tg = og / nx;
            if (og + 1u == (tg + 1u) * nx) xb_add(&bar[XB_TOPGEN], 1u);
            else XB_SPIN(xb_ld(&bar[XB_TOPGEN]) == tg, bar);
            __builtin_amdgcn_fence(__ATOMIC_ACQUIRE, "agent");
            xb_add(&bar[XB_XGEN(b.x)], 1u);
            asm volatile("s_waitcnt vmcnt(0)" ::: "memory");
        } else {
            XB_SPIN(xb_ld(&bar[XB_XGEN(b.x)]) == gen, bar);
            __builtin_amdgcn_fence(__ATOMIC_ACQUIRE, "agent");
            asm volatile("s_waitcnt vmcnt(0)" ::: "memory");
        }
    }
    __syncthreads();
}
namespace mk {
using pg8::f32x4; using pg8::Unit; using pg8::bf16_t; using pg8::u32x4; using pg8::cvt_pk_bf16;
typedef unsigned u32x2 __attribute__((ext_vector_type(2)));
constexpr int B = 8, S = 4096, D = 1024, T = B * S, INW = 3584, DFF = 2816, NMOD = 6144, NGU = 2 * DFF;
constexpr float EPS = 1e-6f, LOG2E = 1.4426950408889634f, QSCALE = 0.125f * 1.4426950408889634f;
#define EPI_LANES() int lane_; asm volatile("v_mbcnt_lo_u32_b32 %0, -1, 0\n\tv_mbcnt_hi_u32_b32 %0, -1, %0" : "=&v"(lane_)); const int wr = wr_, wc = wc_, fr = lane_ & 15, fq = lane_ >> 4; (void)fr_; (void)fq_;
template <int CTRL> __device__ __forceinline__ float dpp_mov0(float v) { return __int_as_float(__builtin_amdgcn_update_dpp(0, __float_as_int(v), CTRL, 0xF, 0xF, false)); }
__device__ __forceinline__ float row_scan16(float s) { s += dpp_mov0<0x111>(s); s += dpp_mov0<0x112>(s); s += dpp_mov0<0x114>(s); s += dpp_mov0<0x118>(s); return s; }
__device__ __forceinline__ float row_sum16(float s) { s += dpp_mov0<0x128>(s); s += dpp_mov0<0x124>(s); s += dpp_mov0<0x122>(s); s += dpp_mov0<0x121>(s); return s; }
__device__ __forceinline__ float ex2(float x) { return __builtin_amdgcn_exp2f(x); }
__device__ __forceinline__ float lg2(float x) { return __builtin_amdgcn_logf(x); }
__device__ __forceinline__ float rcp(float x) { return __builtin_amdgcn_rcpf(x); }
__device__ __forceinline__ float rsq(float x) { return __builtin_amdgcn_rsqf(x); }
__device__ __forceinline__ float silu(float x) { return x * rcp(1.f + ex2(-x * LOG2E)); }
__device__ __forceinline__ float bf2f(unsigned short h) { return __uint_as_float(((unsigned)h) << 16); }
__device__ __forceinline__ float bflo(unsigned w) { return __uint_as_float(w << 16); }
__device__ __forceinline__ float bfhi(unsigned w) { return __uint_as_float(w & 0xffff0000u); }

struct EpiIn {
    static constexpr bool PERM = true, AFTER_DRAIN = false;
    bf16_t *QT, *KT, *VH, *SG, *AQ, *AK, *AV; float* DEC; const float* lb;
    __device__ __forceinline__ void operator()(f32x4 (&acc)[2][2][4][2], const Unit& u, int wr_, int wc_, int fr_, int fq_) const {
        EPI_LANES();
        const int pn = u.pn; const unsigned row0 = (unsigned)(u.pm * 256 + wr * 64 + fr);
#ifndef NO_HGRN_EPI
        if (pn < 4) {
            const int cb = pn * 128 + wc * 32 + 8 * fq;
            const f32x4 l0 = *(const f32x4*)(lb + cb), l1 = *(const f32x4*)(lb + cb + 4);
#pragma unroll
            for (int ai = 0; ai < 2; ++ai) {
                const unsigned chunk = (unsigned)(u.pm * 4 + ai * 2 + wr);
#pragma unroll
                for (int n = 0; n < 2; ++n) {
                    float dl[4];
#pragma unroll
                    for (int j = 0; j < 4; ++j) {
                        const float lbv = n == 0 ? l0[j] : l1[j], omlb = 1.f - lbv;
                        float lgv[4], b2[4]; float carry = 0.f;
#pragma unroll
                        for (int m = 0; m < 4; ++m) { const float e = ex2(-acc[ai][1][m][n][j] * LOG2E), sg = rcp(1.f + e); lgv[m] = lg2(lbv + omlb * sg); acc[ai][1][m][n][j] = omlb * (e * sg); }
#pragma unroll
                        for (int m = 0; m < 4; ++m) { const float s = row_scan16(lgv[m]), tot = row_sum16(lgv[m]); b2[m] = carry + s; carry += tot; }
                        dl[j] = ex2(carry);
#pragma unroll
                        for (int m = 0; m < 4; ++m) { acc[ai][0][m][n][j] = silu(acc[ai][0][m][n][j]) * ex2(b2[m]); acc[ai][1][m][n][j] *= ex2(-b2[m]); }
                        __builtin_amdgcn_sched_barrier(0);
                    }
                    *(f32x4*)(DEC + (chunk * 512u + (unsigned)(cb + 4 * n))) = (f32x4){dl[0], dl[1], dl[2], dl[3]};
#pragma unroll
                    for (int m = 0; m < 4; ++m) { const unsigned off = (row0 + ai * 128 + m * 16) * 512u + (unsigned)(cb + 4 * n);
                        const f32x4 q = acc[ai][0][m][n], k = acc[ai][1][m][n];
                        u32x2 w; w.x = cvt_pk_bf16(q[0], q[1]); w.y = cvt_pk_bf16(q[2], q[3]); *(u32x2*)(QT + off) = w;
                        u32x2 kw; kw.x = cvt_pk_bf16(k[0], k[1]); kw.y = cvt_pk_bf16(k[2], k[3]); *(u32x2*)(KT + off) = kw; }
                    __builtin_amdgcn_sched_barrier(0);
                }
            }
        } else
#endif
        {
            const int g = (pn - 4) >> 1; bf16_t* base = g == 0 ? VH : g == 1 ? SG : g == 2 ? AQ : g == 3 ? AK : AV;
            const unsigned col0 = (unsigned)(((pn - 4) & 1) * 256 + wc * 32 + 8 * fq);
#pragma unroll
            for (int ai = 0; ai < 2; ++ai)
#pragma unroll
                for (int m = 0; m < 4; ++m) { bf16_t* rowp = base + ((row0 + ai * 128 + m * 16) * 512u + col0);
#pragma unroll
                    for (int bj = 0; bj < 2; ++bj) { f32x4 v0 = acc[ai][bj][m][0], v1 = acc[ai][bj][m][1];
                        if (g == 1) {
#pragma unroll
                            for (int j = 0; j < 4; ++j) { v0[j] = silu(v0[j]); v1[j] = silu(v1[j]); } }
                        if (g == 2) { v0 = v0 * QSCALE; v1 = v1 * QSCALE; }
                        u32x4 w; w.x = cvt_pk_bf16(v0[0], v0[1]); w.y = cvt_pk_bf16(v0[2], v0[3]); w.z = cvt_pk_bf16(v1[0], v1[1]); w.w = cvt_pk_bf16(v1[2], v1[3]);
                        *(u32x4*)(rowp + bj * 128) = w; } }
        }
    }
};

struct EpiOut {
    static constexpr bool PERM = false, AFTER_DRAIN = false;
    const float* x; float* x1; bf16_t* A2; float* ssq; const float* mod; const float* g2;
    __device__ __forceinline__ void operator()(const f32x4 (&acc)[2][2][4][2], const Unit& u, int wr_, int wc_, int fr_, int fq_) const {
        EPI_LANES();
        const int b = u.pm >> 4, col0 = u.pn * 256 + wc * 32 + 4 * fq, rowb = u.pm * 256 + wr * 64 + fr; const float* modb = mod + b * NMOD;
        float ssr[2][4];
#pragma unroll
        for (int ai = 0; ai < 2; ++ai)
#pragma unroll
            for (int m = 0; m < 4; ++m) ssr[ai][m] = 0.f;
#pragma unroll
        for (int bj = 0; bj < 2; ++bj)
#pragma unroll
            for (int n = 0; n < 2; ++n) { const int c = col0 + bj * 128 + n * 16;
                const f32x4 gate = *(const f32x4*)(modb + 2048 + c), sc2 = *(const f32x4*)(modb + 4096 + c), gg = *(const f32x4*)(g2 + c); const f32x4 mul = gg * (sc2 + 1.0f);
#pragma unroll
                for (int ai = 0; ai < 2; ++ai)
#pragma unroll
                    for (int m = 0; m < 4; ++m) { const size_t off = (size_t)(rowb + ai * 128 + m * 16) * D + c;
                        const f32x4 v = *(const f32x4*)(x + off) + gate * acc[ai][bj][m][n]; *(f32x4*)(x1 + off) = v;
                        ssr[ai][m] += (v[0] * v[0] + v[1] * v[1]) + (v[2] * v[2] + v[3] * v[3]);
                        const f32x4 a = v * mul; u32x2 w; w.x = cvt_pk_bf16(a[0], a[1]); w.y = cvt_pk_bf16(a[2], a[3]); *(u32x2*)(A2 + off) = w; } }
#pragma unroll
        for (int ai = 0; ai < 2; ++ai)
#pragma unroll
            for (int m = 0; m < 4; ++m) { float s = ssr[ai][m]; s += __shfl_xor(s, 16); s += __shfl_xor(s, 32);
                if (fq == 0) ssq[(size_t)(rowb + ai * 128 + m * 16) * 16 + u.pn * 4 + wc] = s; }
    }
};

struct EpiGU {
    static constexpr bool PERM = true, AFTER_DRAIN = false;
    bf16_t* HID; const float* ssq; const float* bias2;
    __device__ __forceinline__ void operator()(const f32x4 (&acc)[2][2][4][2], const Unit& u, int wr_, int wc_, int fr_, int fq_) const {
        EPI_LANES();
        const int b = u.pm >> 4, rowb = u.pm * 256 + wr * 64 + fr; const float* bb = bias2 + b * NGU + u.pn * 256 + wc * 32 + 8 * fq;
        const f32x4 ba0 = *(const f32x4*)(bb), ba1 = *(const f32x4*)(bb + 4), bu0 = *(const f32x4*)(bb + 128), bu1 = *(const f32x4*)(bb + 132);
#pragma unroll
        for (int ai = 0; ai < 2; ++ai)
#pragma unroll
            for (int m = 0; m < 4; ++m) { const int row = rowb + ai * 128 + m * 16; const f32x4* sp = (const f32x4*)(ssq + (size_t)row * 16);
                const f32x4 s0 = sp[0], s1 = sp[1], s2 = sp[2], s3 = sp[3]; const f32x4 st = (s0 + s1) + (s2 + s3);
                const float rstd = rsq(((st[0] + st[1]) + (st[2] + st[3])) * (1.0f / D) + EPS);
                const f32x4 a0 = acc[ai][0][m][0] * rstd + ba0, a1 = acc[ai][0][m][1] * rstd + ba1, u0 = acc[ai][1][m][0] * rstd + bu0, u1 = acc[ai][1][m][1] * rstd + bu1;
                float h[8];
#pragma unroll
                for (int j = 0; j < 4; ++j) { h[j] = silu(a0[j]) * u0[j]; h[4 + j] = silu(a1[j]) * u1[j]; }
                u32x4 w; w.x = cvt_pk_bf16(h[0], h[1]); w.y = cvt_pk_bf16(h[2], h[3]); w.z = cvt_pk_bf16(h[4], h[5]); w.w = cvt_pk_bf16(h[6], h[7]);
                *(u32x4*)(HID + (size_t)row * DFF + u.pn * 128 + wc * 32 + 8 * fq) = w; }
    }
};

struct EpiDown {
    static constexpr bool PERM = false, AFTER_DRAIN = false;
    float* xio; const float* mod;
    __device__ __forceinline__ void operator()(const f32x4 (&acc)[2][2][4][2], const Unit& u, int wr_, int wc_, int fr_, int fq_) const {
        EPI_LANES();
        const int b = u.pm >> 4, col0 = u.pn * 256 + wc * 32 + 4 * fq, rowb = u.pm * 256 + wr * 64 + fr; const float* modb = mod + b * NMOD;
#pragma unroll
        for (int bj = 0; bj < 2; ++bj)
#pragma unroll
            for (int n = 0; n < 2; ++n) { const int c = col0 + bj * 128 + n * 16; const f32x4 gate = *(const f32x4*)(modb + 5120 + c);
#pragma unroll
                for (int ai = 0; ai < 2; ++ai)
#pragma unroll
                    for (int m = 0; m < 4; ++m) { const size_t off = (size_t)(rowb + ai * 128 + m * 16) * D + c; *(f32x4*)(xio + off) = *(const f32x4*)(xio + off) + gate * acc[ai][bj][m][n]; } }
    }
};
}
namespace mk {
constexpr int NWAVES = 8;
constexpr size_t MiB = 1u << 20;
constexpr size_t WS_CTL = 0, CTL_ZERO_BYTES = 64 * 1024;
constexpr size_t WS_MODP = 1 * MiB;
constexpr size_t WS_MOD = 3 * MiB, WS_LB = WS_MOD + 256 * 1024, WS_BIAS2 = WS_MOD + 512 * 1024;
constexpr size_t WS_WIN = 4 * MiB, WS_WOUT = 11 * MiB, WS_WGU = 13 * MiB, WS_WD = 24 * MiB;
constexpr size_t WS_DEC = 30 * MiB, WS_LSE = 31 * MiB, WS_SSQ1 = 34 * MiB;
constexpr size_t WS_BUFA = 40 * MiB;
constexpr size_t WS_BUFB = 104 * MiB;
constexpr size_t WS_R = 168 * MiB;
constexpr size_t WS_QT = WS_R, WS_KT = WS_R + 32 * MiB, WS_VH = WS_R + 64 * MiB, WS_SG = WS_R + 96 * MiB, WS_AQ = WS_R + 128 * MiB, WS_AK = WS_R + 160 * MiB, WS_AV = WS_R + 192 * MiB;
constexpr size_t WS_OHG = WS_BUFA, WS_ATT0 = WS_BUFA + 32 * MiB, WS_ATT1 = WS_R + 224 * MiB, WS_ATT2 = WS_R + 256 * MiB;
constexpr size_t WS_HID = WS_R;
constexpr size_t WS_END = WS_R + 288 * MiB;
constexpr int CW_BAR = 4096;
constexpr int RING_BYTES = 131072, LDSCTL_OFF = RING_BYTES, MISC_OFF = LDSCTL_OFF + 320, LDS_BYTES = 147456;

__device__ __forceinline__ const float* karg_ptr(int i) {
    asm volatile("" : "+s"(i));
    typedef const float* cfp;
    const __attribute__((address_space(4))) cfp* ka = (const __attribute__((address_space(4))) cfp*)__builtin_amdgcn_kernarg_segment_ptr();
    return ka[i];
}

__device__ __forceinline__ void transpose_item(const float* W, int K, int N, bf16* WT, int mode, LAS float* scr, int item, int lane) {
    const int nblk = N / 32, kb = item / nblk, nb = item % nblk, k0 = 64 * kb, n0 = 32 * nb;
    int r0 = n0;
    if (mode == 1) { if (n0 < 512) r0 = (n0 >> 7) * 256 + (n0 & 127); else if (n0 < 1024) r0 = ((n0 - 512) >> 7) * 256 + 128 + (n0 & 127); }
    if (mode == 2) { if (n0 < DFF) r0 = (n0 >> 7) * 256 + (n0 & 127); else r0 = ((n0 - DFF) >> 7) * 256 + 128 + ((n0 - DFF) & 127); }
#pragma unroll 8
    for (int i = 0; i < 32; ++i) { const int kk = 2 * i + (lane >> 5); scr[kk * 33 + (lane & 31)] = W[(size_t)(k0 + kk) * N + n0 + (lane & 31)]; }
    LDS_WAIT(); asm volatile("" ::: "memory");
    const int c = lane & 7;
#pragma unroll
    for (int j = 0; j < 4; ++j) { const int n = (lane >> 3) + 8 * j; const LAS float* s = scr + (8 * c) * 33 + n;
        v4u o; o.x = pk2(s[0 * 33], s[1 * 33]); o.y = pk2(s[2 * 33], s[3 * 33]); o.z = pk2(s[4 * 33], s[5 * 33]); o.w = pk2(s[6 * 33], s[7 * 33]);
        *(GAS v4u*)(WT + (size_t)(r0 + n) * K + k0 + 8 * c) = o; }
    LDS_WAIT(); asm volatile("" ::: "memory");
}
__device__ __forceinline__ void mod_partial(const float* Pc, const float* Pw_ada, float* modp, LAS float* scr, int it, int lane) {
    const int cg = it % 96, ks = it / 96, n = cg * 64 + lane;
#pragma unroll
    for (int i = 0; i < 16; ++i) { const int idx = i * 64 + lane, kk = idx & 127, b = idx >> 7; scr[kk * 8 + b] = silu(Pc[b * D + ks * 128 + kk]); }
    LDS_WAIT(); asm volatile("" ::: "memory");
    float acc[8];
#pragma unroll
    for (int b = 0; b < 8; ++b) acc[b] = 0.f;
    const float* wp = Pw_ada + (size_t)(ks * 128) * NMOD + n;
#pragma unroll 16
    for (int kk = 0; kk < 128; ++kk) { const float w = wp[(size_t)kk * NMOD]; const f32x4 c0 = *(const LAS f32x4*)(scr + kk * 8), c1 = *(const LAS f32x4*)(scr + kk * 8 + 4);
        acc[0] += c0[0] * w; acc[1] += c0[1] * w; acc[2] += c0[2] * w; acc[3] += c0[3] * w; acc[4] += c1[0] * w; acc[5] += c1[1] * w; acc[6] += c1[2] * w; acc[7] += c1[3] * w; }
#pragma unroll
    for (int b = 0; b < 8; ++b) modp[(size_t)(ks * 8 + b) * NMOD + n] = acc[b];
    LDS_WAIT(); asm volatile("" ::: "memory");
}
__device__ __forceinline__ float wsum64(float v) {
#pragma unroll
    for (int o = 1; o < 64; o <<= 1) v += __shfl_xor(v, o);
    return v;
}
__device__ __forceinline__ float wmax64(float v) {
#pragma unroll
    for (int o = 1; o < 64; o <<= 1) v = fmaxf(v, __shfl_xor(v, o));
    return v;
}

struct Args { const float* in[14]; float* out; unsigned char* ws; };
__global__ void __launch_bounds__(NWAVES * 64, 2) mk_fwd(Args args) {
    extern __shared__ __attribute__((aligned(16))) unsigned char lds_raw[];
    LAS unsigned char* lds = (LAS unsigned char*)lds_raw;
    volatile LAS unsigned* MISC = (volatile LAS unsigned*)(lds + MISC_OFF);
    const int wave = __builtin_amdgcn_readfirstlane(threadIdx.x >> 6);
    const int G = gridDim.x, bx = blockIdx.x; const int vcu = (G % 8 == 0) ? (bx % 8) * (G / 8) + bx / 8 : bx;
    const int gw = vcu * NWAVES + wave, NGW = G * NWAVES;
    (void)args;
#define INP(i) karg_ptr(i)
#define P_x INP(0)
#define P_c INP(1)
#define P_w_ada INP(2)
#define P_b_ada INP(3)
#define P_g1 INP(4)
#define P_w_in INP(5)
#define P_lbl INP(6)
#define P_hg_on INP(7)
#define P_att_on INP(8)
#define P_w_out INP(9)
#define P_g2 INP(10)
#define P_w_gu INP(11)
#define P_w_down INP(12)
#define P_gf INP(13)
#define P_out ((float*)INP(14))
    unsigned char* const ws = (unsigned char*)INP(15);
    gu32* ctl = (gu32*)(ws + WS_CTL);
#define MODP ((float*)(ws + WS_MODP))
#define MOD ((float*)(ws + WS_MOD))
#define LB ((float*)(ws + WS_LB))
#define BIAS2 ((float*)(ws + WS_BIAS2))
#define WIN_T ((bf16*)(ws + WS_WIN))
#define WOUT_T ((bf16*)(ws + WS_WOUT))
#define WGU_T ((bf16*)(ws + WS_WGU))
#define WD_T ((bf16*)(ws + WS_WD))
#define DEC ((float*)(ws + WS_DEC))
#define LSE ((float*)(ws + WS_LSE))
#define SSQ1 ((float*)(ws + WS_SSQ1))
#define XN ((bf16*)(ws + WS_BUFA))
#define A2 ((bf16*)(ws + WS_BUFA))
#define MIXIN ((bf16*)(ws + WS_BUFB))
#define QT ((bf16*)(ws + WS_QT))
#define KT ((bf16*)(ws + WS_KT))
#define VH ((bf16*)(ws + WS_VH))
#define SG ((bf16*)(ws + WS_SG))
#define AQ ((bf16*)(ws + WS_AQ))
#define AK ((bf16*)(ws + WS_AK))
#define AV ((bf16*)(ws + WS_AV))
#define OHG ((bf16*)(ws + WS_OHG))
#define HID ((bf16*)(ws + WS_HID))
#define PHASE_TID() int lane; asm volatile("v_mbcnt_lo_u32_b32 %0, -1, 0\n\tv_mbcnt_hi_u32_b32 %0, -1, %0" : "=&v"(lane)); const int tid = wave * 64 + lane; (void)tid;

    for (int u = threadIdx.x; u < (LDS_BYTES - LDSCTL_OFF) / 4; u += NWAVES * 64) ((LAS unsigned*)(lds + LDSCTL_OFF))[u] = 0u;
    __syncthreads();
    XcdBarrier bar = xcd_barrier_post((unsigned*)(ctl + CW_BAR), MISC + 8);

    {   PHASE_TID();
        LAS float* scr = (LAS float*)(lds + wave * 16384);
        constexpr int I_MOD = 768, I_IN = 16 * (INW / 32), I_OUT = 16 * (D / 32), I_GU = 16 * (NGU / 32), I_DN = (DFF / 64) * (D / 32);
        constexpr int NTASK = I_MOD + I_IN + I_OUT + I_GU + I_DN + 1;
        for (int it = gw; it < NTASK; it += NGW) {
            int r = it;
            if (r < I_MOD) { mod_partial(P_c, P_w_ada, MODP, scr, r, lane); continue; } r -= I_MOD;
            if (r < I_IN) { transpose_item(P_w_in, D, INW, WIN_T, 1, scr, r, lane); continue; } r -= I_IN;
            if (r < I_OUT) { transpose_item(P_w_out, D, D, WOUT_T, 0, scr, r, lane); continue; } r -= I_OUT;
            if (r < I_GU) { transpose_item(P_w_gu, D, NGU, WGU_T, 2, scr, r, lane); continue; } r -= I_GU;
            if (r < I_DN) { transpose_item(P_w_down, DFF, D, WD_T, 0, scr, r, lane); continue; }
#pragma unroll
            for (int i = 0; i < 8; ++i) { const int j = lane + 64 * i; LB[j] = rcp(1.f + ex2((P_lbl[512 + j] - P_lbl[j]) * LOG2E)); }
        }
    }
    xcd_barrier(bar);

    {   PHASE_TID();
        LAS float* ms = (LAS float*)lds; LAS float* sh = ms + D;
        if (tid < 192) { const int idx = bx * 192 + tid; const int b = idx / NMOD, n = idx % NMOD; float v = P_b_ada[n];
#pragma unroll
            for (int ks = 0; ks < 8; ++ks) v += MODP[(size_t)(ks * 8 + b) * NMOD + n];
            MOD[idx] = v; }
        const int rows_per = T / G, row0 = bx * rows_per, b = row0 / S;
#pragma unroll
        for (int i = 0; i < 2; ++i) { const int k = tid + 512 * i; float s1 = P_b_ada[k], c1 = P_b_ada[1024 + k];
#pragma unroll
            for (int ks = 0; ks < 8; ++ks) { s1 += MODP[(size_t)(ks * 8 + b) * NMOD + k]; c1 += MODP[(size_t)(ks * 8 + b) * NMOD + 1024 + k]; }
            ms[k] = P_g1[k] * (1.f + c1); sh[k] = s1; }
        __syncthreads();
        for (int r = wave; r < rows_per; r += NWAVES) {
            const int row = row0 + r; const GAS f32x4* xr = (const GAS f32x4*)(P_x + (size_t)row * D) + lane;
            f32x4 v[4]; float s = 0.f;
#pragma unroll
            for (int j = 0; j < 4; ++j) { v[j] = xr[64 * j]; s += (v[j].x * v[j].x + v[j].y * v[j].y) + (v[j].z * v[j].z + v[j].w * v[j].w); }
            const float rstd = rsq(wsum64(s) * (1.f / D) + EPS);
            GAS unsigned long long* o8 = (GAS unsigned long long*)(XN + (size_t)row * D) + lane;
#pragma unroll
            for (int j = 0; j < 4; ++j) { const f32x4 m4 = *(const LAS f32x4*)(ms + 256 * j + 4 * lane), s4 = *(const LAS f32x4*)(sh + 256 * j + 4 * lane); const f32x4 o = v[j] * rstd * m4 + s4;
                o8[64 * j] = (unsigned long long)pk2(o.x, o.y) | ((unsigned long long)pk2(o.z, o.w) << 32); }
        }
    }
    xcd_barrier(bar);

    {
        pg8::Gemm g{XN, WIN_T, T, INW, D}; pg8::StaticOrder So; So.init(T, INW, G, bx);
        EpiIn E{QT, KT, VH, SG, AQ, AK, AV, DEC, LB};
        pg8::gemm_phase<EpiIn, pg8::StaticOrder, true, true>(lds, g, So, E, wave);
    }
    xcd_barrier(bar);

    {   PHASE_TID();
        if (bx < 32) {
            const int b = bx >> 2, h = bx & 3; LAS float* qs = (LAS float*)lds; LAS float* ks = qs + 128; LAS float* dc = ks + 128; LAS float* op = dc + 128;
            const int v = tid & 127, kh = (tid >> 7) & 1, kb = kh * 64;
            float R[64];
#pragma unroll
            for (int k = 0; k < 64; ++k) R[k] = 0.f;
            for (int t = 0; t < S; ++t) {
                const size_t row = (size_t)b * S + t; const bool last = (t & 63) == 63;
                float qv = 0.f, kv = 0.f, dv = 0.f;
                const float vv = bf2f(VH[row * 512 + h * 128 + v]);
                if (tid < 128) { qv = bf2f(QT[row * 512 + h * 128 + tid]); kv = bf2f(KT[row * 512 + h * 128 + tid]); if (last) dv = DEC[(row >> 6) * 512 + h * 128 + tid]; }
                __syncthreads();
                if (tid < 128) { qs[tid] = qv; ks[tid] = kv; if (last) dc[tid] = dv; }
                __syncthreads();
                if (tid < 256) { float o = 0.f;
#pragma unroll
                    for (int k0 = 0; k0 < 64; k0 += 8) {
#pragma unroll
                        for (int k = k0; k < k0 + 8; ++k) { R[k] += ks[kb + k] * vv; o += qs[kb + k] * R[k]; }
                        __builtin_amdgcn_sched_barrier(0); }
                    if (last) {
#pragma unroll
                        for (int k0 = 0; k0 < 64; k0 += 8) {
#pragma unroll
                            for (int k = k0; k < k0 + 8; ++k) R[k] *= dc[kb + k];
                            __builtin_amdgcn_sched_barrier(0); } }
                    op[tid] = o; }
                __syncthreads();
                if (tid < 128) OHG[row * 512 + h * 128 + tid] = (bf16)f2bf(op[tid] + op[128 + tid]);
            }
        }
        __syncthreads();
    }
    {   PHASE_TID();
        LAS float* ps = (LAS float*)(lds + 4096) + wave * 192;
        for (int gid = gw; gid < T * 8; gid += NGW) {
            const int t = gid % S, h = (gid / S) % 8, b = gid / (S * 8); const size_t row = (size_t)b * S + t;
            float q[64];
            { const v4u* qp = (const v4u*)(AQ + row * 512 + h * 64);
#pragma unroll
              for (int c = 0; c < 8; ++c) { const v4u w = qp[c]; q[c * 8 + 0] = bflo(w.x); q[c * 8 + 1] = bfhi(w.x); q[c * 8 + 2] = bflo(w.y); q[c * 8 + 3] = bfhi(w.y); q[c * 8 + 4] = bflo(w.z); q[c * 8 + 5] = bfhi(w.z); q[c * 8 + 6] = bflo(w.w); q[c * 8 + 7] = bfhi(w.w); } }
#pragma unroll 1
            for (int br = 0; br < 3; ++br) {
                const int d = br == 0 ? 1 : (br == 1 ? 4 : 16);
                float sc[3]; float m = -INFINITY;
#pragma unroll
                for (int r = 0; r < 3; ++r) { const int j = r * 64 + lane; const int pos = t - j * d; float v = -INFINITY;
                    if (j < 129 && pos >= 0) { const v4u* kp = (const v4u*)(AK + ((size_t)b * S + pos) * 512 + h * 64); float a = 0.f;
#pragma unroll
                        for (int c = 0; c < 8; ++c) { const v4u w = kp[c];
                            a += q[c * 8 + 0] * bflo(w.x) + q[c * 8 + 1] * bfhi(w.x); a += q[c * 8 + 2] * bflo(w.y) + q[c * 8 + 3] * bfhi(w.y);
                            a += q[c * 8 + 4] * bflo(w.z) + q[c * 8 + 5] * bfhi(w.z); a += q[c * 8 + 6] * bflo(w.w) + q[c * 8 + 7] * bfhi(w.w); }
                        v = a; }
                    sc[r] = v; m = fmaxf(m, v); }
                m = wmax64(m);
                float l = 0.f;
#pragma unroll
                for (int r = 0; r < 3; ++r) { const float p = (sc[r] == -INFINITY) ? 0.f : ex2(sc[r] - m); l += p; ps[r * 64 + lane] = p; }
                l = wsum64(l);
                LDS_WAIT(); asm volatile("" ::: "memory");
                float o = 0.f;
                for (int j = 0; j < 129; ++j) { const int pos = t - j * d; if (pos >= 0) o += ps[j] * bf2f(AV[((size_t)b * S + pos) * 512 + h * 64 + lane]); }
                bf16* AO = (bf16*)(ws + (br == 0 ? WS_ATT0 : br == 1 ? WS_ATT1 : WS_ATT2));
                AO[row * 512 + h * 64 + lane] = (bf16)f2bf(o * rcp(l));
                if (lane == 0) LSE[(size_t)br * T * 8 + row * 8 + h] = m + lg2(l);
                LDS_WAIT(); asm volatile("" ::: "memory");
            }
        }
    }
    xcd_barrier(bar);

    {   PHASE_TID();
        for (int t = gw; t < T; t += NGW) {
            const int c8 = lane * 8;
            {   const v4u ov = *(const v4u*)(OHG + (size_t)t * 512 + c8), sv = *(const v4u*)(SG + (size_t)t * 512 + c8);
                float o[8] = {bflo(ov.x), bfhi(ov.x), bflo(ov.y), bfhi(ov.y), bflo(ov.z), bfhi(ov.z), bflo(ov.w), bfhi(ov.w)};
                const float g[8] = {bflo(sv.x), bfhi(sv.x), bflo(sv.y), bfhi(sv.y), bflo(sv.z), bfhi(sv.z), bflo(sv.w), bfhi(sv.w)};
                float ss = 0.f;
#pragma unroll
                for (int i = 0; i < 8; ++i) ss += o[i] * o[i];
                ss += __shfl_xor(ss, 1); ss += __shfl_xor(ss, 2); ss += __shfl_xor(ss, 4); ss += __shfl_xor(ss, 8);
                const float rstd = rsq(ss * (1.f / 128.f) + EPS);
                const f32x4 n0 = *(const f32x4*)(P_hg_on + (c8 & 127)), n1 = *(const f32x4*)(P_hg_on + (c8 & 127) + 4);
#pragma unroll
                for (int i = 0; i < 4; ++i) { o[i] = o[i] * rstd * n0[i] * g[i]; o[4 + i] = o[4 + i] * rstd * n1[i] * g[4 + i]; }
                v4u w; w.x = pk2(o[0], o[1]); w.y = pk2(o[2], o[3]); w.z = pk2(o[4], o[5]); w.w = pk2(o[6], o[7]);
                *(v4u*)(MIXIN + (size_t)t * D + c8) = w; }
            {   const int h = lane >> 3;
                const float l0 = LSE[(size_t)t * 8 + h], l1 = LSE[(size_t)T * 8 + (size_t)t * 8 + h], l2 = LSE[(size_t)2 * T * 8 + (size_t)t * 8 + h];
                const float mx = fmaxf(l0, fmaxf(l1, l2)); float w0 = ex2(l0 - mx), w1 = ex2(l1 - mx), w2 = ex2(l2 - mx); const float inv = rcp(w0 + w1 + w2); w0 *= inv; w1 *= inv; w2 *= inv;
                const v4u a0 = *(const v4u*)((const bf16*)(ws + WS_ATT0) + (size_t)t * 512 + c8), a1 = *(const v4u*)((const bf16*)(ws + WS_ATT1) + (size_t)t * 512 + c8), a2 = *(const v4u*)((const bf16*)(ws + WS_ATT2) + (size_t)t * 512 + c8);
                float a[8];
                a[0] = w0 * bflo(a0.x) + w1 * bflo(a1.x) + w2 * bflo(a2.x); a[1] = w0 * bfhi(a0.x) + w1 * bfhi(a1.x) + w2 * bfhi(a2.x);
                a[2] = w0 * bflo(a0.y) + w1 * bflo(a1.y) + w2 * bflo(a2.y); a[3] = w0 * bfhi(a0.y) + w1 * bfhi(a1.y) + w2 * bfhi(a2.y);
                a[4] = w0 * bflo(a0.z) + w1 * bflo(a1.z) + w2 * bflo(a2.z); a[5] = w0 * bfhi(a0.z) + w1 * bfhi(a1.z) + w2 * bfhi(a2.z);
                a[6] = w0 * bflo(a0.w) + w1 * bflo(a1.w) + w2 * bflo(a2.w); a[7] = w0 * bfhi(a0.w) + w1 * bfhi(a1.w) + w2 * bfhi(a2.w);
                float ss = 0.f;
#pragma unroll
                for (int i = 0; i < 8; ++i) ss += a[i] * a[i];
                const float rstd = rsq(wsum64(ss) * (1.f / 512.f) + EPS);
                const f32x4 n0 = *(const f32x4*)(P_att_on + c8), n1 = *(const f32x4*)(P_att_on + c8 + 4);
#pragma unroll
                for (int i = 0; i < 4; ++i) { a[i] = a[i] * rstd * n0[i]; a[4 + i] = a[4 + i] * rstd * n1[i]; }
                v4u w; w.x = pk2(a[0], a[1]); w.y = pk2(a[2], a[3]); w.z = pk2(a[4], a[5]); w.w = pk2(a[6], a[7]);
                *(v4u*)(MIXIN + (size_t)t * D + 512 + c8) = w; }
        }
        __syncthreads();
        LAS float* sh2 = (LAS float*)lds;
        for (int i = tid; i < 8 * D; i += NWAVES * 64) sh2[i] = MOD[(i >> 10) * NMOD + 3072 + (i & 1023)];
        __syncthreads();
        const int ncol = NGU / G;
        for (int j = wave; j < ncol; j += NWAVES) { const int n = bx * ncol + j;
            const v4u w0 = *(const v4u*)(WGU_T + (size_t)n * D + lane * 16), w1 = *(const v4u*)(WGU_T + (size_t)n * D + lane * 16 + 8);
            const float wv[16] = {bflo(w0.x), bfhi(w0.x), bflo(w0.y), bfhi(w0.y), bflo(w0.z), bfhi(w0.z), bflo(w0.w), bfhi(w0.w), bflo(w1.x), bfhi(w1.x), bflo(w1.y), bfhi(w1.y), bflo(w1.z), bfhi(w1.z), bflo(w1.w), bfhi(w1.w)};
#pragma unroll
            for (int b = 0; b < 8; ++b) { float s = 0.f;
#pragma unroll
                for (int q4 = 0; q4 < 4; ++q4) { const f32x4 sv = *(const LAS f32x4*)(sh2 + b * D + lane * 16 + q4 * 4); s += wv[q4 * 4] * sv[0] + wv[q4 * 4 + 1] * sv[1] + wv[q4 * 4 + 2] * sv[2] + wv[q4 * 4 + 3] * sv[3]; }
                s = wsum64(s); if (lane == 0) BIAS2[b * NGU + n] = s; }
        }
        __syncthreads();
    }
    xcd_barrier(bar);

    {
        pg8::Gemm g{MIXIN, WOUT_T, T, D, D}; pg8::StaticOrder So; So.init(T, D, G, bx);
        EpiOut E{P_x, P_out, A2, SSQ1, MOD, P_g2};
        pg8::gemm_phase<EpiOut, pg8::StaticOrder, true, true>(lds, g, So, E, wave);
    }
    xcd_barrier(bar);

    {
        pg8::Gemm g{A2, WGU_T, T, NGU, D}; pg8::StaticOrder So; So.init(T, NGU, G, bx);
        EpiGU E{HID, SSQ1, BIAS2};
        pg8::gemm_phase<EpiGU, pg8::StaticOrder, true, true>(lds, g, So, E, wave);
    }
    xcd_barrier(bar);

    {
        pg8::Gemm g{HID, WD_T, T, D, DFF}; pg8::StaticOrder So; So.init(T, D, G, bx);
        EpiDown E{P_out, MOD};
        pg8::gemm_phase<EpiDown, pg8::StaticOrder, true, true>(lds, g, So, E, wave);
    }
    xcd_barrier(bar);

    PHASE_TID();
    for (int row = gw; row < T; row += NGW) {
        GAS f32x4* xr = (GAS f32x4*)(P_out + (size_t)row * D) + lane;
        f32x4 v[4]; float s = 0.f;
#pragma unroll
        for (int j = 0; j < 4; ++j) { v[j] = xr[64 * j]; s += (v[j].x * v[j].x + v[j].y * v[j].y) + (v[j].z * v[j].z + v[j].w * v[j].w); }
        const float rstd = rsq(wsum64(s) * (1.f / D) + EPS);
#pragma unroll
        for (int j = 0; j < 4; ++j) { const f32x4 g4 = *(const f32x4*)(P_gf + 256 * j + 4 * lane); xr[64 * j] = v[j] * rstd * g4; }
    }
}
}

extern "C" void kernel_launch(void* const* d_in, const int* in_sizes, int n_in, void* d_out, int out_size, void* d_ws, size_t ws_size, hipStream_t stream) {
    using namespace mk;
    static int grid = 0;
    if (grid == 0) {
        if (n_in != 14 || in_sizes[0] != T * D || out_size != T * D || ws_size < WS_END) { fprintf(stderr, "kernel_launch: unexpected shapes (n_in %d, in0 %d, out %d, ws %zu); nothing launched\n", n_in, n_in > 0 ? in_sizes[0] : -1, out_size, ws_size); grid = -1; return; }
        int dev = 0, cus = 0, per_cu = 0;
        if (hipGetDevice(&dev) != hipSuccess || hipDeviceGetAttribute(&cus, hipDeviceAttributeMultiprocessorCount, dev) != hipSuccess) { grid = -1; return; }
        if (hipFuncSetAttribute((const void*)mk_fwd, hipFuncAttributeMaxDynamicSharedMemorySize, LDS_BYTES) != hipSuccess) { fprintf(stderr, "kernel_launch: hipFuncSetAttribute failed\n"); grid = -1; return; }
        if (hipOccupancyMaxActiveBlocksPerMultiprocessor(&per_cu, (const void*)mk_fwd, NWAVES * 64, LDS_BYTES) != hipSuccess || per_cu < 1) { fprintf(stderr, "kernel_launch: occupancy query says %d blocks per CU\n", per_cu); per_cu = 1; }
        (void)hipGetLastError();
        grid = cus;
        if (grid != 256) { fprintf(stderr, "kernel_launch: this kernel is laid out for a 256-CU device, found %d CUs; nothing launched\n", grid); grid = -1; return; }
    }
    if (grid < 0) return;
    if (hipMemsetAsync((char*)d_ws + WS_CTL, 0, CTL_ZERO_BYTES, stream) != hipSuccess) { fprintf(stderr, "kernel_launch: hipMemsetAsync failed\n"); return; }
    Args a{};
    for (int i = 0; i < 14; ++i) a.in[i] = (const float*)d_in[i];
    a.out = (float*)d_out; a.ws = (unsigned char*)d_ws;
    hipLaunchKernelGGL(mk_fwd, dim3(grid), dim3(NWAVES * 64), LDS_BYTES, stream, a);
    const hipError_t le = hipPeekAtLastError();
    if (le != hipSuccess) fprintf(stderr, "kernel_launch: launch failed: %s\n", hipGetErrorName(le));
}
```

```cpp
#include <hip/hip_runtime.h>
#include <cstdio>
#include <cstdint>
namespace pg8 {
#define PG8_LAS __attribute__((address_space(3)))
typedef unsigned short bf16_t;
typedef short bf16x8 __attribute__((ext_vector_type(8)));
typedef float f32x4 __attribute__((ext_vector_type(4)));
typedef unsigned u32x4 __attribute__((ext_vector_type(4)));
constexpr int BM = 256, BK = 64, HALF = 128, HTB = HALF * BK * 2  , STAGE_BYTES = 8 * HTB, NXCD = 8, WGM = 8;

__host__ __device__ __forceinline__ int lds_byte(int r, int c) { const int st = (r >> 4) * 2 + (c >> 5), rr = r & 15, cc = c & 31, ob = rr * 64 + cc * 2; return st * 1024 + (ob ^ (((ob >> 9) & 1) << 5)); }
__host__ __device__ __forceinline__ void stage_rc(int b, int& R, int& C) { const int st = b / 1024, sb = b % 1024, swz = sb ^ (((sb >> 9) & 1) << 5); R = (st >> 1) * 16 + swz / 64; C = (st & 1) * 32 + (swz % 64) / 2; }
__host__ __device__ __forceinline__ int perm32(int rho) { const int n = rho >> 4, i = rho & 15; return 8 * (i >> 2) + 4 * n + (i & 3); }

struct Unit { int pm, pn; };
struct Gemm { const bf16_t* A; const bf16_t* Bt; int M, N, K; };

struct StaticOrder {
    int nM, nN, nwg, G, c;
    __host__ __device__ void init(int M, int N, int G_, int c_) { nM = M / BM; nN = N / BM; nwg = nM * nN; G = G_; c = c_; }
    __host__ __device__ bool next(int i, Unit& u) const {
        const long L = (long)i * G + c; if (L >= nwg) return false;
        int wgid = (int)L; { const int q = nwg / NXCD, r = nwg % NXCD, xcd = wgid % NXCD, off = wgid / NXCD; wgid = (xcd < r ? xcd * (q + 1) : r * (q + 1) + (xcd - r) * q) + off; }
        const int nig = WGM * nN, gid = wgid / nig, fm = gid * WGM, gsz = (nM - fm) < WGM ? (nM - fm) : WGM;
        u.pm = fm + ((wgid % nig) % gsz); u.pn = (wgid % nig) / gsz; return true;
    }
    __device__ __forceinline__ void a_ready(const Unit&) const {}
    __device__ __forceinline__ void done(const Unit&) const {}
};

__device__ __forceinline__ unsigned cvt_pk_bf16(float lo, float hi) { unsigned r; asm volatile("v_cvt_pk_bf16_f32 %0, %1, %2" : "=v"(r) : "v"(lo), "v"(hi)); return r; }
typedef float f32x2 __attribute__((ext_vector_type(2)));
template <class Epi, class Sched, bool ALIGN_EPI = false, bool SP2 = false>
__device__ __forceinline__ void gemm_phase(PG8_LAS unsigned char* lds, const Gemm g, const Sched& S, const Epi& E, const int wid_in  ) {
    int lane_o; asm volatile("v_mbcnt_lo_u32_b32 %0, -1, 0\n\tv_mbcnt_hi_u32_b32 %0, -1, %0" : "=&v"(lane_o));
    const int wid = wid_in, lane = lane_o, tid = wid * 64 + lane, wr = wid >> 2, wc = wid & 3, fr = lane & 15, fq = lane >> 4;
    const int K = g.K, nt = K / BK;
    unsigned voffA[2], voffB[2];
#pragma unroll
    for (int i = 0; i < 2; ++i) { int R, C; stage_rc(tid * 16 + i * 8192, R, C); const int Rb = Epi::PERM ? ((R & ~31) + perm32(R & 31)) : R;
        voffA[i] = (unsigned)(R * K + C) * 2u; voffB[i] = (unsigned)(Rb * K + C) * 2u; }
    const size_t kstep = (size_t)(BK * 2);
    const size_t hstep = (size_t)HALF * K * 2;
    const size_t tstep = 2 * hstep;
    const unsigned ldsw = (unsigned)wid * 1024u;
    const int aoff = lds_byte(wr * 64 + fr, fq * 8), boff = lds_byte(wc * 32 + fr, fq * 8);
#define PG8_SA(b, h) (((b) * 2 + (h)) * HTB)
#define PG8_SB(b, h) ((4 + (b) * 2 + (h)) * HTB)
#define PG8_STAGE(bufoff, gbase, voff) do { _Pragma("unroll") for (int _i = 0; _i < 2; ++_i) \
        __builtin_amdgcn_global_load_lds((const unsigned*)((const char*)(gbase) + (voff)[_i]), (PG8_LAS unsigned*)(lds + (bufoff) + ldsw + _i * 8192), 16, 0, 0); } while (0)
#define PG8_LDA(dst, b, h) do { _Pragma("unroll") for (int m = 0; m < 4; ++m) _Pragma("unroll") for (int k = 0; k < 2; ++k) dst[m][k] = *(const PG8_LAS bf16x8*)(lds + PG8_SA(b, h) + aoff + m * 2048 + k * 1024); } while (0)
#define PG8_LDB(dst, b, h) do { _Pragma("unroll") for (int n = 0; n < 2; ++n) _Pragma("unroll") for (int k = 0; k < 2; ++k) dst[n][k] = *(const PG8_LAS bf16x8*)(lds + PG8_SB(b, h) + boff + n * 2048 + k * 1024); } while (0)
#define PG8_MMA(ai, bj, At, Bt) do { __builtin_amdgcn_s_setprio(1); _Pragma("unroll") for (int m = 0; m < 4; ++m) _Pragma("unroll") for (int n = 0; n < 2; ++n) _Pragma("unroll") for (int k = 0; k < 2; ++k) \
        acc[ai][bj][m][n] = __builtin_amdgcn_mfma_f32_16x16x32_bf16(Bt[n][k], At[m][k], acc[ai][bj][m][n], 0, 0, 0); __builtin_amdgcn_s_setprio(0); } while (0)
#define PG8_WAIT_V(n) asm volatile("s_waitcnt vmcnt(" #n ")" ::: "memory")
#define PG8_WAIT_L(n) asm volatile("s_waitcnt lgkmcnt(" #n ")" ::: "memory")
#define PG8_BAR __builtin_amdgcn_s_barrier()
#define PG8_SCHED __builtin_amdgcn_sched_barrier(0)
    Unit cur, nxt; int ui = 0;
    if (!S.next(0, cur)) return;
    f32x4 acc[2][2][4][2];
#pragma unroll
    for (int a = 0; a < 2; ++a)
#pragma unroll
        for (int b = 0; b < 2; ++b)
#pragma unroll
            for (int m = 0; m < 4; ++m)
#pragma unroll
                for (int n = 0; n < 2; ++n) acc[a][b][m][n] = (f32x4){0.f, 0.f, 0.f, 0.f};
    bf16x8 At[4][2], B0[2][2], B1[2][2];
    const char* cA = (const char*)g.A + (size_t)cur.pm * tstep; const char* cB = (const char*)g.Bt + (size_t)cur.pn * tstep;
    S.a_ready(cur);
    if constexpr (SP2) {
        PG8_STAGE(PG8_SB(0, 0), cB, voffB); PG8_STAGE(PG8_SB(0, 1), cB + hstep, voffB); PG8_STAGE(PG8_SA(0, 0), cA, voffA); PG8_STAGE(PG8_SA(0, 1), cA + hstep, voffA);
        if (wr == 1) PG8_BAR;
        PG8_WAIT_V(2); PG8_BAR;
        PG8_STAGE(PG8_SB(1, 0), cB + kstep, voffB); PG8_STAGE(PG8_SA(1, 0), cA + kstep, voffA); PG8_STAGE(PG8_SB(1, 1), cB + hstep + kstep, voffB);
        PG8_WAIT_V(6); PG8_BAR;
    } else {
        PG8_STAGE(PG8_SB(0, 0), cB, voffB); PG8_STAGE(PG8_SA(0, 0), cA, voffA); PG8_STAGE(PG8_SB(0, 1), cB + hstep, voffB); PG8_STAGE(PG8_SA(0, 1), cA + hstep, voffA);
        if (wr == 1) PG8_BAR;
        PG8_WAIT_V(4); PG8_BAR;
        PG8_STAGE(PG8_SB(1, 0), cB + kstep, voffB); PG8_STAGE(PG8_SA(1, 0), cA + kstep, voffA); PG8_STAGE(PG8_SB(1, 1), cB + hstep + kstep, voffB);
        PG8_WAIT_V(6); PG8_BAR;
    }
    for (;;) {
        const bool has_next = S.next(ui + 1, nxt);
        const char* nA = has_next ? (const char*)g.A + (size_t)nxt.pm * tstep : cA; const char* nB = has_next ? (const char*)g.Bt + (size_t)nxt.pn * tstep : cB;
        for (int t = 0; t < nt; t += 2) {
            const bool last = (t == nt - 2);
            const char* a1 = cA + (size_t)(t + 1) * kstep;
            const char* a2 = last ? nA : cA + (size_t)(t + 2) * kstep; const char* b2 = last ? nB : cB + (size_t)(t + 2) * kstep;
            const char* a3 = a2 + kstep; const char* b3 = b2 + kstep;
            if (last && has_next) S.a_ready(nxt);
            if constexpr (SP2) {
            PG8_LDB(B0, 0, 0); PG8_LDB(B1, 0, 1); PG8_SCHED; PG8_LDA(At, 0, 0); PG8_STAGE(PG8_SA(1, 1), a1 + hstep, voffA);
            PG8_WAIT_V(8); PG8_WAIT_L(0); PG8_BAR; PG8_MMA(0, 0, At, B0); PG8_MMA(0, 1, At, B1); PG8_BAR; PG8_SCHED;
            PG8_LDA(At, 0, 1); PG8_STAGE(PG8_SB(0, 0), b2, voffB); PG8_STAGE(PG8_SB(0, 1), b2 + hstep, voffB); PG8_STAGE(PG8_SA(0, 0), a2, voffA);
            PG8_WAIT_V(8); PG8_WAIT_L(0); PG8_BAR; PG8_MMA(1, 0, At, B0); PG8_MMA(1, 1, At, B1); PG8_BAR; PG8_SCHED;
            PG8_LDB(B0, 1, 0); PG8_LDB(B1, 1, 1); PG8_SCHED; PG8_LDA(At, 1, 0); PG8_STAGE(PG8_SA(0, 1), a2 + hstep, voffA);
            PG8_WAIT_V(8); PG8_WAIT_L(0); PG8_BAR; PG8_MMA(0, 0, At, B0); PG8_MMA(0, 1, At, B1); PG8_BAR; PG8_SCHED;
            PG8_LDA(At, 1, 1); PG8_STAGE(PG8_SB(1, 0), b3, voffB); PG8_STAGE(PG8_SB(1, 1), b3 + hstep, voffB); PG8_STAGE(PG8_SA(1, 0), a3, voffA);
            PG8_WAIT_V(8); PG8_WAIT_L(0); PG8_BAR; PG8_MMA(1, 0, At, B0); PG8_MMA(1, 1, At, B1); PG8_BAR; PG8_SCHED;
            } else {
            PG8_LDB(B0, 0, 0); PG8_SCHED; PG8_LDA(At, 0, 0); PG8_STAGE(PG8_SA(1, 1), a1 + hstep, voffA);
            PG8_WAIT_L(8); PG8_BAR; PG8_WAIT_L(0); PG8_MMA(0, 0, At, B0); PG8_BAR; PG8_SCHED;
            PG8_LDB(B1, 0, 1); PG8_STAGE(PG8_SB(0, 0), b2, voffB);
            PG8_BAR; PG8_WAIT_L(0); PG8_MMA(0, 1, At, B1); PG8_BAR;
            PG8_LDA(At, 0, 1); PG8_STAGE(PG8_SA(0, 0), a2, voffA);
            PG8_BAR; PG8_WAIT_L(0); PG8_MMA(1, 0, At, B0); PG8_BAR; PG8_SCHED;
            PG8_STAGE(PG8_SB(0, 1), b2 + hstep, voffB);
            PG8_WAIT_V(6); PG8_BAR; PG8_MMA(1, 1, At, B1); PG8_BAR;
            PG8_LDB(B0, 1, 0); PG8_SCHED; PG8_LDA(At, 1, 0); PG8_STAGE(PG8_SA(0, 1), a2 + hstep, voffA);
            PG8_WAIT_L(8); PG8_BAR; PG8_WAIT_L(0); PG8_MMA(0, 0, At, B0); PG8_BAR; PG8_SCHED;
            PG8_LDB(B1, 1, 1); PG8_STAGE(PG8_SB(1, 0), b3, voffB);
            PG8_BAR; PG8_WAIT_L(0); PG8_MMA(0, 1, At, B1); PG8_BAR;
            PG8_LDA(At, 1, 1); PG8_STAGE(PG8_SA(1, 0), a3, voffA);
            PG8_BAR; PG8_WAIT_L(0); PG8_MMA(1, 0, At, B0); PG8_BAR; PG8_SCHED;
            PG8_STAGE(PG8_SB(1, 1), b3 + hstep, voffB);
            PG8_WAIT_V(6); PG8_BAR; PG8_MMA(1, 1, At, B1); PG8_BAR;
            }
        }
        if constexpr (ALIGN_EPI) { if (wr == 0) PG8_BAR; }
        if constexpr (!Epi::AFTER_DRAIN) { E(acc, cur, wr, wc, fr, fq); S.done(cur); }
        if (!has_next) break;
#pragma unroll
        for (int a = 0; a < 2; ++a)
#pragma unroll
            for (int b = 0; b < 2; ++b)
#pragma unroll
                for (int m = 0; m < 4; ++m)
#pragma unroll
                    for (int n = 0; n < 2; ++n) acc[a][b][m][n] = (f32x4){0.f, 0.f, 0.f, 0.f};
        cur = nxt; cA = nA; cB = nB; ++ui;
        if constexpr (ALIGN_EPI) { if (wr == 1) PG8_BAR; }
    }
    PG8_WAIT_V(0);
    if constexpr (!ALIGN_EPI) { if (wr == 0) PG8_BAR; }
    PG8_BAR;
    if constexpr (Epi::AFTER_DRAIN) { E.fused(acc, cur, wr, wc, fr, fq, lds, wid, lane); S.done(cur); }
#undef PG8_SA
#undef PG8_SB
#undef PG8_STAGE
#undef PG8_LDA
#undef PG8_LDB
#undef PG8_MMA
#undef PG8_WAIT_V
#undef PG8_WAIT_L
#undef PG8_BAR
#undef PG8_SCHED
}
}
#define GAS __attribute__((address_space(1)))
#define LAS __attribute__((address_space(3)))
typedef unsigned short bf16;
typedef unsigned v4u __attribute__((ext_vector_type(4)));
typedef float f32x4 __attribute__((ext_vector_type(4)));
typedef short bf16x8 __attribute__((ext_vector_type(8)));
typedef GAS unsigned gu32;
typedef GAS unsigned long long gu64;
#define RLX_AGENT __ATOMIC_RELAXED, __HIP_MEMORY_SCOPE_AGENT
#define LDS_WAIT() asm volatile("s_waitcnt lgkmcnt(0)" ::: "memory")
#define VM_WAIT() asm volatile("s_waitcnt vmcnt(0)" ::: "memory")
__device__ __forceinline__ unsigned long long rt() { return __builtin_amdgcn_s_memrealtime(); }
__device__ __forceinline__ unsigned f2bf(float f) { unsigned u = __builtin_bit_cast(unsigned, f); return (u + 0x7fffu + ((u >> 16) & 1u)) >> 16; }
__device__ __forceinline__ unsigned pk2(float lo, float hi) { return f2bf(lo) | (f2bf(hi) << 16); }
#define XB_TMO      128
#define XB_XCNT(j)  (256  + 64 * (j))
#define XB_XSUB(j)  (1280 + 64 * (j))
#define XB_XGEN(j)  (2304 + 64 * (j))
#define XB_TOP      3328
#define XB_TOPGEN   3392
#define XCD_BAR_WORDS 3456
#define XB_SPIN_CAP (1u << 24)

__device__ __forceinline__ unsigned xb_ld(unsigned* p)              { return __hip_atomic_load(p, __ATOMIC_RELAXED, __HIP_MEMORY_SCOPE_AGENT); }
__device__ __forceinline__ unsigned xb_add(unsigned* p, unsigned v) { return __hip_atomic_fetch_add(p, v, __ATOMIC_RELAXED, __HIP_MEMORY_SCOPE_AGENT); }
__device__ __forceinline__ unsigned xb_xcc_id() { return (unsigned)__builtin_amdgcn_s_getreg((3 << 11) | 20) & 0xFu; }
#define XB_SPIN(cond, bar) do { unsigned _sp = 0; while (cond) { __builtin_amdgcn_s_sleep(1); \
    if ((++_sp & 255u) == 0u) { if (xb_ld(&(bar)[XB_TMO])) break; if (_sp > XB_SPIN_CAP) { atomicAdd(&(bar)[XB_TMO], 1u); break; } } } } while (0)

struct XcdBarrier {
    unsigned* bar; unsigned x;
    volatile LAS unsigned* st;
};

__device__ __forceinline__ XcdBarrier xcd_barrier_post(unsigned* bar, volatile LAS unsigned* st) {
    XcdBarrier b; b.bar = bar; b.x = xb_xcc_id(); b.st = st;
    if (threadIdx.x == 0) (void)xb_add(&bar[XB_XCNT(b.x)], 1u);
    return b;
}
__device__ __forceinline__ void xcd_barrier_complete(unsigned* bar, unsigned x, unsigned& nloc, unsigned& nx) {
    const unsigned G = gridDim.x * gridDim.y * gridDim.z;
    unsigned sum, cnt, mine, sp = 0u;
    for (;;) {
        sum = 0u; cnt = 0u; mine = 0u;
#pragma unroll
        for (unsigned j = 0; j < 16; ++j) { const unsigned c = xb_ld(&bar[XB_XCNT(j)]); sum += c; cnt += (c > 0u) ? 1u : 0u; mine = (j == x) ? c : mine; }
        if (sum == G) break;
        __builtin_amdgcn_s_sleep(1);
        if ((++sp & 255u) == 0u) { if (xb_ld(&bar[XB_TMO])) break; if (sp > XB_SPIN_CAP) { atomicAdd(&bar[XB_TMO], 1u); break; } }
    }
    nloc = mine > 0u ? mine : 1u; nx = cnt > 0u ? cnt : 1u;
}

__device__ __forceinline__ void xcd_barrier(const XcdBarrier& b) {
    asm volatile("s_waitcnt vmcnt(0)" ::: "memory");
    __syncthreads();
    if (threadIdx.x == 0) {
        unsigned* bar = b.bar;
        __builtin_amdgcn_s_waitcnt(0);
        unsigned nloc = b.st[0], nx = b.st[1];
        if (nloc == 0u) { xcd_barrier_complete(bar, b.x, nloc, nx); b.st[0] = nloc; b.st[1] = nx; }
        const unsigned old = xb_add(&bar[XB_XSUB(b.x)], 1u);
        const unsigned gen = old / nloc;
        if (old + 1u == (gen + 1u) * nloc) {
            __builtin_amdgcn_fence(__ATOMIC_RELEASE, "agent");
            asm volatile("s_waitcnt vmcnt(0)" ::: "memory");
            const unsigned og = xb_add(&bar[XB_TOP], 1u);
            const unsigned tg = og / nx;
            if (og + 1u == (tg + 1u) * nx) xb_add(&bar[XB_TOPGEN], 1u);
            else XB_SPIN(xb_ld(&bar[XB_TOPGEN]) == tg, bar);
            __builtin_amdgcn_fence(__ATOMIC_ACQUIRE, "agent");
            xb_add(&bar[XB_XGEN(b.x)], 1u);
            asm volatile("s_waitcnt vmcnt(0)" ::: "memory");
        } else {
            XB_SPIN(xb_ld(&bar[XB_XGEN(b.x)]) == gen, bar);
            __builtin_amdgcn_fence(__ATOMIC_ACQUIRE, "agent");
            asm volatile("s_waitcnt vmcnt(0)" ::: "memory");
        }
    }
    __syncthreads();
}
namespace mk {
using pg8::f32x4; using pg8::Unit; using pg8::bf16_t; using pg8::u32x4; using pg8::cvt_pk_bf16;
typedef unsigned u32x2 __attribute__((ext_vector_type(2)));
constexpr int B = 8, S = 4096, D = 1024, T = B * S, INW = 3584, DFF = 2816, NMOD = 6144, NGU = 2 * DFF;
constexpr float EPS = 1e-6f, LOG2E = 1.4426950408889634f, QSCALE = 0.125f * 1.4426950408889634f;
#define EPI_LANES() int lane_; asm volatile("v_mbcnt_lo_u32_b32 %0, -1, 0\n\tv_mbcnt_hi_u32_b32 %0, -1, %0" : "=&v"(lane_)); const int wr = wr_, wc = wc_, fr = lane_ & 15, fq = lane_ >> 4; (void)fr_; (void)fq_;
template <int CTRL> __device__ __forceinline__ float dpp_mov0(float v) { return __int_as_float(__builtin_amdgcn_update_dpp(0, __float_as_int(v), CTRL, 0xF, 0xF, false)); }
__device__ __forceinline__ float row_scan16(float s) { s += dpp_mov0<0x111>(s); s += dpp_mov0<0x112>(s); s += dpp_mov0<0x114>(s); s += dpp_mov0<0x118>(s); return s; }
__device__ __forceinline__ float row_sum16(float s) { s += dpp_mov0<0x128>(s); s += dpp_mov0<0x124>(s); s += dpp_mov0<0x122>(s); s += dpp_mov0<0x121>(s); return s; }
__device__ __forceinline__ float ex2(float x) { return __builtin_amdgcn_exp2f(x); }
__device__ __forceinline__ float lg2(float x) { return __builtin_amdgcn_logf(x); }
__device__ __forceinline__ float rcp(float x) { return __builtin_amdgcn_rcpf(x); }
__device__ __forceinline__ float rsq(float x) { return __builtin_amdgcn_rsqf(x); }
__device__ __forceinline__ float silu(float x) { return x * rcp(1.f + ex2(-x * LOG2E)); }
typedef short bf16x8 __attribute__((ext_vector_type(8)));
__device__ __forceinline__ unsigned pk2r(float lo, float hi) { return cvt_pk_bf16(lo, hi); }
__device__ __forceinline__ float bf2f(unsigned short h) { return __uint_as_float(((unsigned)h) << 16); }
__device__ __forceinline__ float bflo(unsigned w) { return __uint_as_float(w << 16); }
__device__ __forceinline__ float bfhi(unsigned w) { return __uint_as_float(w & 0xffff0000u); }

struct EpiIn {
    static constexpr bool PERM = true, AFTER_DRAIN = false;
    bf16_t *QT, *KT, *VH, *SG, *AQ, *AK, *AV; float* DEC; const float* lb;
    __device__ __forceinline__ void operator()(f32x4 (&acc)[2][2][4][2], const Unit& u, int wr_, int wc_, int fr_, int fq_) const {
        EPI_LANES();
        const int pn = u.pn; const unsigned row0 = (unsigned)(u.pm * 256 + wr * 64 + fr);
#ifndef NO_HGRN_EPI
        if (pn < 4) {
            const int cb = pn * 128 + wc * 32 + 8 * fq;
            const f32x4 l0 = *(const f32x4*)(lb + cb), l1 = *(const f32x4*)(lb + cb + 4);
#pragma unroll
            for (int ai = 0; ai < 2; ++ai) {
                const unsigned chunk = (unsigned)(u.pm * 4 + ai * 2 + wr);
#pragma unroll
                for (int n = 0; n < 2; ++n) {
                    float dl[4];
#pragma unroll
                    for (int j = 0; j < 4; ++j) {
                        const float lbv = n == 0 ? l0[j] : l1[j], omlb = 1.f - lbv;
                        float lgv[4], b2[4]; float carry = 0.f;
#pragma unroll
                        for (int m = 0; m < 4; ++m) { const float e = ex2(-acc[ai][1][m][n][j] * LOG2E), sg = rcp(1.f + e); lgv[m] = lg2(lbv + omlb * sg); acc[ai][1][m][n][j] = omlb * (e * sg); }
#pragma unroll
                        for (int m = 0; m < 4; ++m) { const float s = row_scan16(lgv[m]), tot = row_sum16(lgv[m]); b2[m] = carry + s; carry += tot; }
                        dl[j] = ex2(carry);
#pragma unroll
                        for (int m = 0; m < 4; ++m) { acc[ai][0][m][n][j] = silu(acc[ai][0][m][n][j]) * ex2(b2[m]); acc[ai][1][m][n][j] *= ex2(-b2[m]); }
                        __builtin_amdgcn_sched_barrier(0);
                    }
                    *(f32x4*)(DEC + (chunk * 512u + (unsigned)(cb + 4 * n))) = (f32x4){dl[0], dl[1], dl[2], dl[3]};
#pragma unroll
                    for (int m = 0; m < 4; ++m) { const unsigned off = (row0 + ai * 128 + m * 16) * 512u + (unsigned)(cb + 4 * n);
                        const f32x4 q = acc[ai][0][m][n], k = acc[ai][1][m][n];
                        u32x2 w; w.x = cvt_pk_bf16(q[0], q[1]); w.y = cvt_pk_bf16(q[2], q[3]); *(u32x2*)(QT + off) = w;
                        u32x2 kw; kw.x = cvt_pk_bf16(k[0], k[1]); kw.y = cvt_pk_bf16(k[2], k[3]); *(u32x2*)(KT + off) = kw; }
                    __builtin_amdgcn_sched_barrier(0);
                }
            }
        } else
#endif
        {
            const int g = (pn - 4) >> 1; bf16_t* base = g == 0 ? VH : g == 1 ? SG : g == 2 ? AQ : g == 3 ? AK : AV;
            const unsigned col0 = (unsigned)(((pn - 4) & 1) * 256 + wc * 32 + 8 * fq);
#pragma unroll
            for (int ai = 0; ai < 2; ++ai)
#pragma unroll
                for (int m = 0; m < 4; ++m) { bf16_t* rowp = base + ((row0 + ai * 128 + m * 16) * 512u + col0);
#pragma unroll
                    for (int bj = 0; bj < 2; ++bj) { f32x4 v0 = acc[ai][bj][m][0], v1 = acc[ai][bj][m][1];
                        if (g == 1) {
#pragma unroll
                            for (int j = 0; j < 4; ++j) { v0[j] = silu(v0[j]); v1[j] = silu(v1[j]); } }
                        if (g == 2) { v0 = v0 * QSCALE; v1 = v1 * QSCALE; }
                        u32x4 w; w.x = cvt_pk_bf16(v0[0], v0[1]); w.y = cvt_pk_bf16(v0[2], v0[3]); w.z = cvt_pk_bf16(v1[0], v1[1]); w.w = cvt_pk_bf16(v1[2], v1[3]);
                        *(u32x4*)(rowp + bj * 128) = w; } }
        }
    }
};

struct EpiOut {
    static constexpr bool PERM = false, AFTER_DRAIN = false;
    const float* x; float* x1; bf16_t* A2; float* ssq; const float* mod; const float* g2;
    __device__ __forceinline__ void operator()(const f32x4 (&acc)[2][2][4][2], const Unit& u, int wr_, int wc_, int fr_, int fq_) const {
        EPI_LANES();
        const int b = u.pm >> 4, col0 = u.pn * 256 + wc * 32 + 4 * fq, rowb = u.pm * 256 + wr * 64 + fr; const float* modb = mod + b * NMOD;
        float ssr[2][4];
#pragma unroll
        for (int ai = 0; ai < 2; ++ai)
#pragma unroll
            for (int m = 0; m < 4; ++m) ssr[ai][m] = 0.f;
#pragma unroll
        for (int bj = 0; bj < 2; ++bj)
#pragma unroll
            for (int n = 0; n < 2; ++n) { const int c = col0 + bj * 128 + n * 16;
                const f32x4 gate = *(const f32x4*)(modb + 2048 + c), sc2 = *(const f32x4*)(modb + 4096 + c), gg = *(const f32x4*)(g2 + c); const f32x4 mul = gg * (sc2 + 1.0f);
#pragma unroll
                for (int ai = 0; ai < 2; ++ai)
#pragma unroll
                    for (int m = 0; m < 4; ++m) { const size_t off = (size_t)(rowb + ai * 128 + m * 16) * D + c;
                        const f32x4 v = *(const f32x4*)(x + off) + gate * acc[ai][bj][m][n]; *(f32x4*)(x1 + off) = v;
                        ssr[ai][m] += (v[0] * v[0] + v[1] * v[1]) + (v[2] * v[2] + v[3] * v[3]);
                        const f32x4 a = v * mul; u32x2 w; w.x = cvt_pk_bf16(a[0], a[1]); w.y = cvt_pk_bf16(a[2], a[3]); *(u32x2*)(A2 + off) = w; } }
#pragma unroll
        for (int ai = 0; ai < 2; ++ai)
#pragma unroll
            for (int m = 0; m < 4; ++m) { float s = ssr[ai][m]; s += __shfl_xor(s, 16); s += __shfl_xor(s, 32);
                if (fq == 0) ssq[(size_t)(rowb + ai * 128 + m * 16) * 16 + u.pn * 4 + wc] = s; }
    }
};

struct EpiGU {
    static constexpr bool PERM = true, AFTER_DRAIN = false;
    bf16_t* HID; const float* ssq; const float* bias2;
    __device__ __forceinline__ void operator()(const f32x4 (&acc)[2][2][4][2], const Unit& u, int wr_, int wc_, int fr_, int fq_) const {
        EPI_LANES();
        const int b = u.pm >> 4, rowb = u.pm * 256 + wr * 64 + fr; const float* bb = bias2 + b * NGU + u.pn * 256 + wc * 32 + 8 * fq;
        const f32x4 ba0 = *(const f32x4*)(bb), ba1 = *(const f32x4*)(bb + 4), bu0 = *(const f32x4*)(bb + 128), bu1 = *(const f32x4*)(bb + 132);
#pragma unroll
        for (int ai = 0; ai < 2; ++ai)
#pragma unroll
            for (int m = 0; m < 4; ++m) { const int row = rowb + ai * 128 + m * 16; const f32x4* sp = (const f32x4*)(ssq + (size_t)row * 16);
                const f32x4 s0 = sp[0], s1 = sp[1], s2 = sp[2], s3 = sp[3]; const f32x4 st = (s0 + s1) + (s2 + s3);
                const float rstd = rsq(((st[0] + st[1]) + (st[2] + st[3])) * (1.0f / D) + EPS);
                const f32x4 a0 = acc[ai][0][m][0] * rstd + ba0, a1 = acc[ai][0][m][1] * rstd + ba1, u0 = acc[ai][1][m][0] * rstd + bu0, u1 = acc[ai][1][m][1] * rstd + bu1;
                float h[8];
#pragma unroll
                for (int j = 0; j < 4; ++j) { h[j] = silu(a0[j]) * u0[j]; h[4 + j] = silu(a1[j]) * u1[j]; }
                u32x4 w; w.x = cvt_pk_bf16(h[0], h[1]); w.y = cvt_pk_bf16(h[2], h[3]); w.z = cvt_pk_bf16(h[4], h[5]); w.w = cvt_pk_bf16(h[6], h[7]);
                *(u32x4*)(HID + (size_t)row * DFF + u.pn * 128 + wc * 32 + 8 * fq) = w; }
    }
};

struct EpiDown {
    static constexpr bool PERM = false, AFTER_DRAIN = false;
    float* xio; const float* mod;
    __device__ __forceinline__ void operator()(const f32x4 (&acc)[2][2][4][2], const Unit& u, int wr_, int wc_, int fr_, int fq_) const {
        EPI_LANES();
        const int b = u.pm >> 4, col0 = u.pn * 256 + wc * 32 + 4 * fq, rowb = u.pm * 256 + wr * 64 + fr; const float* modb = mod + b * NMOD;
#pragma unroll
        for (int bj = 0; bj < 2; ++bj)
#pragma unroll
            for (int n = 0; n < 2; ++n) { const int c = col0 + bj * 128 + n * 16; const f32x4 gate = *(const f32x4*)(modb + 5120 + c);
#pragma unroll
                for (int ai = 0; ai < 2; ++ai)
#pragma unroll
                    for (int m = 0; m < 4; ++m) { const size_t off = (size_t)(rowb + ai * 128 + m * 16) * D + c; *(f32x4*)(xio + off) = *(const f32x4*)(xio + off) + gate * acc[ai][bj][m][n]; } }
    }
};
}
namespace mk {
constexpr int NWAVES = 8;
constexpr size_t MiB = 1u << 20;
constexpr size_t WS_CTL = 0, CTL_ZERO_BYTES = 64 * 1024;
constexpr size_t WS_MODP = 1 * MiB;
constexpr size_t WS_MOD = 3 * MiB, WS_LB = WS_MOD + 256 * 1024, WS_BIAS2 = WS_MOD + 512 * 1024;
constexpr size_t WS_WIN = 4 * MiB, WS_WOUT = 11 * MiB, WS_WGU = 13 * MiB, WS_WD = 24 * MiB;
constexpr size_t WS_DEC = 30 * MiB, WS_LSE = 31 * MiB, WS_SSQ1 = 34 * MiB;
constexpr size_t WS_BUFA = 40 * MiB;
constexpr size_t WS_BUFB = 104 * MiB;
constexpr size_t WS_R = 168 * MiB;
constexpr size_t WS_QT = WS_R, WS_KT = WS_R + 32 * MiB, WS_VH = WS_R + 64 * MiB, WS_SG = WS_R + 96 * MiB, WS_AQ = WS_R + 128 * MiB, WS_AK = WS_R + 160 * MiB, WS_AV = WS_R + 192 * MiB;
constexpr size_t WS_OHG = WS_BUFA, WS_ATT0 = WS_BUFA + 32 * MiB, WS_ATT1 = WS_R + 224 * MiB, WS_ATT2 = WS_R + 256 * MiB;
constexpr size_t WS_HID = WS_R;
constexpr size_t WS_END = WS_R + 288 * MiB;
constexpr int CW_BAR = 4096;
constexpr int RING_BYTES = 131072, LDSCTL_OFF = RING_BYTES, MISC_OFF = LDSCTL_OFF + 320, LDS_BYTES = 147456;

__device__ __forceinline__ const float* karg_ptr(int i) {
    asm volatile("" : "+s"(i));
    typedef const float* cfp;
    const __attribute__((address_space(4))) cfp* ka = (const __attribute__((address_space(4))) cfp*)__builtin_amdgcn_kernarg_segment_ptr();
    return ka[i];
}

__device__ __forceinline__ void transpose_item(const float* W, int K, int N, bf16* WT, int mode, LAS float* scr, int item, int lane) {
    const int nblk = N / 32, kb = item / nblk, nb = item % nblk, k0 = 64 * kb, n0 = 32 * nb;
    int r0 = n0;
    if (mode == 1) { if (n0 < 512) r0 = (n0 >> 7) * 256 + (n0 & 127); else if (n0 < 1024) r0 = ((n0 - 512) >> 7) * 256 + 128 + (n0 & 127); }
    if (mode == 2) { if (n0 < DFF) r0 = (n0 >> 7) * 256 + (n0 & 127); else r0 = ((n0 - DFF) >> 7) * 256 + 128 + ((n0 - DFF) & 127); }
#pragma unroll 8
    for (int i = 0; i < 32; ++i) { const int kk = 2 * i + (lane >> 5); scr[kk * 33 + (lane & 31)] = W[(size_t)(k0 + kk) * N + n0 + (lane & 31)]; }
    LDS_WAIT(); asm volatile("" ::: "memory");
    const int c = lane & 7;
#pragma unroll
    for (int j = 0; j < 4; ++j) { const int n = (lane >> 3) + 8 * j; const LAS float* s = scr + (8 * c) * 33 + n;
        v4u o; o.x = pk2(s[0 * 33], s[1 * 33]); o.y = pk2(s[2 * 33], s[3 * 33]); o.z = pk2(s[4 * 33], s[5 * 33]); o.w = pk2(s[6 * 33], s[7 * 33]);
        *(GAS v4u*)(WT + (size_t)(r0 + n) * K + k0 + 8 * c) = o; }
    LDS_WAIT(); asm volatile("" ::: "memory");
}
__device__ __forceinline__ void mod_partial(const float* Pc, const float* Pw_ada, float* modp, LAS float* scr, int it, int lane) {
    const int cg = it % 96, ks = it / 96, n = cg * 64 + lane;
#pragma unroll
    for (int i = 0; i < 16; ++i) { const int idx = i * 64 + lane, kk = idx & 127, b = idx >> 7; scr[kk * 8 + b] = silu(Pc[b * D + ks * 128 + kk]); }
    LDS_WAIT(); asm volatile("" ::: "memory");
    float acc[8];
#pragma unroll
    for (int b = 0; b < 8; ++b) acc[b] = 0.f;
    const float* wp = Pw_ada + (size_t)(ks * 128) * NMOD + n;
#pragma unroll 16
    for (int kk = 0; kk < 128; ++kk) { const float w = wp[(size_t)kk * NMOD]; const f32x4 c0 = *(const LAS f32x4*)(scr + kk * 8), c1 = *(const LAS f32x4*)(scr + kk * 8 + 4);
        acc[0] += c0[0] * w; acc[1] += c0[1] * w; acc[2] += c0[2] * w; acc[3] += c0[3] * w; acc[4] += c1[0] * w; acc[5] += c1[1] * w; acc[6] += c1[2] * w; acc[7] += c1[3] * w; }
#pragma unroll
    for (int b = 0; b < 8; ++b) modp[(size_t)(ks * 8 + b) * NMOD + n] = acc[b];
    LDS_WAIT(); asm volatile("" ::: "memory");
}
__device__ __forceinline__ float wsum64(float v) {
#pragma unroll
    for (int o = 1; o < 64; o <<= 1) v += __shfl_xor(v, o);
    return v;
}
__device__ __forceinline__ float wmax64(float v) {
#pragma unroll
    for (int o = 1; o < 64; o <<= 1) v = fmaxf(v, __shfl_xor(v, o));
    return v;
}

typedef short s16x4v __attribute__((ext_vector_type(4)));
struct AttU { int b, h, dsh, r, n, br; };
__device__ __forceinline__ AttU att_decode(int g) {
    AttU U; const int bh = g / 96, u = g % 96; U.b = bh >> 3; U.h = bh & 7;
    if (u < 32) { U.dsh = 0; U.r = 0; U.n = u; U.br = 0; }
    else if (u < 64) { U.dsh = 2; U.r = (u - 32) >> 3; U.n = (u - 32) & 7; U.br = 1; }
    else { U.dsh = 4; U.r = (u - 64) >> 1; U.n = (u - 64) & 1; U.br = 2; }
    return U;
}
__device__ __forceinline__ void att_dma(LAS unsigned char* lds, int bufo, const bf16* AK, const bf16* AV, const AttU& U, int wave, int lane) {
    const int gch = (lane & 7) ^ (lane >> 3);
#pragma unroll
    for (int pi = 0; pi < 4; ++pi) { const int piece = wave + 8 * pi, row = piece * 8 + (lane >> 3); int m = 128 * (U.n - 1) + row; if (m < 0) m += 128;
        const size_t eoff = ((size_t)U.b * S + (size_t)((m << U.dsh) + U.r)) * 512 + U.h * 64 + gch * 8;
        __builtin_amdgcn_global_load_lds((const unsigned*)(AK + eoff), (LAS unsigned*)(lds + bufo + piece * 1024), 16, 0, 0);
        __builtin_amdgcn_global_load_lds((const unsigned*)(AV + eoff), (LAS unsigned*)(lds + bufo + 32768 + piece * 1024), 16, 0, 0); }
}
__device__ __forceinline__ void attn_units(LAS unsigned char* lds, const bf16* AQ, const bf16* AK, const bf16* AV, unsigned char* ws, float* LSE, int wave, int lane, int glo, int ghi) {
    const int i16 = lane & 15, g4 = lane >> 4;
    AttU U = att_decode(glo);
    att_dma(lds, 0, AK, AV, U, wave, lane);
    bf16x8 qn0, qn1;
    { const bf16* qp = AQ + (((size_t)U.b * S + (size_t)(((128 * U.n + 16 * wave + i16) << U.dsh) + U.r)) * 512 + U.h * 64 + 8 * g4); qn0 = *(const bf16x8*)qp; qn1 = *(const bf16x8*)(qp + 32); }
    for (int gu = glo; gu < ghi; ++gu) {
        const int cur = (gu - glo) & 1; const AttU C = U; const bf16x8 qf0 = qn0, qf1 = qn1;
        asm volatile("s_waitcnt vmcnt(0)" ::: "memory");
        __syncthreads();
        if (gu + 1 < ghi) { U = att_decode(gu + 1); att_dma(lds, (cur ^ 1) * 65536, AK, AV, U, wave, lane);
            const bf16* qp = AQ + (((size_t)U.b * S + (size_t)(((128 * U.n + 16 * wave + i16) << U.dsh) + U.r)) * 512 + U.h * 64 + 8 * g4); qn0 = *(const bf16x8*)qp; qn1 = *(const bf16x8*)(qp + 32); }
        const LAS unsigned char* Kb = lds + cur * 65536; const LAS unsigned char* Vb = Kb + 32768;
        f32x4 st[9];
#pragma unroll
        for (int t = 0; t < 9; ++t) { const int R = 16 * (wave + t) + i16; const LAS unsigned char* kp = Kb + R * 128;
            const bf16x8 a0 = *(const LAS bf16x8*)(kp + ((g4 ^ (R & 7)) << 4)), a1 = *(const LAS bf16x8*)(kp + (((g4 + 4) ^ (R & 7)) << 4));
            f32x4 z = {0.f, 0.f, 0.f, 0.f};
            z = __builtin_amdgcn_mfma_f32_16x16x32_bf16(a0, qf0, z, 0, 0, 0); st[t] = __builtin_amdgcn_mfma_f32_16x16x32_bf16(a1, qf1, z, 0, 0, 0); }
        const int qi = 16 * wave + i16; const float NEG = -INFINITY;
#pragma unroll
        for (int reg = 0; reg < 4; ++reg) { const int kj0 = 16 * wave + 4 * g4 + reg; if (kj0 < qi) st[0][reg] = NEG; if (kj0 + 128 > qi + 128) st[8][reg] = NEG; }
        if (C.n == 0) {
#pragma unroll
            for (int t = 0; t < 8; ++t)
#pragma unroll
                for (int reg = 0; reg < 4; ++reg) { if (16 * (wave + t) + 4 * g4 + reg < 128) st[t][reg] = NEG; } }
        float mx = st[0][0];
#pragma unroll
        for (int t = 0; t < 9; ++t)
#pragma unroll
            for (int reg = 0; reg < 4; ++reg) mx = fmaxf(mx, st[t][reg]);
        mx = fmaxf(mx, __shfl_xor(mx, 16)); mx = fmaxf(mx, __shfl_xor(mx, 32));
        float l = 0.f;
#pragma unroll
        for (int t = 0; t < 9; ++t)
#pragma unroll
            for (int reg = 0; reg < 4; ++reg) { const float pv = ex2(st[t][reg] - mx); st[t][reg] = pv; l += pv; }
        l += __shfl_xor(l, 16); l += __shfl_xor(l, 32);
        f32x4 o[4];
#pragma unroll
        for (int et = 0; et < 4; ++et) o[et] = (f32x4){0.f, 0.f, 0.f, 0.f};
#pragma unroll
        for (int ks = 0; ks < 5; ++ks) {
            const int ta = 2 * ks, tb = (ks < 4) ? 2 * ks + 1 : 2 * ks;
            v4u pw; pw.x = pk2r(st[ta][0], st[ta][1]); pw.y = pk2r(st[ta][2], st[ta][3]);
            if (ks < 4) { pw.z = pk2r(st[tb][0], st[tb][1]); pw.w = pk2r(st[tb][2], st[tb][3]); } else { pw.z = 0u; pw.w = 0u; }
            const bf16x8 pf = __builtin_bit_cast(bf16x8, pw);
            const int Ra = 16 * (wave + ta) + 4 * g4 + (i16 >> 2), Rb = 16 * (wave + tb) + 4 * g4 + (i16 >> 2);
#pragma unroll
            for (int et = 0; et < 4; ++et) { const int ch = 2 * et + ((i16 & 3) >> 1), bo = (i16 & 1) * 8;
                const s16x4v va = __builtin_amdgcn_ds_read_tr16_b64_v4i16((LAS s16x4v*)(Vb + Ra * 128 + ((ch ^ (Ra & 7)) << 4) + bo));
                const s16x4v vb = __builtin_amdgcn_ds_read_tr16_b64_v4i16((LAS s16x4v*)(Vb + Rb * 128 + ((ch ^ (Rb & 7)) << 4) + bo));
                const bf16x8 vf = {va[0], va[1], va[2], va[3], vb[0], vb[1], vb[2], vb[3]};
                o[et] = __builtin_amdgcn_mfma_f32_16x16x32_bf16(vf, pf, o[et], 0, 0, 0); }
        }
        const float il = rcp(l);
        const size_t orow = (size_t)C.b * S + (size_t)(((128 * C.n + qi) << C.dsh) + C.r);
        bf16* AO = (bf16*)(ws + (C.br == 0 ? WS_ATT0 : C.br == 1 ? WS_ATT1 : WS_ATT2)) + orow * 512 + C.h * 64 + 4 * g4;
#pragma unroll
        for (int et = 0; et < 4; ++et) { u32x2 w; w.x = pk2r(o[et][0] * il, o[et][1] * il); w.y = pk2r(o[et][2] * il, o[et][3] * il); *(u32x2*)(AO + 16 * et) = w; }
        if (g4 == 0) LSE[(size_t)C.br * T * 8 + orow * 8 + C.h] = mx + lg2(l);
    }
    __syncthreads();
}

struct Args { const float* in[14]; float* out; unsigned char* ws; };
__global__ void __launch_bounds__(NWAVES * 64, 2) mk_fwd(Args args) {
    extern __shared__ __attribute__((aligned(16))) unsigned char lds_raw[];
    LAS unsigned char* lds = (LAS unsigned char*)lds_raw;
    volatile LAS unsigned* MISC = (volatile LAS unsigned*)(lds + MISC_OFF);
    const int wave = __builtin_amdgcn_readfirstlane(threadIdx.x >> 6);
    const int G = gridDim.x, bx = blockIdx.x; const int vcu = (G % 8 == 0) ? (bx % 8) * (G / 8) + bx / 8 : bx;
    const int gw = vcu * NWAVES + wave, NGW = G * NWAVES;
    (void)args;
#define INP(i) karg_ptr(i)
#define P_x INP(0)
#define P_c INP(1)
#define P_w_ada INP(2)
#define P_b_ada INP(3)
#define P_g1 INP(4)
#define P_w_in INP(5)
#define P_lbl INP(6)
#define P_hg_on INP(7)
#define P_att_on INP(8)
#define P_w_out INP(9)
#define P_g2 INP(10)
#define P_w_gu INP(11)
#define P_w_down INP(12)
#define P_gf INP(13)
#define P_out ((float*)INP(14))
    unsigned char* const ws = (unsigned char*)INP(15);
    gu32* ctl = (gu32*)(ws + WS_CTL);
#define MODP ((float*)(ws + WS_MODP))
#define MOD ((float*)(ws + WS_MOD))
#define LB ((float*)(ws + WS_LB))
#define BIAS2 ((float*)(ws + WS_BIAS2))
#define WIN_T ((bf16*)(ws + WS_WIN))
#define WOUT_T ((bf16*)(ws + WS_WOUT))
#define WGU_T ((bf16*)(ws + WS_WGU))
#define WD_T ((bf16*)(ws + WS_WD))
#define DEC ((float*)(ws + WS_DEC))
#define LSE ((float*)(ws + WS_LSE))
#define SSQ1 ((float*)(ws + WS_SSQ1))
#define XN ((bf16*)(ws + WS_BUFA))
#define A2 ((bf16*)(ws + WS_BUFA))
#define MIXIN ((bf16*)(ws + WS_BUFB))
#define QT ((bf16*)(ws + WS_QT))
#define KT ((bf16*)(ws + WS_KT))
#define VH ((bf16*)(ws + WS_VH))
#define SG ((bf16*)(ws + WS_SG))
#define AQ ((bf16*)(ws + WS_AQ))
#define AK ((bf16*)(ws + WS_AK))
#define AV ((bf16*)(ws + WS_AV))
#define OHG ((bf16*)(ws + WS_OHG))
#define HID ((bf16*)(ws + WS_HID))
#define PHASE_TID() int lane; asm volatile("v_mbcnt_lo_u32_b32 %0, -1, 0\n\tv_mbcnt_hi_u32_b32 %0, -1, %0" : "=&v"(lane)); const int tid = wave * 64 + lane; (void)tid;

    for (int u = threadIdx.x; u < (LDS_BYTES - LDSCTL_OFF) / 4; u += NWAVES * 64) ((LAS unsigned*)(lds + LDSCTL_OFF))[u] = 0u;
    __syncthreads();
    XcdBarrier bar = xcd_barrier_post((unsigned*)(ctl + CW_BAR), MISC + 8);

    {   PHASE_TID();
        LAS float* scr = (LAS float*)(lds + wave * 16384);
        constexpr int I_MOD = 768, I_IN = 16 * (INW / 32), I_OUT = 16 * (D / 32), I_GU = 16 * (NGU / 32), I_DN = (DFF / 64) * (D / 32);
        constexpr int NTASK = I_MOD + I_IN + I_OUT + I_GU + I_DN + 1;
        for (int it = gw; it < NTASK; it += NGW) {
            int r = it;
            if (r < I_MOD) { mod_partial(P_c, P_w_ada, MODP, scr, r, lane); continue; } r -= I_MOD;
            if (r < I_IN) { transpose_item(P_w_in, D, INW, WIN_T, 1, scr, r, lane); continue; } r -= I_IN;
            if (r < I_OUT) { transpose_item(P_w_out, D, D, WOUT_T, 0, scr, r, lane); continue; } r -= I_OUT;
            if (r < I_GU) { transpose_item(P_w_gu, D, NGU, WGU_T, 2, scr, r, lane); continue; } r -= I_GU;
            if (r < I_DN) { transpose_item(P_w_down, DFF, D, WD_T, 0, scr, r, lane); continue; }
#pragma unroll
            for (int i = 0; i < 8; ++i) { const int j = lane + 64 * i; LB[j] = rcp(1.f + ex2((P_lbl[512 + j] - P_lbl[j]) * LOG2E)); }
        }
    }
    xcd_barrier(bar);

    {   PHASE_TID();
        LAS float* ms = (LAS float*)lds; LAS float* sh = ms + D;
        if (tid < 192) { const int idx = bx * 192 + tid; const int b = idx / NMOD, n = idx % NMOD; float v = P_b_ada[n];
#pragma unroll
            for (int ks = 0; ks < 8; ++ks) v += MODP[(size_t)(ks * 8 + b) * NMOD + n];
            MOD[idx] = v; }
        const int rows_per = T / G, row0 = bx * rows_per, b = row0 / S;
#pragma unroll
        for (int i = 0; i < 2; ++i) { const int k = tid + 512 * i; float s1 = P_b_ada[k], c1 = P_b_ada[1024 + k];
#pragma unroll
            for (int ks = 0; ks < 8; ++ks) { s1 += MODP[(size_t)(ks * 8 + b) * NMOD + k]; c1 += MODP[(size_t)(ks * 8 + b) * NMOD + 1024 + k]; }
            ms[k] = P_g1[k] * (1.f + c1); sh[k] = s1; }
        __syncthreads();
        for (int r = wave; r < rows_per; r += NWAVES) {
            const int row = row0 + r; const GAS f32x4* xr = (const GAS f32x4*)(P_x + (size_t)row * D) + lane;
            f32x4 v[4]; float s = 0.f;
#pragma unroll
            for (int j = 0; j < 4; ++j) { v[j] = xr[64 * j]; s += (v[j].x * v[j].x + v[j].y * v[j].y) + (v[j].z * v[j].z + v[j].w * v[j].w); }
            const float rstd = rsq(wsum64(s) * (1.f / D) + EPS);
            GAS unsigned long long* o8 = (GAS unsigned long long*)(XN + (size_t)row * D) + lane;
#pragma unroll
            for (int j = 0; j < 4; ++j) { const f32x4 m4 = *(const LAS f32x4*)(ms + 256 * j + 4 * lane), s4 = *(const LAS f32x4*)(sh + 256 * j + 4 * lane); const f32x4 o = v[j] * rstd * m4 + s4;
                o8[64 * j] = (unsigned long long)pk2(o.x, o.y) | ((unsigned long long)pk2(o.z, o.w) << 32); }
        }
    }
    xcd_barrier(bar);

    {
        pg8::Gemm g{XN, WIN_T, T, INW, D}; pg8::StaticOrder So; So.init(T, INW, G, bx);
        EpiIn E{QT, KT, VH, SG, AQ, AK, AV, DEC, LB};
        pg8::gemm_phase<EpiIn, pg8::StaticOrder, true, true>(lds, g, So, E, wave);
    }
    xcd_barrier(bar);

    {   PHASE_TID();
        if (bx < 32) {
            const int b = bx >> 2, h = bx & 3; LAS float* qs = (LAS float*)lds; LAS float* ks = qs + 128; LAS float* dc = ks + 128; LAS float* op = dc + 128;
            const int v = tid & 127, kh = (tid >> 7) & 1, kb = kh * 64;
            float R[64];
#pragma unroll
            for (int k = 0; k < 64; ++k) R[k] = 0.f;
            for (int t = 0; t < S; ++t) {
                const size_t row = (size_t)b * S + t; const bool last = (t & 63) == 63;
                float qv = 0.f, kv = 0.f, dv = 0.f;
                const float vv = bf2f(VH[row * 512 + h * 128 + v]);
                if (tid < 128) { qv = bf2f(QT[row * 512 + h * 128 + tid]); kv = bf2f(KT[row * 512 + h * 128 + tid]); if (last) dv = DEC[(row >> 6) * 512 + h * 128 + tid]; }
                __syncthreads();
                if (tid < 128) { qs[tid] = qv; ks[tid] = kv; if (last) dc[tid] = dv; }
                __syncthreads();
                if (tid < 256) { float o = 0.f;
#pragma unroll
                    for (int k0 = 0; k0 < 64; k0 += 8) {
#pragma unroll
                        for (int k = k0; k < k0 + 8; ++k) { R[k] += ks[kb + k] * vv; o += qs[kb + k] * R[k]; }
                        __builtin_amdgcn_sched_barrier(0); }
                    if (last) {
#pragma unroll
                        for (int k0 = 0; k0 < 64; k0 += 8) {
#pragma unroll
                            for (int k = k0; k < k0 + 8; ++k) R[k] *= dc[kb + k];
                            __builtin_amdgcn_sched_barrier(0); } }
                    op[tid] = o; }
                __syncthreads();
                if (tid < 128) OHG[row * 512 + h * 128 + tid] = (bf16)f2bf(op[tid] + op[128 + tid]);
            }
        }
        __syncthreads();
    }
    {   PHASE_TID();
        attn_units(lds, AQ, AK, AV, ws, LSE, wave, lane, vcu * 24, vcu * 24 + 24);
    }
    xcd_barrier(bar);

    {   PHASE_TID();
        for (int t = gw; t < T; t += NGW) {
            const int c8 = lane * 8;
            {   const v4u ov = *(const v4u*)(OHG + (size_t)t * 512 + c8), sv = *(const v4u*)(SG + (size_t)t * 512 + c8);
                float o[8] = {bflo(ov.x), bfhi(ov.x), bflo(ov.y), bfhi(ov.y), bflo(ov.z), bfhi(ov.z), bflo(ov.w), bfhi(ov.w)};
                const float g[8] = {bflo(sv.x), bfhi(sv.x), bflo(sv.y), bfhi(sv.y), bflo(sv.z), bfhi(sv.z), bflo(sv.w), bfhi(sv.w)};
                float ss = 0.f;
#pragma unroll
                for (int i = 0; i < 8; ++i) ss += o[i] * o[i];
                ss += __shfl_xor(ss, 1); ss += __shfl_xor(ss, 2); ss += __shfl_xor(ss, 4); ss += __shfl_xor(ss, 8);
                const float rstd = rsq(ss * (1.f / 128.f) + EPS);
                const f32x4 n0 = *(const f32x4*)(P_hg_on + (c8 & 127)), n1 = *(const f32x4*)(P_hg_on + (c8 & 127) + 4);
#pragma unroll
                for (int i = 0; i < 4; ++i) { o[i] = o[i] * rstd * n0[i] * g[i]; o[4 + i] = o[4 + i] * rstd * n1[i] * g[4 + i]; }
                v4u w; w.x = pk2(o[0], o[1]); w.y = pk2(o[2], o[3]); w.z = pk2(o[4], o[5]); w.w = pk2(o[6], o[7]);
                *(v4u*)(MIXIN + (size_t)t * D + c8) = w; }
            {   const int h = lane >> 3;
                const float l0 = LSE[(size_t)t * 8 + h], l1 = LSE[(size_t)T * 8 + (size_t)t * 8 + h], l2 = LSE[(size_t)2 * T * 8 + (size_t)t * 8 + h];
                const float mx = fmaxf(l0, fmaxf(l1, l2)); float w0 = ex2(l0 - mx), w1 = ex2(l1 - mx), w2 = ex2(l2 - mx); const float inv = rcp(w0 + w1 + w2); w0 *= inv; w1 *= inv; w2 *= inv;
                const v4u a0 = *(const v4u*)((const bf16*)(ws + WS_ATT0) + (size_t)t * 512 + c8), a1 = *(const v4u*)((const bf16*)(ws + WS_ATT1) + (size_t)t * 512 + c8), a2 = *(const v4u*)((const bf16*)(ws + WS_ATT2) + (size_t)t * 512 + c8);
                float a[8];
                a[0] = w0 * bflo(a0.x) + w1 * bflo(a1.x) + w2 * bflo(a2.x); a[1] = w0 * bfhi(a0.x) + w1 * bfhi(a1.x) + w2 * bfhi(a2.x);
                a[2] = w0 * bflo(a0.y) + w1 * bflo(a1.y) + w2 * bflo(a2.y); a[3] = w0 * bfhi(a0.y) + w1 * bfhi(a1.y) + w2 * bfhi(a2.y);
                a[4] = w0 * bflo(a0.z) + w1 * bflo(a1.z) + w2 * bflo(a2.z); a[5] = w0 * bfhi(a0.z) + w1 * bfhi(a1.z) + w2 * bfhi(a2.z);
                a[6] = w0 * bflo(a0.w) + w1 * bflo(a1.w) + w2 * bflo(a2.w); a[7] = w0 * bfhi(a0.w) + w1 * bfhi(a1.w) + w2 * bfhi(a2.w);
                float ss = 0.f;
#pragma unroll
                for (int i = 0; i < 8; ++i) ss += a[i] * a[i];
                const float rstd = rsq(wsum64(ss) * (1.f / 512.f) + EPS);
                const f32x4 n0 = *(const f32x4*)(P_att_on + c8), n1 = *(const f32x4*)(P_att_on + c8 + 4);
#pragma unroll
                for (int i = 0; i < 4; ++i) { a[i] = a[i] * rstd * n0[i]; a[4 + i] = a[4 + i] * rstd * n1[i]; }
                v4u w; w.x = pk2(a[0], a[1]); w.y = pk2(a[2], a[3]); w.z = pk2(a[4], a[5]); w.w = pk2(a[6], a[7]);
                *(v4u*)(MIXIN + (size_t)t * D + 512 + c8) = w; }
        }
        __syncthreads();
        LAS float* sh2 = (LAS float*)lds;
        for (int i = tid; i < 8 * D; i += NWAVES * 64) sh2[i] = MOD[(i >> 10) * NMOD + 3072 + (i & 1023)];
        __syncthreads();
        const int ncol = NGU / G;
        for (int j = wave; j < ncol; j += NWAVES) { const int n = bx * ncol + j;
            const v4u w0 = *(const v4u*)(WGU_T + (size_t)n * D + lane * 16), w1 = *(const v4u*)(WGU_T + (size_t)n * D + lane * 16 + 8);
            const float wv[16] = {bflo(w0.x), bfhi(w0.x), bflo(w0.y), bfhi(w0.y), bflo(w0.z), bfhi(w0.z), bflo(w0.w), bfhi(w0.w), bflo(w1.x), bfhi(w1.x), bflo(w1.y), bfhi(w1.y), bflo(w1.z), bfhi(w1.z), bflo(w1.w), bfhi(w1.w)};
#pragma unroll
            for (int b = 0; b < 8; ++b) { float s = 0.f;
#pragma unroll
                for (int q4 = 0; q4 < 4; ++q4) { const f32x4 sv = *(const LAS f32x4*)(sh2 + b * D + lane * 16 + q4 * 4); s += wv[q4 * 4] * sv[0] + wv[q4 * 4 + 1] * sv[1] + wv[q4 * 4 + 2] * sv[2] + wv[q4 * 4 + 3] * sv[3]; }
                s = wsum64(s); if (lane == 0) BIAS2[b * NGU + n] = s; }
        }
        __syncthreads();
    }
    xcd_barrier(bar);

    {
        pg8::Gemm g{MIXIN, WOUT_T, T, D, D}; pg8::StaticOrder So; So.init(T, D, G, bx);
        EpiOut E{P_x, P_out, A2, SSQ1, MOD, P_g2};
        pg8::gemm_phase<EpiOut, pg8::StaticOrder, true, true>(lds, g, So, E, wave);
    }
    xcd_barrier(bar);

    {
        pg8::Gemm g{A2, WGU_T, T, NGU, D}; pg8::StaticOrder So; So.init(T, NGU, G, bx);
        EpiGU E{HID, SSQ1, BIAS2};
        pg8::gemm_phase<EpiGU, pg8::StaticOrder, true, true>(lds, g, So, E, wave);
    }
    xcd_barrier(bar);

    {
        pg8::Gemm g{HID, WD_T, T, D, DFF}; pg8::StaticOrder So; So.init(T, D, G, bx);
        EpiDown E{P_out, MOD};
        pg8::gemm_phase<EpiDown, pg8::StaticOrder, true, true>(lds, g, So, E, wave);
    }
    xcd_barrier(bar);

    PHASE_TID();
    for (int row = gw; row < T; row += NGW) {
        GAS f32x4* xr = (GAS f32x4*)(P_out + (size_t)row * D) + lane;
        f32x4 v[4]; float s = 0.f;
#pragma unroll
        for (int j = 0; j < 4; ++j) { v[j] = xr[64 * j]; s += (v[j].x * v[j].x + v[j].y * v[j].y) + (v[j].z * v[j].z + v[j].w * v[j].w); }
        const float rstd = rsq(wsum64(s) * (1.f / D) + EPS);
#pragma unroll
        for (int j = 0; j < 4; ++j) { const f32x4 g4 = *(const f32x4*)(P_gf + 256 * j + 4 * lane); xr[64 * j] = v[j] * rstd * g4; }
    }
}
}

extern "C" void kernel_launch(void* const* d_in, const int* in_sizes, int n_in, void* d_out, int out_size, void* d_ws, size_t ws_size, hipStream_t stream) {
    using namespace mk;
    static int grid = 0;
    if (grid == 0) {
        if (n_in != 14 || in_sizes[0] != T * D || out_size != T * D || ws_size < WS_END) { fprintf(stderr, "kernel_launch: unexpected shapes (n_in %d, in0 %d, out %d, ws %zu); nothing launched\n", n_in, n_in > 0 ? in_sizes[0] : -1, out_size, ws_size); grid = -1; return; }
        int dev = 0, cus = 0, per_cu = 0;
        if (hipGetDevice(&dev) != hipSuccess || hipDeviceGetAttribute(&cus, hipDeviceAttributeMultiprocessorCount, dev) != hipSuccess) { grid = -1; return; }
        if (hipFuncSetAttribute((const void*)mk_fwd, hipFuncAttributeMaxDynamicSharedMemorySize, LDS_BYTES) != hipSuccess) { fprintf(stderr, "kernel_launch: hipFuncSetAttribute failed\n"); grid = -1; return; }
        if (hipOccupancyMaxActiveBlocksPerMultiprocessor(&per_cu, (const void*)mk_fwd, NWAVES * 64, LDS_BYTES) != hipSuccess || per_cu < 1) { fprintf(stderr, "kernel_launch: occupancy query says %d blocks per CU\n", per_cu); per_cu = 1; }
        (void)hipGetLastError();
        grid = cus;
        if (grid != 256) { fprintf(stderr, "kernel_launch: this kernel is laid out for a 256-CU device, found %d CUs; nothing launched\n", grid); grid = -1; return; }
    }
    if (grid < 0) return;
    if (hipMemsetAsync((char*)d_ws + WS_CTL, 0, CTL_ZERO_BYTES, stream) != hipSuccess) { fprintf(stderr, "kernel_launch: hipMemsetAsync failed\n"); return; }
    Args a{};
    for (int i = 0; i < 14; ++i) a.in[i] = (const float*)d_in[i];
    a.out = (float*)d_out; a.ws = (unsigned char*)d_ws;
    hipLaunchKernelGGL(mk_fwd, dim3(grid), dim3(NWAVES * 64), LDS_BYTES, stream, a);
    const hipError_t le = hipPeekAtLastError();
    if (le != hipSuccess) fprintf(stderr, "kernel_launch: launch failed: %s\n", hipGetErrorName(le));
}
```

```cpp
#include <hip/hip_runtime.h>
#include <cstdio>
#include <cstdint>
namespace pg8 {
#define PG8_LAS __attribute__((address_space(3)))
typedef unsigned short bf16_t;
typedef short bf16x8 __attribute__((ext_vector_type(8)));
typedef float f32x4 __attribute__((ext_vector_type(4)));
typedef unsigned u32x4 __attribute__((ext_vector_type(4)));
constexpr int BM = 256, BK = 64, HALF = 128, HTB = HALF * BK * 2  , STAGE_BYTES = 8 * HTB, NXCD = 8, WGM = 8;

__host__ __device__ __forceinline__ int lds_byte(int r, int c) { const int st = (r >> 4) * 2 + (c >> 5), rr = r & 15, cc = c & 31, ob = rr * 64 + cc * 2; return st * 1024 + (ob ^ (((ob >> 9) & 1) << 5)); }
__host__ __device__ __forceinline__ void stage_rc(int b, int& R, int& C) { const int st = b / 1024, sb = b % 1024, swz = sb ^ (((sb >> 9) & 1) << 5); R = (st >> 1) * 16 + swz / 64; C = (st & 1) * 32 + (swz % 64) / 2; }
__host__ __device__ __forceinline__ int perm32(int rho) { const int n = rho >> 4, i = rho & 15; return 8 * (i >> 2) + 4 * n + (i & 3); }

struct Unit { int pm, pn; };
struct Gemm { const bf16_t* A; const bf16_t* Bt; int M, N, K; };

struct StaticOrder {
    int nM, nN, nwg, G, c;
    __host__ __device__ void init(int M, int N, int G_, int c_) { nM = M / BM; nN = N / BM; nwg = nM * nN; G = G_; c = c_; }
    __host__ __device__ bool next(int i, Unit& u) const {
        const long L = (long)i * G + c; if (L >= nwg) return false;
        int wgid = (int)L; { const int q = nwg / NXCD, r = nwg % NXCD, xcd = wgid % NXCD, off = wgid / NXCD; wgid = (xcd < r ? xcd * (q + 1) : r * (q + 1) + (xcd - r) * q) + off; }
        const int nig = WGM * nN, gid = wgid / nig, fm = gid * WGM, gsz = (nM - fm) < WGM ? (nM - fm) : WGM;
        u.pm = fm + ((wgid % nig) % gsz); u.pn = (wgid % nig) / gsz; return true;
    }
    __device__ __forceinline__ void a_ready(const Unit&) const {}
    __device__ __forceinline__ void done(const Unit&) const {}
};

__device__ __forceinline__ unsigned cvt_pk_bf16(float lo, float hi) { unsigned r; asm volatile("v_cvt_pk_bf16_f32 %0, %1, %2" : "=v"(r) : "v"(lo), "v"(hi)); return r; }
typedef float f32x2 __attribute__((ext_vector_type(2)));
template <class Epi, class Sched, bool ALIGN_EPI = false, bool SP2 = false>
__device__ __forceinline__ void gemm_phase(PG8_LAS unsigned char* lds, const Gemm g, const Sched& S, const Epi& E, const int wid_in  ) {
    int lane_o; asm volatile("v_mbcnt_lo_u32_b32 %0, -1, 0\n\tv_mbcnt_hi_u32_b32 %0, -1, %0" : "=&v"(lane_o));
    const int wid = wid_in, lane = lane_o, tid = wid * 64 + lane, wr = wid >> 2, wc = wid & 3, fr = lane & 15, fq = lane >> 4;
    const int K = g.K, nt = K / BK;
    unsigned voffA[2], voffB[2];
#pragma unroll
    for (int i = 0; i < 2; ++i) { int R, C; stage_rc(tid * 16 + i * 8192, R, C); const int Rb = Epi::PERM ? ((R & ~31) + perm32(R & 31)) : R;
        voffA[i] = (unsigned)(R * K + C) * 2u; voffB[i] = (unsigned)(Rb * K + C) * 2u; }
    const size_t kstep = (size_t)(BK * 2);
    const size_t hstep = (size_t)HALF * K * 2;
    const size_t tstep = 2 * hstep;
    const unsigned ldsw = (unsigned)wid * 1024u;
    const int aoff = lds_byte(wr * 64 + fr, fq * 8), boff = lds_byte(wc * 32 + fr, fq * 8);
#define PG8_SA(b, h) (((b) * 2 + (h)) * HTB)
#define PG8_SB(b, h) ((4 + (b) * 2 + (h)) * HTB)
#define PG8_STAGE(bufoff, gbase, voff) do { _Pragma("unroll") for (int _i = 0; _i < 2; ++_i) \
        __builtin_amdgcn_global_load_lds((const unsigned*)((const char*)(gbase) + (voff)[_i]), (PG8_LAS unsigned*)(lds + (bufoff) + ldsw + _i * 8192), 16, 0, 0); } while (0)
#define PG8_LDA(dst, b, h) do { _Pragma("unroll") for (int m = 0; m < 4; ++m) _Pragma("unroll") for (int k = 0; k < 2; ++k) dst[m][k] = *(const PG8_LAS bf16x8*)(lds + PG8_SA(b, h) + aoff + m * 2048 + k * 1024); } while (0)
#define PG8_LDB(dst, b, h) do { _Pragma("unroll") for (int n = 0; n < 2; ++n) _Pragma("unroll") for (int k = 0; k < 2; ++k) dst[n][k] = *(const PG8_LAS bf16x8*)(lds + PG8_SB(b, h) + boff + n * 2048 + k * 1024); } while (0)
#define PG8_MMA(ai, bj, At, Bt) do { __builtin_amdgcn_s_setprio(1); _Pragma("unroll") for (int m = 0; m < 4; ++m) _Pragma("unroll") for (int n = 0; n < 2; ++n) _Pragma("unroll") for (int k = 0; k < 2; ++k) \
        acc[ai][bj][m][n] = __builtin_amdgcn_mfma_f32_16x16x32_bf16(Bt[n][k], At[m][k], acc[ai][bj][m][n], 0, 0, 0); __builtin_amdgcn_s_setprio(0); } while (0)
#define PG8_WAIT_V(n) asm volatile("s_waitcnt vmcnt(" #n ")" ::: "memory")
#define PG8_WAIT_L(n) asm volatile("s_waitcnt lgkmcnt(" #n ")" ::: "memory")
#define PG8_BAR __builtin_amdgcn_s_barrier()
#define PG8_SCHED __builtin_amdgcn_sched_barrier(0)
    Unit cur, nxt; int ui = 0;
    if (!S.next(0, cur)) return;
    f32x4 acc[2][2][4][2];
#pragma unroll
    for (int a = 0; a < 2; ++a)
#pragma unroll
        for (int b = 0; b < 2; ++b)
#pragma unroll
            for (int m = 0; m < 4; ++m)
#pragma unroll
                for (int n = 0; n < 2; ++n) acc[a][b][m][n] = (f32x4){0.f, 0.f, 0.f, 0.f};
    bf16x8 At[4][2], B0[2][2], B1[2][2];
    const char* cA = (const char*)g.A + (size_t)cur.pm * tstep; const char* cB = (const char*)g.Bt + (size_t)cur.pn * tstep;
    S.a_ready(cur);
    if constexpr (SP2) {
        PG8_STAGE(PG8_SB(0, 0), cB, voffB); PG8_STAGE(PG8_SB(0, 1), cB + hstep, voffB); PG8_STAGE(PG8_SA(0, 0), cA, voffA); PG8_STAGE(PG8_SA(0, 1), cA + hstep, voffA);
        if (wr == 1) PG8_BAR;
        PG8_WAIT_V(2); PG8_BAR;
        PG8_STAGE(PG8_SB(1, 0), cB + kstep, voffB); PG8_STAGE(PG8_SA(1, 0), cA + kstep, voffA); PG8_STAGE(PG8_SB(1, 1), cB + hstep + kstep, voffB);
        PG8_WAIT_V(6); PG8_BAR;
    } else {
        PG8_STAGE(PG8_SB(0, 0), cB, voffB); PG8_STAGE(PG8_SA(0, 0), cA, voffA); PG8_STAGE(PG8_SB(0, 1), cB + hstep, voffB); PG8_STAGE(PG8_SA(0, 1), cA + hstep, voffA);
        if (wr == 1) PG8_BAR;
        PG8_WAIT_V(4); PG8_BAR;
        PG8_STAGE(PG8_SB(1, 0), cB + kstep, voffB); PG8_STAGE(PG8_SA(1, 0), cA + kstep, voffA); PG8_STAGE(PG8_SB(1, 1), cB + hstep + kstep, voffB);
        PG8_WAIT_V(6); PG8_BAR;
    }
    for (;;) {
        const bool has_next = S.next(ui + 1, nxt);
        const char* nA = has_next ? (const char*)g.A + (size_t)nxt.pm * tstep : cA; const char* nB = has_next ? (const char*)g.Bt + (size_t)nxt.pn * tstep : cB;
        for (int t = 0; t < nt; t += 2) {
            const bool last = (t == nt - 2);
            const char* a1 = cA + (size_t)(t + 1) * kstep;
            const char* a2 = last ? nA : cA + (size_t)(t + 2) * kstep; const char* b2 = last ? nB : cB + (size_t)(t + 2) * kstep;
            const char* a3 = a2 + kstep; const char* b3 = b2 + kstep;
            if (last && has_next) S.a_ready(nxt);
            if constexpr (SP2) {
            PG8_LDB(B0, 0, 0); PG8_LDB(B1, 0, 1); PG8_SCHED; PG8_LDA(At, 0, 0); PG8_STAGE(PG8_SA(1, 1), a1 + hstep, voffA);
            PG8_WAIT_V(8); PG8_WAIT_L(0); PG8_BAR; PG8_MMA(0, 0, At, B0); PG8_MMA(0, 1, At, B1); PG8_BAR; PG8_SCHED;
            PG8_LDA(At, 0, 1); PG8_STAGE(PG8_SB(0, 0), b2, voffB); PG8_STAGE(PG8_SB(0, 1), b2 + hstep, voffB); PG8_STAGE(PG8_SA(0, 0), a2, voffA);
            PG8_WAIT_V(8); PG8_WAIT_L(0); PG8_BAR; PG8_MMA(1, 0, At, B0); PG8_MMA(1, 1, At, B1); PG8_BAR; PG8_SCHED;
            PG8_LDB(B0, 1, 0); PG8_LDB(B1, 1, 1); PG8_SCHED; PG8_LDA(At, 1, 0); PG8_STAGE(PG8_SA(0, 1), a2 + hstep, voffA);
            PG8_WAIT_V(8); PG8_WAIT_L(0); PG8_BAR; PG8_MMA(0, 0, At, B0); PG8_MMA(0, 1, At, B1); PG8_BAR; PG8_SCHED;
            PG8_LDA(At, 1, 1); PG8_STAGE(PG8_SB(1, 0), b3, voffB); PG8_STAGE(PG8_SB(1, 1), b3 + hstep, voffB); PG8_STAGE(PG8_SA(1, 0), a3, voffA);
            PG8_WAIT_V(8); PG8_WAIT_L(0); PG8_BAR; PG8_MMA(1, 0, At, B0); PG8_MMA(1, 1, At, B1); PG8_BAR; PG8_SCHED;
            } else {
            PG8_LDB(B0, 0, 0); PG8_SCHED; PG8_LDA(At, 0, 0); PG8_STAGE(PG8_SA(1, 1), a1 + hstep, voffA);
            PG8_WAIT_L(8); PG8_BAR; PG8_WAIT_L(0); PG8_MMA(0, 0, At, B0); PG8_BAR; PG8_SCHED;
            PG8_LDB(B1, 0, 1); PG8_STAGE(PG8_SB(0, 0), b2, voffB);
            PG8_BAR; PG8_WAIT_L(0); PG8_MMA(0, 1, At, B1); PG8_BAR;
            PG8_LDA(At, 0, 1); PG8_STAGE(PG8_SA(0, 0), a2, voffA);
            PG8_BAR; PG8_WAIT_L(0); PG8_MMA(1, 0, At, B0); PG8_BAR; PG8_SCHED;
            PG8_STAGE(PG8_SB(0, 1), b2 + hstep, voffB);
            PG8_WAIT_V(6); PG8_BAR; PG8_MMA(1, 1, At, B1); PG8_BAR;
            PG8_LDB(B0, 1, 0); PG8_SCHED; PG8_LDA(At, 1, 0); PG8_STAGE(PG8_SA(0, 1), a2 + hstep, voffA);
            PG8_WAIT_L(8); PG8_BAR; PG8_WAIT_L(0); PG8_MMA(0, 0, At, B0); PG8_BAR; PG8_SCHED;
            PG8_LDB(B1, 1, 1); PG8_STAGE(PG8_SB(1, 0), b3, voffB);
            PG8_BAR; PG8_WAIT_L(0); PG8_MMA(0, 1, At, B1); PG8_BAR;
            PG8_LDA(At, 1, 1); PG8_STAGE(PG8_SA(1, 0), a3, voffA);
            PG8_BAR; PG8_WAIT_L(0); PG8_MMA(1, 0, At, B0); PG8_BAR; PG8_SCHED;
            PG8_STAGE(PG8_SB(1, 1), b3 + hstep, voffB);
            PG8_WAIT_V(6); PG8_BAR; PG8_MMA(1, 1, At, B1); PG8_BAR;
            }
        }
        if constexpr (ALIGN_EPI) { if (wr == 0) PG8_BAR; }
        if constexpr (!Epi::AFTER_DRAIN) { E(acc, cur, wr, wc, fr, fq); S.done(cur); }
        if (!has_next) break;
#pragma unroll
        for (int a = 0; a < 2; ++a)
#pragma unroll
            for (int b = 0; b < 2; ++b)
#pragma unroll
                for (int m = 0; m < 4; ++m)
#pragma unroll
                    for (int n = 0; n < 2; ++n) acc[a][b][m][n] = (f32x4){0.f, 0.f, 0.f, 0.f};
        cur = nxt; cA = nA; cB = nB; ++ui;
        if constexpr (ALIGN_EPI) { if (wr == 1) PG8_BAR; }
    }
    PG8_WAIT_V(0);
    if constexpr (!ALIGN_EPI) { if (wr == 0) PG8_BAR; }
    PG8_BAR;
    if constexpr (Epi::AFTER_DRAIN) { E.fused(acc, cur, wr, wc, fr, fq, lds, wid, lane); S.done(cur); }
#undef PG8_SA
#undef PG8_SB
#undef PG8_STAGE
#undef PG8_LDA
#undef PG8_LDB
#undef PG8_MMA
#undef PG8_WAIT_V
#undef PG8_WAIT_L
#undef PG8_BAR
#undef PG8_SCHED
}
}
#define GAS __attribute__((address_space(1)))
#define LAS __attribute__((address_space(3)))
typedef unsigned short bf16;
typedef unsigned v4u __attribute__((ext_vector_type(4)));
typedef float f32x4 __attribute__((ext_vector_type(4)));
typedef short bf16x8 __attribute__((ext_vector_type(8)));
typedef GAS unsigned gu32;
typedef GAS unsigned long long gu64;
#define RLX_AGENT __ATOMIC_RELAXED, __HIP_MEMORY_SCOPE_AGENT
#define LDS_WAIT() asm volatile("s_waitcnt lgkmcnt(0)" ::: "memory")
#define VM_WAIT() asm volatile("s_waitcnt vmcnt(0)" ::: "memory")
__device__ __forceinline__ unsigned long long rt() { return __builtin_amdgcn_s_memrealtime(); }
__device__ __forceinline__ unsigned f2bf(float f) { unsigned u = __builtin_bit_cast(unsigned, f); return (u + 0x7fffu + ((u >> 16) & 1u)) >> 16; }
__device__ __forceinline__ unsigned pk2(float lo, float hi) { return f2bf(lo) | (f2bf(hi) << 16); }
#define XB_TMO      128
#define XB_XCNT(j)  (256  + 64 * (j))
#define XB_XSUB(j)  (1280 + 64 * (j))
#define XB_XGEN(j)  (2304 + 64 * (j))
#define XB_TOP      3328
#define XB_TOPGEN   3392
#define XCD_BAR_WORDS 3456
#define XB_SPIN_CAP (1u << 24)

__device__ __forceinline__ unsigned xb_ld(unsigned* p)              { return __hip_atomic_load(p, __ATOMIC_RELAXED, __HIP_MEMORY_SCOPE_AGENT); }
__device__ __forceinline__ unsigned xb_add(unsigned* p, unsigned v) { return __hip_atomic_fetch_add(p, v, __ATOMIC_RELAXED, __HIP_MEMORY_SCOPE_AGENT); }
__device__ __forceinline__ unsigned xb_xcc_id() { return (unsigned)__builtin_amdgcn_s_getreg((3 << 11) | 20) & 0xFu; }
#define XB_SPIN(cond, bar) do { unsigned _sp = 0; while (cond) { __builtin_amdgcn_s_sleep(1); \
    if ((++_sp & 255u) == 0u) { if (xb_ld(&(bar)[XB_TMO])) break; if (_sp > XB_SPIN_CAP) { atomicAdd(&(bar)[XB_TMO], 1u); break; } } } } while (0)

struct XcdBarrier {
    unsigned* bar; unsigned x;
    volatile LAS unsigned* st;
};

__device__ __forceinline__ XcdBarrier xcd_barrier_post(unsigned* bar, volatile LAS unsigned* st) {
    XcdBarrier b; b.bar = bar; b.x = xb_xcc_id(); b.st = st;
    if (threadIdx.x == 0) (void)xb_add(&bar[XB_XCNT(b.x)], 1u);
    return b;
}
__device__ __forceinline__ void xcd_barrier_complete(unsigned* bar, unsigned x, unsigned& nloc, unsigned& nx) {
    const unsigned G = gridDim.x * gridDim.y * gridDim.z;
    unsigned sum, cnt, mine, sp = 0u;
    for (;;) {
        sum = 0u; cnt = 0u; mine = 0u;
#pragma unroll
        for (unsigned j = 0; j < 16; ++j) { const unsigned c = xb_ld(&bar[XB_XCNT(j)]); sum += c; cnt += (c > 0u) ? 1u : 0u; mine = (j == x) ? c : mine; }
        if (sum == G) break;
        __builtin_amdgcn_s_sleep(1);
        if ((++sp & 255u) == 0u) { if (xb_ld(&bar[XB_TMO])) break; if (sp > XB_SPIN_CAP) { atomicAdd(&bar[XB_TMO], 1u); break; } }
    }
    nloc = mine > 0u ? mine : 1u; nx = cnt > 0u ? cnt : 1u;
}

__device__ __forceinline__ void xcd_barrier(const XcdBarrier& b) {
    asm volatile("s_waitcnt vmcnt(0)" ::: "memory");
    __syncthreads();
    if (threadIdx.x == 0) {
        unsigned* bar = b.bar;
        __builtin_amdgcn_s_waitcnt(0);
        unsigned nloc = b.st[0], nx = b.st[1];
        if (nloc == 0u) { xcd_barrier_complete(bar, b.x, nloc, nx); b.st[0] = nloc; b.st[1] = nx; }
        const unsigned old = xb_add(&bar[XB_XSUB(b.x)], 1u);
        const unsigned gen = old / nloc;
        if (old + 1u == (gen + 1u) * nloc) {
            __builtin_amdgcn_fence(__ATOMIC_RELEASE, "agent");
            asm volatile("s_waitcnt vmcnt(0)" ::: "memory");
            const unsigned og = xb_add(&bar[XB_TOP], 1u);
            const unsigned tg = og / nx;
            if (og + 1u == (tg + 1u) * nx) xb_add(&bar[XB_TOPGEN], 1u);
            else XB_SPIN(xb_ld(&bar[XB_TOPGEN]) == tg, bar);
            __builtin_amdgcn_fence(__ATOMIC_ACQUIRE, "agent");
            xb_add(&bar[XB_XGEN(b.x)], 1u);
            asm volatile("s_waitcnt vmcnt(0)" ::: "memory");
        } else {
            XB_SPIN(xb_ld(&bar[XB_XGEN(b.x)]) == gen, bar);
            __builtin_amdgcn_fence(__ATOMIC_ACQUIRE, "agent");
            asm volatile("s_waitcnt vmcnt(0)" ::: "memory");
        }
    }
    __syncthreads();
}
namespace mk {
using pg8::f32x4; using pg8::Unit; using pg8::bf16_t; using pg8::u32x4; using pg8::cvt_pk_bf16;
typedef unsigned u32x2 __attribute__((ext_vector_type(2)));
constexpr int B = 8, S = 4096, D = 1024, T = B * S, INW = 3584, DFF = 2816, NMOD = 6144, NGU = 2 * DFF;
constexpr float EPS = 1e-6f, LOG2E = 1.4426950408889634f, QSCALE = 0.125f * 1.4426950408889634f;
#define EPI_LANES() int lane_; asm volatile("v_mbcnt_lo_u32_b32 %0, -1, 0\n\tv_mbcnt_hi_u32_b32 %0, -1, %0" : "=&v"(lane_)); const int wr = wr_, wc = wc_, fr = lane_ & 15, fq = lane_ >> 4; (void)fr_; (void)fq_;
template <int CTRL> __device__ __forceinline__ float dpp_mov0(float v) { return __int_as_float(__builtin_amdgcn_update_dpp(0, __float_as_int(v), CTRL, 0xF, 0xF, false)); }
__device__ __forceinline__ float row_scan16(float s) { s += dpp_mov0<0x111>(s); s += dpp_mov0<0x112>(s); s += dpp_mov0<0x114>(s); s += dpp_mov0<0x118>(s); return s; }
__device__ __forceinline__ float row_sum16(float s) { s += dpp_mov0<0x128>(s); s += dpp_mov0<0x124>(s); s += dpp_mov0<0x122>(s); s += dpp_mov0<0x121>(s); return s; }
__device__ __forceinline__ float ex2(float x) { return __builtin_amdgcn_exp2f(x); }
__device__ __forceinline__ float lg2(float x) { return __builtin_amdgcn_logf(x); }
__device__ __forceinline__ float rcp(float x) { return __builtin_amdgcn_rcpf(x); }
__device__ __forceinline__ float rsq(float x) { return __builtin_amdgcn_rsqf(x); }
__device__ __forceinline__ float silu(float x) { return x * rcp(1.f + ex2(-x * LOG2E)); }
typedef short bf16x8 __attribute__((ext_vector_type(8)));
typedef float f32x2c __attribute__((ext_vector_type(2))); typedef __bf16 bf16x2c __attribute__((ext_vector_type(2)));
__device__ __forceinline__ unsigned pk2r(float lo, float hi) { const f32x2c v = {lo, hi}; return __builtin_bit_cast(unsigned, __builtin_convertvector(v, bf16x2c)); }
__device__ __forceinline__ float bf2f(unsigned short h) { return __uint_as_float(((unsigned)h) << 16); }
__device__ __forceinline__ float bflo(unsigned w) { return __uint_as_float(w << 16); }
__device__ __forceinline__ float bfhi(unsigned w) { return __uint_as_float(w & 0xffff0000u); }

struct EpiIn {
    static constexpr bool PERM = true, AFTER_DRAIN = false;
    bf16_t *QT, *KT, *VH, *SG, *AQ, *AK, *AV; float* DEC; const float* lb;
    __device__ __forceinline__ void operator()(f32x4 (&acc)[2][2][4][2], const Unit& u, int wr_, int wc_, int fr_, int fq_) const {
        EPI_LANES();
        const int pn = u.pn; const unsigned row0 = (unsigned)(u.pm * 256 + wr * 64 + fr);
#ifndef NO_HGRN_EPI
        if (pn < 4) {
            const int cb = pn * 128 + wc * 32 + 8 * fq;
            const f32x4 l0 = *(const f32x4*)(lb + cb), l1 = *(const f32x4*)(lb + cb + 4);
#pragma unroll
            for (int ai = 0; ai < 2; ++ai) {
                const unsigned chunk = (unsigned)(u.pm * 4 + ai * 2 + wr);
#pragma unroll
                for (int n = 0; n < 2; ++n) {
                    float dl[4];
#pragma unroll
                    for (int j = 0; j < 4; ++j) {
                        const float lbv = n == 0 ? l0[j] : l1[j], omlb = 1.f - lbv;
                        float lgv[4], b2[4]; float carry = 0.f;
#pragma unroll
                        for (int m = 0; m < 4; ++m) { const float e = ex2(-acc[ai][1][m][n][j] * LOG2E), sg = rcp(1.f + e); lgv[m] = lg2(lbv + omlb * sg); acc[ai][1][m][n][j] = omlb * (e * sg); }
#pragma unroll
                        for (int m = 0; m < 4; ++m) { const float s = row_scan16(lgv[m]), tot = row_sum16(lgv[m]); b2[m] = carry + s; carry += tot; }
                        dl[j] = ex2(carry);
#pragma unroll
                        for (int m = 0; m < 4; ++m) { acc[ai][0][m][n][j] = silu(acc[ai][0][m][n][j]) * ex2(b2[m]); acc[ai][1][m][n][j] *= ex2(-b2[m]); }
                        __builtin_amdgcn_sched_barrier(0);
                    }
                    *(f32x4*)(DEC + (chunk * 512u + (unsigned)(cb + 4 * n))) = (f32x4){dl[0], dl[1], dl[2], dl[3]};
#pragma unroll
                    for (int m = 0; m < 4; ++m) { const unsigned off = (row0 + ai * 128 + m * 16) * 512u + (unsigned)(cb + 4 * n);
                        const f32x4 q = acc[ai][0][m][n], k = acc[ai][1][m][n];
                        u32x2 w; w.x = pk2r(q[0], q[1]); w.y = pk2r(q[2], q[3]); *(u32x2*)(QT + off) = w;
                        u32x2 kw; kw.x = pk2r(k[0], k[1]); kw.y = pk2r(k[2], k[3]); *(u32x2*)(KT + off) = kw; }
                    __builtin_amdgcn_sched_barrier(0);
                }
            }
        } else
#endif
        {
            const int g = (pn - 4) >> 1; bf16_t* base = g == 0 ? VH : g == 1 ? SG : g == 2 ? AQ : g == 3 ? AK : AV;
            const unsigned col0 = (unsigned)(((pn - 4) & 1) * 256 + wc * 32 + 8 * fq);
#pragma unroll
            for (int ai = 0; ai < 2; ++ai)
#pragma unroll
                for (int m = 0; m < 4; ++m) { bf16_t* rowp = base + ((row0 + ai * 128 + m * 16) * 512u + col0);
#pragma unroll
                    for (int bj = 0; bj < 2; ++bj) { f32x4 v0 = acc[ai][bj][m][0], v1 = acc[ai][bj][m][1];
                        if (g == 1) {
#pragma unroll
                            for (int j = 0; j < 4; ++j) { v0[j] = silu(v0[j]); v1[j] = silu(v1[j]); } }
                        if (g == 2) { v0 = v0 * QSCALE; v1 = v1 * QSCALE; }
                        u32x4 w; w.x = pk2r(v0[0], v0[1]); w.y = pk2r(v0[2], v0[3]); w.z = pk2r(v1[0], v1[1]); w.w = pk2r(v1[2], v1[3]);
                        *(u32x4*)(rowp + bj * 128) = w; } }
        }
    }
};

struct EpiOut {
    static constexpr bool PERM = false, AFTER_DRAIN = false;
    const float* x; float* x1; bf16_t* A2; float* ssq; const float* mod; const float* g2;
    __device__ __forceinline__ void operator()(const f32x4 (&acc)[2][2][4][2], const Unit& u, int wr_, int wc_, int fr_, int fq_) const {
        EPI_LANES();
        const int b = u.pm >> 4, col0 = u.pn * 256 + wc * 32 + 4 * fq, rowb = u.pm * 256 + wr * 64 + fr; const float* modb = mod + b * NMOD;
        float ssr[2][4];
#pragma unroll
        for (int ai = 0; ai < 2; ++ai)
#pragma unroll
            for (int m = 0; m < 4; ++m) ssr[ai][m] = 0.f;
#pragma unroll
        for (int bj = 0; bj < 2; ++bj)
#pragma unroll
            for (int n = 0; n < 2; ++n) { const int c = col0 + bj * 128 + n * 16;
                const f32x4 gate = *(const f32x4*)(modb + 2048 + c), sc2 = *(const f32x4*)(modb + 4096 + c), gg = *(const f32x4*)(g2 + c); const f32x4 mul = gg * (sc2 + 1.0f);
#pragma unroll
                for (int ai = 0; ai < 2; ++ai)
#pragma unroll
                    for (int m = 0; m < 4; ++m) { const size_t off = (size_t)(rowb + ai * 128 + m * 16) * D + c;
                        const f32x4 v = *(const f32x4*)(x + off) + gate * acc[ai][bj][m][n]; *(f32x4*)(x1 + off) = v;
                        ssr[ai][m] += (v[0] * v[0] + v[1] * v[1]) + (v[2] * v[2] + v[3] * v[3]);
                        const f32x4 a = v * mul; u32x2 w; w.x = pk2r(a[0], a[1]); w.y = pk2r(a[2], a[3]); *(u32x2*)(A2 + off) = w; } }
#pragma unroll
        for (int ai = 0; ai < 2; ++ai)
#pragma unroll
            for (int m = 0; m < 4; ++m) { float s = ssr[ai][m]; s += __shfl_xor(s, 16); s += __shfl_xor(s, 32);
                if (fq == 0) ssq[(size_t)(rowb + ai * 128 + m * 16) * 16 + u.pn * 4 + wc] = s; }
    }
};

struct EpiGU {
    static constexpr bool PERM = true, AFTER_DRAIN = false;
    bf16_t* HID; const float* ssq; const float* bias2;
    __device__ __forceinline__ void operator()(const f32x4 (&acc)[2][2][4][2], const Unit& u, int wr_, int wc_, int fr_, int fq_) const {
        EPI_LANES();
        const int b = u.pm >> 4, rowb = u.pm * 256 + wr * 64 + fr; const float* bb = bias2 + b * NGU + u.pn * 256 + wc * 32 + 8 * fq;
        const f32x4 ba0 = *(const f32x4*)(bb), ba1 = *(const f32x4*)(bb + 4), bu0 = *(const f32x4*)(bb + 128), bu1 = *(const f32x4*)(bb + 132);
#pragma unroll
        for (int ai = 0; ai < 2; ++ai)
#pragma unroll
            for (int m = 0; m < 4; ++m) { const int row = rowb + ai * 128 + m * 16; const f32x4* sp = (const f32x4*)(ssq + (size_t)row * 16);
                const f32x4 s0 = sp[0], s1 = sp[1], s2 = sp[2], s3 = sp[3]; const f32x4 st = (s0 + s1) + (s2 + s3);
                const float rstd = rsq(((st[0] + st[1]) + (st[2] + st[3])) * (1.0f / D) + EPS);
                const f32x4 a0 = acc[ai][0][m][0] * rstd + ba0, a1 = acc[ai][0][m][1] * rstd + ba1, u0 = acc[ai][1][m][0] * rstd + bu0, u1 = acc[ai][1][m][1] * rstd + bu1;
                float h[8];
#pragma unroll
                for (int j = 0; j < 4; ++j) { h[j] = silu(a0[j]) * u0[j]; h[4 + j] = silu(a1[j]) * u1[j]; }
                u32x4 w; w.x = pk2r(h[0], h[1]); w.y = pk2r(h[2], h[3]); w.z = pk2r(h[4], h[5]); w.w = pk2r(h[6], h[7]);
                *(u32x4*)(HID + (size_t)row * DFF + u.pn * 128 + wc * 32 + 8 * fq) = w; }
    }
};

struct EpiDown {
    static constexpr bool PERM = false, AFTER_DRAIN = false;
    float* xio; const float* mod;
    __device__ __forceinline__ void operator()(const f32x4 (&acc)[2][2][4][2], const Unit& u, int wr_, int wc_, int fr_, int fq_) const {
        EPI_LANES();
        const int b = u.pm >> 4, col0 = u.pn * 256 + wc * 32 + 4 * fq, rowb = u.pm * 256 + wr * 64 + fr; const float* modb = mod + b * NMOD;
#pragma unroll
        for (int bj = 0; bj < 2; ++bj)
#pragma unroll
            for (int n = 0; n < 2; ++n) { const int c = col0 + bj * 128 + n * 16; const f32x4 gate = *(const f32x4*)(modb + 5120 + c);
#pragma unroll
                for (int ai = 0; ai < 2; ++ai)
#pragma unroll
                    for (int m = 0; m < 4; ++m) { const size_t off = (size_t)(rowb + ai * 128 + m * 16) * D + c; *(f32x4*)(xio + off) = *(const f32x4*)(xio + off) + gate * acc[ai][bj][m][n]; } }
    }
};
}
namespace mk {
constexpr int NWAVES = 8;
constexpr size_t MiB = 1u << 20;
constexpr size_t WS_CTL = 0, CTL_ZERO_BYTES = 64 * 1024;
constexpr size_t WS_MODP = 1 * MiB;
constexpr size_t WS_MOD = 3 * MiB, WS_LB = WS_MOD + 256 * 1024, WS_BIAS2 = WS_MOD + 512 * 1024;
constexpr size_t WS_WIN = 4 * MiB, WS_WOUT = 11 * MiB, WS_WGU = 13 * MiB, WS_WD = 24 * MiB;
constexpr size_t WS_DEC = 30 * MiB, WS_LSE = 31 * MiB, WS_SSQ1 = 34 * MiB;
constexpr size_t WS_BUFA = 40 * MiB;
constexpr size_t WS_BUFB = 104 * MiB;
constexpr size_t WS_R = 168 * MiB;
constexpr size_t WS_QT = WS_R, WS_KT = WS_R + 32 * MiB, WS_VH = WS_R + 64 * MiB, WS_SG = WS_R + 96 * MiB, WS_AQ = WS_R + 128 * MiB, WS_AK = WS_R + 160 * MiB, WS_AV = WS_R + 192 * MiB;
constexpr size_t WS_ST = WS_BUFA;
constexpr size_t WS_ATT0 = WS_R + 224 * MiB, WS_ATT1 = WS_R + 256 * MiB, WS_ATT2 = WS_R + 288 * MiB;
constexpr size_t WS_HID = WS_R;
constexpr size_t WS_END = WS_R + 320 * MiB;
constexpr int CW_BAR = 4096;
constexpr int RING_BYTES = 131072, LDSCTL_OFF = RING_BYTES, MISC_OFF = LDSCTL_OFF + 320, LDS_BYTES = 147456;

__device__ __forceinline__ const float* karg_ptr(int i) {
    asm volatile("" : "+s"(i));
    typedef const float* cfp;
    const __attribute__((address_space(4))) cfp* ka = (const __attribute__((address_space(4))) cfp*)__builtin_amdgcn_kernarg_segment_ptr();
    return ka[i];
}

__device__ __forceinline__ void transpose_item(const float* W, int K, int N, bf16* WT, int mode, LAS float* scr, int item, int lane) {
    const int nblk = N / 32, kb = item / nblk, nb = item % nblk, k0 = 64 * kb, n0 = 32 * nb;
    int r0 = n0;
    if (mode == 1) { if (n0 < 512) r0 = (n0 >> 7) * 256 + (n0 & 127); else if (n0 < 1024) r0 = ((n0 - 512) >> 7) * 256 + 128 + (n0 & 127); }
    if (mode == 2) { if (n0 < DFF) r0 = (n0 >> 7) * 256 + (n0 & 127); else r0 = ((n0 - DFF) >> 7) * 256 + 128 + ((n0 - DFF) & 127); }
#pragma unroll 8
    for (int i = 0; i < 32; ++i) { const int kk = 2 * i + (lane >> 5); scr[kk * 33 + (lane & 31)] = W[(size_t)(k0 + kk) * N + n0 + (lane & 31)]; }
    LDS_WAIT(); asm volatile("" ::: "memory");
    const int c = lane & 7;
#pragma unroll
    for (int j = 0; j < 4; ++j) { const int n = (lane >> 3) + 8 * j; const LAS float* s = scr + (8 * c) * 33 + n;
        v4u o; o.x = pk2(s[0 * 33], s[1 * 33]); o.y = pk2(s[2 * 33], s[3 * 33]); o.z = pk2(s[4 * 33], s[5 * 33]); o.w = pk2(s[6 * 33], s[7 * 33]);
        *(GAS v4u*)(WT + (size_t)(r0 + n) * K + k0 + 8 * c) = o; }
    LDS_WAIT(); asm volatile("" ::: "memory");
}
__device__ __forceinline__ void mod_partial(const float* Pc, const float* Pw_ada, float* modp, LAS float* scr, int it, int lane) {
    const int cg = it % 96, ks = it / 96, n = cg * 64 + lane;
#pragma unroll
    for (int i = 0; i < 16; ++i) { const int idx = i * 64 + lane, kk = idx & 127, b = idx >> 7; scr[kk * 8 + b] = silu(Pc[b * D + ks * 128 + kk]); }
    LDS_WAIT(); asm volatile("" ::: "memory");
    float acc[8];
#pragma unroll
    for (int b = 0; b < 8; ++b) acc[b] = 0.f;
    const float* wp = Pw_ada + (size_t)(ks * 128) * NMOD + n;
#pragma unroll 16
    for (int kk = 0; kk < 128; ++kk) { const float w = wp[(size_t)kk * NMOD]; const f32x4 c0 = *(const LAS f32x4*)(scr + kk * 8), c1 = *(const LAS f32x4*)(scr + kk * 8 + 4);
        acc[0] += c0[0] * w; acc[1] += c0[1] * w; acc[2] += c0[2] * w; acc[3] += c0[3] * w; acc[4] += c1[0] * w; acc[5] += c1[1] * w; acc[6] += c1[2] * w; acc[7] += c1[3] * w; }
#pragma unroll
    for (int b = 0; b < 8; ++b) modp[(size_t)(ks * 8 + b) * NMOD + n] = acc[b];
    LDS_WAIT(); asm volatile("" ::: "memory");
}
__device__ __forceinline__ float wsum64(float v) {
#pragma unroll
    for (int o = 1; o < 64; o <<= 1) v += __shfl_xor(v, o);
    return v;
}
__device__ __forceinline__ float wmax64(float v) {
#pragma unroll
    for (int o = 1; o < 64; o <<= 1) v = fmaxf(v, __shfl_xor(v, o));
    return v;
}

typedef short s16x4v __attribute__((ext_vector_type(4)));
template <int SW> __device__ __forceinline__ int swz(int R) { return SW == 0 ? (R & 15) : SW == 1 ? (((R & 3) << 1) | (((R >> 3) & 1) << 3)) : ((R & 7) << 1); }
template <int SW> __device__ __forceinline__ void tile_dma(LAS unsigned char* lds, int to, const bf16* src, size_t tok0, int col0, int wave, int lane) {
#pragma unroll
    for (int pi = 0; pi < 2; ++pi) { const int piece = wave + 8 * pi, R = 4 * piece + (lane >> 4); const int gch = (lane & 15) ^ swz<SW>(R);
        __builtin_amdgcn_global_load_lds((const unsigned*)(src + (tok0 + R) * 512 + col0 + gch * 8), (LAS unsigned*)(lds + to + piece * 1024), 16, 0, 0); }
}
template <int SW> __device__ __forceinline__ bf16x8 tr_frag(const LAS unsigned char* tile, int r0a, int r0b, int c0, int i16) {
    const int q = i16 >> 2, ch = (c0 >> 3) + ((i16 & 3) >> 1), bo = (i16 & 1) * 8; const int Ra = r0a + q, Rb = r0b + q;
    const s16x4v va = __builtin_amdgcn_ds_read_tr16_b64_v4i16((LAS s16x4v*)(tile + Ra * 256 + ((ch ^ swz<SW>(Ra)) << 4) + bo));
    const s16x4v vb = __builtin_amdgcn_ds_read_tr16_b64_v4i16((LAS s16x4v*)(tile + Rb * 256 + ((ch ^ swz<SW>(Rb)) << 4) + bo));
    return (bf16x8){va[0], va[1], va[2], va[3], vb[0], vb[1], vb[2], vb[3]};
}
__device__ __forceinline__ bf16x8 row_frag(const LAS unsigned char* tile, int R, int ch) { return *(const LAS bf16x8*)(tile + R * 256 + ((ch ^ (R & 15)) << 4)); }

__device__ __forceinline__ void hgrn_scan(LAS unsigned char* lds, const bf16* KT, const bf16* VH, const float* DEC, bf16* ST, int bh, int wave, int lane) {
    const int b = bh >> 2, h = bh & 3, i16 = lane & 15, g4 = lane >> 4; const size_t tokb = (size_t)b * S;
    f32x4 acc[8];
#pragma unroll
    for (int vt = 0; vt < 8; ++vt) acc[vt] = (f32x4){0.f, 0.f, 0.f, 0.f};
    tile_dma<1>(lds, 0, KT, tokb, h * 128, wave, lane); tile_dma<1>(lds, 16384, VH, tokb, h * 128, wave, lane);
    for (int c = 0; c < 63; ++c) {
        const int cur = c & 1;
        asm volatile("s_waitcnt vmcnt(0)" ::: "memory");
        __syncthreads();
        if (c + 1 < 63) { tile_dma<1>(lds, (cur ^ 1) * 32768, KT, tokb + 64 * (c + 1), h * 128, wave, lane); tile_dma<1>(lds, (cur ^ 1) * 32768 + 16384, VH, tokb + 64 * (c + 1), h * 128, wave, lane); }
        const f32x4 dv = *(const f32x4*)(DEC + ((size_t)(b * 64 + c) * 512 + h * 128 + 16 * wave + 4 * g4));
        const LAS unsigned char* Kt = lds + cur * 32768; const LAS unsigned char* Vt = Kt + 16384;
#pragma unroll
        for (int ks = 0; ks < 2; ++ks) { const int r0 = 32 * ks + 8 * g4;
            const bf16x8 af = tr_frag<1>(Kt, r0, r0 + 4, 16 * wave, i16);
#pragma unroll
            for (int vt = 0; vt < 8; ++vt) { const bf16x8 bfv = tr_frag<1>(Vt, r0, r0 + 4, 16 * vt, i16);
                acc[vt] = __builtin_amdgcn_mfma_f32_16x16x32_bf16(af, bfv, acc[vt], 0, 0, 0); } }
        bf16* sp = ST + (((size_t)(bh * 64 + c) * 128 + i16) * 128 + 16 * wave + 4 * g4);
#pragma unroll
        for (int vt = 0; vt < 8; ++vt) { acc[vt] = acc[vt] * dv;
            u32x2 w; w.x = pk2r(acc[vt][0], acc[vt][1]); w.y = pk2r(acc[vt][2], acc[vt][3]); *(u32x2*)(sp + (size_t)vt * 16 * 128) = w; }
    }
    __syncthreads();
}

__device__ __forceinline__ void hgrn_out_units(LAS unsigned char* lds, const bf16* QT, const bf16* KT, const bf16* VH, const bf16* SG, const bf16* ST, const float* hg_on, bf16* MIXIN, int wave, int lane, int ulo, int uhi) {
    const int i16 = lane & 15, g4 = lane >> 4;
    LAS unsigned char* Pl = lds + 98304; LAS float* ssq = (LAS float*)(lds + 106496);
    { const int bh = ulo >> 6, c = ulo & 63, b = bh >> 2, h = bh & 3; const size_t tok0 = (size_t)b * S + 64 * c;
      tile_dma<0>(lds, 0, QT, tok0, h * 128, wave, lane); tile_dma<0>(lds, 16384, KT, tok0, h * 128, wave, lane); tile_dma<2>(lds, 32768, VH, tok0, h * 128, wave, lane); }
    for (int u = ulo; u < uhi; ++u) {
        const int cur = (u - ulo) & 1; const int bh = u >> 6, c = u & 63, b = bh >> 2, h = bh & 3; const size_t tok0 = (size_t)b * S + 64 * c;
        asm volatile("s_waitcnt vmcnt(0)" ::: "memory");
        __syncthreads();
        if (u + 1 < uhi) { const int bh2 = (u + 1) >> 6, c2 = (u + 1) & 63; const size_t t2 = (size_t)(bh2 >> 2) * S + 64 * c2; const int h2 = bh2 & 3, o2 = (cur ^ 1) * 49152;
            tile_dma<0>(lds, o2, QT, t2, h2 * 128, wave, lane); tile_dma<0>(lds, o2 + 16384, KT, t2, h2 * 128, wave, lane); tile_dma<2>(lds, o2 + 32768, VH, t2, h2 * 128, wave, lane); }
        const LAS unsigned char* Qt = lds + cur * 49152; const LAS unsigned char* Kt = Qt + 16384; const LAS unsigned char* Vt = Qt + 32768;
        bf16x8 sa[4];
        if (c > 0) { const bf16* sp = ST + (((size_t)(bh * 64 + c - 1) * 128 + 16 * wave + i16) * 128 + 8 * g4);
#pragma unroll
            for (int ks = 0; ks < 4; ++ks) sa[ks] = *(const bf16x8*)(sp + 32 * ks); }
        else {
#pragma unroll
            for (int ks = 0; ks < 4; ++ks) sa[ks] = (bf16x8){0, 0, 0, 0, 0, 0, 0, 0}; }
#pragma unroll
        for (int q = 0; q < 2; ++q) { const int id = 2 * wave + q, si = id >> 2, ti = id & 3; f32x4 a = {0.f, 0.f, 0.f, 0.f};
            if (si <= ti) {
#pragma unroll
                for (int ks = 0; ks < 4; ++ks) a = __builtin_amdgcn_mfma_f32_16x16x32_bf16(row_frag(Kt, 16 * si + i16, g4 + 4 * ks), row_frag(Qt, 16 * ti + i16, g4 + 4 * ks), a, 0, 0, 0);
                if (si == ti) {
#pragma unroll
                    for (int reg = 0; reg < 4; ++reg) if (4 * g4 + reg > i16) a[reg] = 0.f; } }
            u32x2 w; w.x = pk2r(a[0], a[1]); w.y = pk2r(a[2], a[3]); *(LAS u32x2*)(Pl + id * 512 + lane * 8) = w; }
        __syncthreads();
        f32x4 o[4];
#pragma unroll
        for (int tt = 0; tt < 4; ++tt) { o[tt] = (f32x4){0.f, 0.f, 0.f, 0.f};
#pragma unroll
            for (int ks = 0; ks < 4; ++ks) o[tt] = __builtin_amdgcn_mfma_f32_16x16x32_bf16(sa[ks], row_frag(Qt, 16 * tt + i16, g4 + 4 * ks), o[tt], 0, 0, 0);
#pragma unroll
            for (int kp = 0; kp < 2; ++kp) { if (2 * kp <= tt) {
                    const u32x2 pa = *(const LAS u32x2*)(Pl + ((2 * kp) * 4 + tt) * 512 + lane * 8), pb = *(const LAS u32x2*)(Pl + ((2 * kp + 1) * 4 + tt) * 512 + lane * 8);
                    const v4u pw = {pa.x, pa.y, pb.x, pb.y};
                    const bf16x8 vf = tr_frag<2>(Vt, 32 * kp + 4 * g4, 32 * kp + 16 + 4 * g4, 16 * wave, i16);
                    o[tt] = __builtin_amdgcn_mfma_f32_16x16x32_bf16(vf, __builtin_bit_cast(bf16x8, pw), o[tt], 0, 0, 0); } } }
#pragma unroll
        for (int tt = 0; tt < 4; ++tt) { float ss = (o[tt][0] * o[tt][0] + o[tt][1] * o[tt][1]) + (o[tt][2] * o[tt][2] + o[tt][3] * o[tt][3]); ss += __shfl_xor(ss, 16); ss += __shfl_xor(ss, 32);
            if (g4 == 0) ssq[wave * 64 + 16 * tt + i16] = ss; }
        __syncthreads();
        const f32x4 gon = *(const f32x4*)(hg_on + 16 * wave + 4 * g4);
#pragma unroll
        for (int tt = 0; tt < 4; ++tt) { float tot = 0.f;
#pragma unroll
            for (int w8 = 0; w8 < 8; ++w8) tot += ssq[w8 * 64 + 16 * tt + i16];
            const float rstd = rsq(tot * (1.f / 128.f) + EPS);
            const size_t tok = tok0 + 16 * tt + i16; const int col = h * 128 + 16 * wave + 4 * g4;
            const u32x2 sg = *(const u32x2*)(SG + tok * 512 + col);
            u32x2 w; w.x = pk2r(o[tt][0] * rstd * gon[0] * bflo(sg.x), o[tt][1] * rstd * gon[1] * bfhi(sg.x)); w.y = pk2r(o[tt][2] * rstd * gon[2] * bflo(sg.y), o[tt][3] * rstd * gon[3] * bfhi(sg.y));
            *(u32x2*)(MIXIN + tok * D + col) = w; }
    }
    __syncthreads();
}

struct AttU { int b, h, dsh, r, n, br; };
__device__ __forceinline__ AttU att_decode(int g) {
    AttU U; const int bh = g / 96, u = g % 96; U.b = bh >> 3; U.h = bh & 7;
    if (u < 32) { U.dsh = 0; U.r = 0; U.n = u; U.br = 0; }
    else if (u < 64) { U.dsh = 2; U.r = (u - 32) >> 3; U.n = (u - 32) & 7; U.br = 1; }
    else { U.dsh = 4; U.r = (u - 64) >> 1; U.n = (u - 64) & 1; U.br = 2; }
    return U;
}
__device__ __forceinline__ void att_dma(LAS unsigned char* lds, int bufo, const bf16* AK, const bf16* AV, const AttU& U, int wave, int lane) {
    const int gch = (lane & 7) ^ (lane >> 3);
#pragma unroll
    for (int pi = 0; pi < 4; ++pi) { const int piece = wave + 8 * pi, row = piece * 8 + (lane >> 3); int m = 128 * (U.n - 1) + row; if (m < 0) m += 128;
        const size_t eoff = ((size_t)U.b * S + (size_t)((m << U.dsh) + U.r)) * 512 + U.h * 64 + gch * 8;
        __builtin_amdgcn_global_load_lds((const unsigned*)(AK + eoff), (LAS unsigned*)(lds + bufo + piece * 1024), 16, 0, 0);
        __builtin_amdgcn_global_load_lds((const unsigned*)(AV + eoff), (LAS unsigned*)(lds + bufo + 32768 + piece * 1024), 16, 0, 0); }
}
__device__ __forceinline__ void attn_units(LAS unsigned char* lds, const bf16* AQ, const bf16* AK, const bf16* AV, unsigned char* ws, float* LSE, int wave, int lane, int glo, int ghi) {
    const int i16 = lane & 15, g4 = lane >> 4;
    AttU U = att_decode(glo);
    att_dma(lds, 0, AK, AV, U, wave, lane);
    bf16x8 qn0, qn1;
    { const bf16* qp = AQ + (((size_t)U.b * S + (size_t)(((128 * U.n + 16 * wave + i16) << U.dsh) + U.r)) * 512 + U.h * 64 + 8 * g4); qn0 = *(const bf16x8*)qp; qn1 = *(const bf16x8*)(qp + 32); }
    for (int gu = glo; gu < ghi; ++gu) {
        const int cur = (gu - glo) & 1; const AttU C = U; const bf16x8 qf0 = qn0, qf1 = qn1;
        asm volatile("s_waitcnt vmcnt(0)" ::: "memory");
        __syncthreads();
        if (gu + 1 < ghi) { U = att_decode(gu + 1); att_dma(lds, (cur ^ 1) * 65536, AK, AV, U, wave, lane);
            const bf16* qp = AQ + (((size_t)U.b * S + (size_t)(((128 * U.n + 16 * wave + i16) << U.dsh) + U.r)) * 512 + U.h * 64 + 8 * g4); qn0 = *(const bf16x8*)qp; qn1 = *(const bf16x8*)(qp + 32); }
        const LAS unsigned char* Kb = lds + cur * 65536; const LAS unsigned char* Vb = Kb + 32768;
        f32x4 st[9];
#pragma unroll
        for (int t = 0; t < 9; ++t) { const int R = 16 * (wave + t) + i16; const LAS unsigned char* kp = Kb + R * 128;
            const bf16x8 a0 = *(const LAS bf16x8*)(kp + ((g4 ^ (R & 7)) << 4)), a1 = *(const LAS bf16x8*)(kp + (((g4 + 4) ^ (R & 7)) << 4));
            f32x4 z = {0.f, 0.f, 0.f, 0.f};
            z = __builtin_amdgcn_mfma_f32_16x16x32_bf16(a0, qf0, z, 0, 0, 0); st[t] = __builtin_amdgcn_mfma_f32_16x16x32_bf16(a1, qf1, z, 0, 0, 0); }
        const int qi = 16 * wave + i16; const float NEG = -INFINITY;
#pragma unroll
        for (int reg = 0; reg < 4; ++reg) { const int kj0 = 16 * wave + 4 * g4 + reg; if (kj0 < qi) st[0][reg] = NEG; if (kj0 + 128 > qi + 128) st[8][reg] = NEG; }
        if (C.n == 0) {
#pragma unroll
            for (int t = 0; t < 8; ++t)
#pragma unroll
                for (int reg = 0; reg < 4; ++reg) { if (16 * (wave + t) + 4 * g4 + reg < 128) st[t][reg] = NEG; } }
        float mx = st[0][0];
#pragma unroll
        for (int t = 0; t < 9; ++t)
#pragma unroll
            for (int reg = 0; reg < 4; ++reg) mx = fmaxf(mx, st[t][reg]);
        mx = fmaxf(mx, __shfl_xor(mx, 16)); mx = fmaxf(mx, __shfl_xor(mx, 32));
        float l = 0.f;
#pragma unroll
        for (int t = 0; t < 9; ++t)
#pragma unroll
            for (int reg = 0; reg < 4; ++reg) { const float pv = ex2(st[t][reg] - mx); st[t][reg] = pv; l += pv; }
        l += __shfl_xor(l, 16); l += __shfl_xor(l, 32);
        f32x4 o[4];
#pragma unroll
        for (int et = 0; et < 4; ++et) o[et] = (f32x4){0.f, 0.f, 0.f, 0.f};
#pragma unroll
        for (int ks = 0; ks < 5; ++ks) {
            const int ta = 2 * ks, tb = (ks < 4) ? 2 * ks + 1 : 2 * ks;
            v4u pw; pw.x = pk2r(st[ta][0], st[ta][1]); pw.y = pk2r(st[ta][2], st[ta][3]);
            if (ks < 4) { pw.z = pk2r(st[tb][0], st[tb][1]); pw.w = pk2r(st[tb][2], st[tb][3]); } else { pw.z = 0u; pw.w = 0u; }
            const bf16x8 pf = __builtin_bit_cast(bf16x8, pw);
            const int Ra = 16 * (wave + ta) + 4 * g4 + (i16 >> 2), Rb = 16 * (wave + tb) + 4 * g4 + (i16 >> 2);
#pragma unroll
            for (int et = 0; et < 4; ++et) { const int ch = 2 * et + ((i16 & 3) >> 1), bo = (i16 & 1) * 8;
                const s16x4v va = __builtin_amdgcn_ds_read_tr16_b64_v4i16((LAS s16x4v*)(Vb + Ra * 128 + ((ch ^ (Ra & 7)) << 4) + bo));
                const s16x4v vb = __builtin_amdgcn_ds_read_tr16_b64_v4i16((LAS s16x4v*)(Vb + Rb * 128 + ((ch ^ (Rb & 7)) << 4) + bo));
                const bf16x8 vf = {va[0], va[1], va[2], va[3], vb[0], vb[1], vb[2], vb[3]};
                o[et] = __builtin_amdgcn_mfma_f32_16x16x32_bf16(vf, pf, o[et], 0, 0, 0); }
        }
        const float il = rcp(l);
        const size_t orow = (size_t)C.b * S + (size_t)(((128 * C.n + qi) << C.dsh) + C.r);
        bf16* AO = (bf16*)(ws + (C.br == 0 ? WS_ATT0 : C.br == 1 ? WS_ATT1 : WS_ATT2)) + orow * 512 + C.h * 64 + 4 * g4;
#pragma unroll
        for (int et = 0; et < 4; ++et) { u32x2 w; w.x = pk2r(o[et][0] * il, o[et][1] * il); w.y = pk2r(o[et][2] * il, o[et][3] * il); *(u32x2*)(AO + 16 * et) = w; }
        if (g4 == 0) LSE[(size_t)C.br * T * 8 + orow * 8 + C.h] = mx + lg2(l);
    }
    __syncthreads();
}

struct Args { const float* in[14]; float* out; unsigned char* ws; };
__global__ void __launch_bounds__(NWAVES * 64, 2) mk_fwd(Args args) {
    extern __shared__ __attribute__((aligned(16))) unsigned char lds_raw[];
    LAS unsigned char* lds = (LAS unsigned char*)lds_raw;
    volatile LAS unsigned* MISC = (volatile LAS unsigned*)(lds + MISC_OFF);
    const int wave = __builtin_amdgcn_readfirstlane(threadIdx.x >> 6);
    const int G = gridDim.x, bx = blockIdx.x; const int vcu = (G % 8 == 0) ? (bx % 8) * (G / 8) + bx / 8 : bx;
    const int gw = vcu * NWAVES + wave, NGW = G * NWAVES;
    (void)args;
#define INP(i) karg_ptr(i)
#define P_x INP(0)
#define P_c INP(1)
#define P_w_ada INP(2)
#define P_b_ada INP(3)
#define P_g1 INP(4)
#define P_w_in INP(5)
#define P_lbl INP(6)
#define P_hg_on INP(7)
#define P_att_on INP(8)
#define P_w_out INP(9)
#define P_g2 INP(10)
#define P_w_gu INP(11)
#define P_w_down INP(12)
#define P_gf INP(13)
#define P_out ((float*)INP(14))
    unsigned char* const ws = (unsigned char*)INP(15);
    gu32* ctl = (gu32*)(ws + WS_CTL);
#define MODP ((float*)(ws + WS_MODP))
#define MOD ((float*)(ws + WS_MOD))
#define LB ((float*)(ws + WS_LB))
#define BIAS2 ((float*)(ws + WS_BIAS2))
#define WIN_T ((bf16*)(ws + WS_WIN))
#define WOUT_T ((bf16*)(ws + WS_WOUT))
#define WGU_T ((bf16*)(ws + WS_WGU))
#define WD_T ((bf16*)(ws + WS_WD))
#define DEC ((float*)(ws + WS_DEC))
#define LSE ((float*)(ws + WS_LSE))
#define SSQ1 ((float*)(ws + WS_SSQ1))
#define XN ((bf16*)(ws + WS_BUFA))
#define A2 ((bf16*)(ws + WS_BUFA))
#define MIXIN ((bf16*)(ws + WS_BUFB))
#define QT ((bf16*)(ws + WS_QT))
#define KT ((bf16*)(ws + WS_KT))
#define VH ((bf16*)(ws + WS_VH))
#define SG ((bf16*)(ws + WS_SG))
#define AQ ((bf16*)(ws + WS_AQ))
#define AK ((bf16*)(ws + WS_AK))
#define AV ((bf16*)(ws + WS_AV))
#define STB ((bf16*)(ws + WS_ST))
#define HID ((bf16*)(ws + WS_HID))
#define PHASE_TID() int lane; asm volatile("v_mbcnt_lo_u32_b32 %0, -1, 0\n\tv_mbcnt_hi_u32_b32 %0, -1, %0" : "=&v"(lane)); const int tid = wave * 64 + lane; (void)tid;

    for (int u = threadIdx.x; u < (LDS_BYTES - LDSCTL_OFF) / 4; u += NWAVES * 64) ((LAS unsigned*)(lds + LDSCTL_OFF))[u] = 0u;
    __syncthreads();
    XcdBarrier bar = xcd_barrier_post((unsigned*)(ctl + CW_BAR), MISC + 8);

    {   PHASE_TID();
        LAS float* scr = (LAS float*)(lds + wave * 16384);
        constexpr int I_MOD = 768, I_IN = 16 * (INW / 32), I_OUT = 16 * (D / 32), I_GU = 16 * (NGU / 32), I_DN = (DFF / 64) * (D / 32);
        constexpr int NTASK = I_MOD + I_IN + I_OUT + I_GU + I_DN + 1;
        for (int it = gw; it < NTASK; it += NGW) {
            int r = it;
            if (r < I_MOD) { mod_partial(P_c, P_w_ada, MODP, scr, r, lane); continue; } r -= I_MOD;
            if (r < I_IN) { transpose_item(P_w_in, D, INW, WIN_T, 1, scr, r, lane); continue; } r -= I_IN;
            if (r < I_OUT) { transpose_item(P_w_out, D, D, WOUT_T, 0, scr, r, lane); continue; } r -= I_OUT;
            if (r < I_GU) { transpose_item(P_w_gu, D, NGU, WGU_T, 2, scr, r, lane); continue; } r -= I_GU;
            if (r < I_DN) { transpose_item(P_w_down, DFF, D, WD_T, 0, scr, r, lane); continue; }
#pragma unroll
            for (int i = 0; i < 8; ++i) { const int j = lane + 64 * i; LB[j] = rcp(1.f + ex2((P_lbl[512 + j] - P_lbl[j]) * LOG2E)); }
        }
    }
    xcd_barrier(bar);

    {   PHASE_TID();
        LAS float* ms = (LAS float*)lds; LAS float* sh = ms + D;
        if (tid < 192) { const int idx = bx * 192 + tid; const int b = idx / NMOD, n = idx % NMOD; float v = P_b_ada[n];
#pragma unroll
            for (int ks = 0; ks < 8; ++ks) v += MODP[(size_t)(ks * 8 + b) * NMOD + n];
            MOD[idx] = v; }
        const int rows_per = T / G, row0 = bx * rows_per, b = row0 / S;
#pragma unroll
        for (int i = 0; i < 2; ++i) { const int k = tid + 512 * i; float s1 = P_b_ada[k], c1 = P_b_ada[1024 + k];
#pragma unroll
            for (int ks = 0; ks < 8; ++ks) { s1 += MODP[(size_t)(ks * 8 + b) * NMOD + k]; c1 += MODP[(size_t)(ks * 8 + b) * NMOD + 1024 + k]; }
            ms[k] = P_g1[k] * (1.f + c1); sh[k] = s1; }
        __syncthreads();
        for (int r = wave; r < rows_per; r += NWAVES) {
            const int row = row0 + r; const GAS f32x4* xr = (const GAS f32x4*)(P_x + (size_t)row * D) + lane;
            f32x4 v[4]; float s = 0.f;
#pragma unroll
            for (int j = 0; j < 4; ++j) { v[j] = xr[64 * j]; s += (v[j].x * v[j].x + v[j].y * v[j].y) + (v[j].z * v[j].z + v[j].w * v[j].w); }
            const float rstd = rsq(wsum64(s) * (1.f / D) + EPS);
            GAS unsigned long long* o8 = (GAS unsigned long long*)(XN + (size_t)row * D) + lane;
#pragma unroll
            for (int j = 0; j < 4; ++j) { const f32x4 m4 = *(const LAS f32x4*)(ms + 256 * j + 4 * lane), s4 = *(const LAS f32x4*)(sh + 256 * j + 4 * lane); const f32x4 o = v[j] * rstd * m4 + s4;
                o8[64 * j] = (unsigned long long)pk2(o.x, o.y) | ((unsigned long long)pk2(o.z, o.w) << 32); }
        }
    }
    xcd_barrier(bar);

    {
        pg8::Gemm g{XN, WIN_T, T, INW, D}; pg8::StaticOrder So; So.init(T, INW, G, bx);
        EpiIn E{QT, KT, VH, SG, AQ, AK, AV, DEC, LB};
        pg8::gemm_phase<EpiIn, pg8::StaticOrder, true, true>(lds, g, So, E, wave);
    }
    xcd_barrier(bar);

    if (vcu < 32) {   PHASE_TID();
        hgrn_scan(lds, KT, VH, DEC, STB, vcu, wave, lane);
    }
    {   PHASE_TID();
        attn_units(lds, AQ, AK, AV, ws, LSE, wave, lane, vcu * 24, vcu * 24 + 24);
    }
    xcd_barrier(bar);

    {   PHASE_TID();
        hgrn_out_units(lds, QT, KT, VH, SG, STB, P_hg_on, MIXIN, wave, lane, vcu * 8, vcu * 8 + 8);
        for (int t = gw; t < T; t += NGW) {
            const int c8 = lane * 8;
            {   const int h = lane >> 3;
                const float l0 = LSE[(size_t)t * 8 + h], l1 = LSE[(size_t)T * 8 + (size_t)t * 8 + h], l2 = LSE[(size_t)2 * T * 8 + (size_t)t * 8 + h];
                const float mx = fmaxf(l0, fmaxf(l1, l2)); float w0 = ex2(l0 - mx), w1 = ex2(l1 - mx), w2 = ex2(l2 - mx); const float inv = rcp(w0 + w1 + w2); w0 *= inv; w1 *= inv; w2 *= inv;
                const v4u a0 = *(const v4u*)((const bf16*)(ws + WS_ATT0) + (size_t)t * 512 + c8), a1 = *(const v4u*)((const bf16*)(ws + WS_ATT1) + (size_t)t * 512 + c8), a2 = *(const v4u*)((const bf16*)(ws + WS_ATT2) + (size_t)t * 512 + c8);
                float a[8];
                a[0] = w0 * bflo(a0.x) + w1 * bflo(a1.x) + w2 * bflo(a2.x); a[1] = w0 * bfhi(a0.x) + w1 * bfhi(a1.x) + w2 * bfhi(a2.x);
                a[2] = w0 * bflo(a0.y) + w1 * bflo(a1.y) + w2 * bflo(a2.y); a[3] = w0 * bfhi(a0.y) + w1 * bfhi(a1.y) + w2 * bfhi(a2.y);
                a[4] = w0 * bflo(a0.z) + w1 * bflo(a1.z) + w2 * bflo(a2.z); a[5] = w0 * bfhi(a0.z) + w1 * bfhi(a1.z) + w2 * bfhi(a2.z);
                a[6] = w0 * bflo(a0.w) + w1 * bflo(a1.w) + w2 * bflo(a2.w); a[7] = w0 * bfhi(a0.w) + w1 * bfhi(a1.w) + w2 * bfhi(a2.w);
                float ss = 0.f;
#pragma unroll
                for (int i = 0; i < 8; ++i) ss += a[i] * a[i];
                const float rstd = rsq(wsum64(ss) * (1.f / 512.f) + EPS);
                const f32x4 n0 = *(const f32x4*)(P_att_on + c8), n1 = *(const f32x4*)(P_att_on + c8 + 4);
#pragma unroll
                for (int i = 0; i < 4; ++i) { a[i] = a[i] * rstd * n0[i]; a[4 + i] = a[4 + i] * rstd * n1[i]; }
                v4u w; w.x = pk2(a[0], a[1]); w.y = pk2(a[2], a[3]); w.z = pk2(a[4], a[5]); w.w = pk2(a[6], a[7]);
                *(v4u*)(MIXIN + (size_t)t * D + 512 + c8) = w; }
        }
        __syncthreads();
        LAS float* sh2 = (LAS float*)lds;
        for (int i = tid; i < 8 * D; i += NWAVES * 64) sh2[i] = MOD[(i >> 10) * NMOD + 3072 + (i & 1023)];
        __syncthreads();
        const int ncol = NGU / G;
        for (int j = wave; j < ncol; j += NWAVES) { const int n = bx * ncol + j;
            const v4u w0 = *(const v4u*)(WGU_T + (size_t)n * D + lane * 16), w1 = *(const v4u*)(WGU_T + (size_t)n * D + lane * 16 + 8);
            const float wv[16] = {bflo(w0.x), bfhi(w0.x), bflo(w0.y), bfhi(w0.y), bflo(w0.z), bfhi(w0.z), bflo(w0.w), bfhi(w0.w), bflo(w1.x), bfhi(w1.x), bflo(w1.y), bfhi(w1.y), bflo(w1.z), bfhi(w1.z), bflo(w1.w), bfhi(w1.w)};
#pragma unroll
            for (int b = 0; b < 8; ++b) { float s = 0.f;
#pragma unroll
                for (int q4 = 0; q4 < 4; ++q4) { const f32x4 sv = *(const LAS f32x4*)(sh2 + b * D + lane * 16 + q4 * 4); s += wv[q4 * 4] * sv[0] + wv[q4 * 4 + 1] * sv[1] + wv[q4 * 4 + 2] * sv[2] + wv[q4 * 4 + 3] * sv[3]; }
                s = wsum64(s); if (lane == 0) BIAS2[b * NGU + n] = s; }
        }
        __syncthreads();
    }
    xcd_barrier(bar);

    {
        pg8::Gemm g{MIXIN, WOUT_T, T, D, D}; pg8::StaticOrder So; So.init(T, D, G, bx);
        EpiOut E{P_x, P_out, A2, SSQ1, MOD, P_g2};
        pg8::gemm_phase<EpiOut, pg8::StaticOrder, true, true>(lds, g, So, E, wave);
    }
    xcd_barrier(bar);

    {
        pg8::Gemm g{A2, WGU_T, T, NGU, D}; pg8::StaticOrder So; So.init(T, NGU, G, bx);
        EpiGU E{HID, SSQ1, BIAS2};
        pg8::gemm_phase<EpiGU, pg8::StaticOrder, true, true>(lds, g, So, E, wave);
    }
    xcd_barrier(bar);

    {
        pg8::Gemm g{HID, WD_T, T, D, DFF}; pg8::StaticOrder So; So.init(T, D, G, bx);
        EpiDown E{P_out, MOD};
        pg8::gemm_phase<EpiDown, pg8::StaticOrder, true, true>(lds, g, So, E, wave);
    }
    xcd_barrier(bar);

    PHASE_TID();
    for (int row = gw; row < T; row += NGW) {
        GAS f32x4* xr = (GAS f32x4*)(P_out + (size_t)row * D) + lane;
        f32x4 v[4]; float s = 0.f;
#pragma unroll
        for (int j = 0; j < 4; ++j) { v[j] = xr[64 * j]; s += (v[j].x * v[j].x + v[j].y * v[j].y) + (v[j].z * v[j].z + v[j].w * v[j].w); }
        const float rstd = rsq(wsum64(s) * (1.f / D) + EPS);
#pragma unroll
        for (int j = 0; j < 4; ++j) { const f32x4 g4 = *(const f32x4*)(P_gf + 256 * j + 4 * lane); xr[64 * j] = v[j] * rstd * g4; }
    }
}
}

extern "C" void kernel_launch(void* const* d_in, const int* in_sizes, int n_in, void* d_out, int out_size, void* d_ws, size_t ws_size, hipStream_t stream) {
    using namespace mk;
    static int grid = 0;
    if (grid == 0) {
        if (n_in != 14 || in_sizes[0] != T * D || out_size != T * D || ws_size < WS_END) { fprintf(stderr, "kernel_launch: unexpected shapes (n_in %d, in0 %d, out %d, ws %zu); nothing launched\n", n_in, n_in > 0 ? in_sizes[0] : -1, out_size, ws_size); grid = -1; return; }
        int dev = 0, cus = 0, per_cu = 0;
        if (hipGetDevice(&dev) != hipSuccess || hipDeviceGetAttribute(&cus, hipDeviceAttributeMultiprocessorCount, dev) != hipSuccess) { grid = -1; return; }
        if (hipFuncSetAttribute((const void*)mk_fwd, hipFuncAttributeMaxDynamicSharedMemorySize, LDS_BYTES) != hipSuccess) { fprintf(stderr, "kernel_launch: hipFuncSetAttribute failed\n"); grid = -1; return; }
        if (hipOccupancyMaxActiveBlocksPerMultiprocessor(&per_cu, (const void*)mk_fwd, NWAVES * 64, LDS_BYTES) != hipSuccess || per_cu < 1) { fprintf(stderr, "kernel_launch: occupancy query says %d blocks per CU\n", per_cu); per_cu = 1; }
        (void)hipGetLastError();
        grid = cus;
        if (grid != 256) { fprintf(stderr, "kernel_launch: this kernel is laid out for a 256-CU device, found %d CUs; nothing launched\n", grid); grid = -1; return; }
    }
    if (grid < 0) return;
    if (hipMemsetAsync((char*)d_ws + WS_CTL, 0, CTL_ZERO_BYTES, stream) != hipSuccess) { fprintf(stderr, "kernel_launch: hipMemsetAsync failed\n"); return; }
    Args a{};
    for (int i = 0; i < 14; ++i) a.in[i] = (const float*)d_in[i];
    a.out = (float*)d_out; a.ws = (unsigned char*)d_ws;
    hipLaunchKernelGGL(mk_fwd, dim3(grid), dim3(NWAVES * 64), LDS_BYTES, stream, a);
    const hipError_t le = hipPeekAtLastError();
    if (le != hipSuccess) fprintf(stderr, "kernel_launch: launch failed: %s\n", hipGetErrorName(le));
}
```

```cpp
#include <hip/hip_runtime.h>
#include <cstdio>
#include <cstdint>
namespace pg8 {
#define PG8_LAS __attribute__((address_space(3)))
typedef unsigned short bf16_t;
typedef short bf16x8 __attribute__((ext_vector_type(8)));
typedef float f32x4 __attribute__((ext_vector_type(4)));
typedef unsigned u32x4 __attribute__((ext_vector_type(4)));
constexpr int BM = 256, BK = 64, HALF = 128, HTB = HALF * BK * 2  , STAGE_BYTES = 8 * HTB, NXCD = 8, WGM = 8;

__host__ __device__ __forceinline__ int lds_byte(int r, int c) { const int st = (r >> 4) * 2 + (c >> 5), rr = r & 15, cc = c & 31, ob = rr * 64 + cc * 2; return st * 1024 + (ob ^ (((ob >> 9) & 1) << 5)); }
__host__ __device__ __forceinline__ void stage_rc(int b, int& R, int& C) { const int st = b / 1024, sb = b % 1024, swz = sb ^ (((sb >> 9) & 1) << 5); R = (st >> 1) * 16 + swz / 64; C = (st & 1) * 32 + (swz % 64) / 2; }
__host__ __device__ __forceinline__ int perm32(int rho) { const int n = rho >> 4, i = rho & 15; return 8 * (i >> 2) + 4 * n + (i & 3); }

struct Unit { int pm, pn; };
struct Gemm { const bf16_t* A; const bf16_t* Bt; int M, N, K; };

struct StaticOrder {
    int nM, nN, nwg, G, c;
    __host__ __device__ void init(int M, int N, int G_, int c_) { nM = M / BM; nN = N / BM; nwg = nM * nN; G = G_; c = c_; }
    __host__ __device__ bool next(int i, Unit& u) const {
        const long L = (long)i * G + c; if (L >= nwg) return false;
        int wgid = (int)L; { const int q = nwg / NXCD, r = nwg % NXCD, xcd = wgid % NXCD, off = wgid / NXCD; wgid = (xcd < r ? xcd * (q + 1) : r * (q + 1) + (xcd - r) * q) + off; }
        const int nig = WGM * nN, gid = wgid / nig, fm = gid * WGM, gsz = (nM - fm) < WGM ? (nM - fm) : WGM;
        u.pm = fm + ((wgid % nig) % gsz); u.pn = (wgid % nig) / gsz; return true;
    }
    __device__ __forceinline__ void a_ready(const Unit&) const {}
    __device__ __forceinline__ void done(const Unit&) const {}
};

__device__ __forceinline__ unsigned cvt_pk_bf16(float lo, float hi) { unsigned r; asm volatile("v_cvt_pk_bf16_f32 %0, %1, %2" : "=v"(r) : "v"(lo), "v"(hi)); return r; }
typedef float f32x2 __attribute__((ext_vector_type(2)));
template <class Epi, class Sched, bool ALIGN_EPI = false, bool SP2 = false>
__device__ __forceinline__ void gemm_phase(PG8_LAS unsigned char* lds, const Gemm g, const Sched& S, const Epi& E, const int wid_in  ) {
    int lane_o; asm volatile("v_mbcnt_lo_u32_b32 %0, -1, 0\n\tv_mbcnt_hi_u32_b32 %0, -1, %0" : "=&v"(lane_o));
    const int wid = wid_in, lane = lane_o, tid = wid * 64 + lane, wr = wid >> 2, wc = wid & 3, fr = lane & 15, fq = lane >> 4;
    const int K = g.K, nt = K / BK;
    unsigned voffA[2], voffB[2];
#pragma unroll
    for (int i = 0; i < 2; ++i) { int R, C; stage_rc(tid * 16 + i * 8192, R, C); const int Rb = Epi::PERM ? ((R & ~31) + perm32(R & 31)) : R;
        voffA[i] = (unsigned)(R * K + C) * 2u; voffB[i] = (unsigned)(Rb * K + C) * 2u; }
    const size_t kstep = (size_t)(BK * 2);
    const size_t hstep = (size_t)HALF * K * 2;
    const size_t tstep = 2 * hstep;
    const unsigned ldsw = (unsigned)wid * 1024u;
    const int aoff = lds_byte(wr * 64 + fr, fq * 8), boff = lds_byte(wc * 32 + fr, fq * 8);
#define PG8_SA(b, h) (((b) * 2 + (h)) * HTB)
#define PG8_SB(b, h) ((4 + (b) * 2 + (h)) * HTB)
#define PG8_STAGE(bufoff, gbase, voff) do { _Pragma("unroll") for (int _i = 0; _i < 2; ++_i) \
        __builtin_amdgcn_global_load_lds((const unsigned*)((const char*)(gbase) + (voff)[_i]), (PG8_LAS unsigned*)(lds + (bufoff) + ldsw + _i * 8192), 16, 0, 0); } while (0)
#define PG8_LDA(dst, b, h) do { _Pragma("unroll") for (int m = 0; m < 4; ++m) _Pragma("unroll") for (int k = 0; k < 2; ++k) dst[m][k] = *(const PG8_LAS bf16x8*)(lds + PG8_SA(b, h) + aoff + m * 2048 + k * 1024); } while (0)
#define PG8_LDB(dst, b, h) do { _Pragma("unroll") for (int n = 0; n < 2; ++n) _Pragma("unroll") for (int k = 0; k < 2; ++k) dst[n][k] = *(const PG8_LAS bf16x8*)(lds + PG8_SB(b, h) + boff + n * 2048 + k * 1024); } while (0)
#define PG8_MMA(ai, bj, At, Bt) do { __builtin_amdgcn_s_setprio(1); _Pragma("unroll") for (int m = 0; m < 4; ++m) _Pragma("unroll") for (int n = 0; n < 2; ++n) _Pragma("unroll") for (int k = 0; k < 2; ++k) \
        acc[ai][bj][m][n] = __builtin_amdgcn_mfma_f32_16x16x32_bf16(Bt[n][k], At[m][k], acc[ai][bj][m][n], 0, 0, 0); __builtin_amdgcn_s_setprio(0); } while (0)
#define PG8_WAIT_V(n) asm volatile("s_waitcnt vmcnt(" #n ")" ::: "memory")
#define PG8_WAIT_L(n) asm volatile("s_waitcnt lgkmcnt(" #n ")" ::: "memory")
#define PG8_BAR __builtin_amdgcn_s_barrier()
#define PG8_SCHED __builtin_amdgcn_sched_barrier(0)
    Unit cur, nxt; int ui = 0;
    if (!S.next(0, cur)) return;
    f32x4 acc[2][2][4][2];
#pragma unroll
    for (int a = 0; a < 2; ++a)
#pragma unroll
        for (int b = 0; b < 2; ++b)
#pragma unroll
            for (int m = 0; m < 4; ++m)
#pragma unroll
                for (int n = 0; n < 2; ++n) acc[a][b][m][n] = (f32x4){0.f, 0.f, 0.f, 0.f};
    bf16x8 At[4][2], B0[2][2], B1[2][2];
    const char* cA = (const char*)g.A + (size_t)cur.pm * tstep; const char* cB = (const char*)g.Bt + (size_t)cur.pn * tstep;
    S.a_ready(cur);
    if constexpr (SP2) {
        PG8_STAGE(PG8_SB(0, 0), cB, voffB); PG8_STAGE(PG8_SB(0, 1), cB + hstep, voffB); PG8_STAGE(PG8_SA(0, 0), cA, voffA); PG8_STAGE(PG8_SA(0, 1), cA + hstep, voffA);
        if (wr == 1) PG8_BAR;
        PG8_WAIT_V(2); PG8_BAR;
        PG8_STAGE(PG8_SB(1, 0), cB + kstep, voffB); PG8_STAGE(PG8_SA(1, 0), cA + kstep, voffA); PG8_STAGE(PG8_SB(1, 1), cB + hstep + kstep, voffB);
        PG8_WAIT_V(6); PG8_BAR;
    } else {
        PG8_STAGE(PG8_SB(0, 0), cB, voffB); PG8_STAGE(PG8_SA(0, 0), cA, voffA); PG8_STAGE(PG8_SB(0, 1), cB + hstep, voffB); PG8_STAGE(PG8_SA(0, 1), cA + hstep, voffA);
        if (wr == 1) PG8_BAR;
        PG8_WAIT_V(4); PG8_BAR;
        PG8_STAGE(PG8_SB(1, 0), cB + kstep, voffB); PG8_STAGE(PG8_SA(1, 0), cA + kstep, voffA); PG8_STAGE(PG8_SB(1, 1), cB + hstep + kstep, voffB);
        PG8_WAIT_V(6); PG8_BAR;
    }
    for (;;) {
        const bool has_next = S.next(ui + 1, nxt);
        const char* nA = has_next ? (const char*)g.A + (size_t)nxt.pm * tstep : cA; const char* nB = has_next ? (const char*)g.Bt + (size_t)nxt.pn * tstep : cB;
        for (int t = 0; t < nt; t += 2) {
            const bool last = (t == nt - 2);
            const char* a1 = cA + (size_t)(t + 1) * kstep;
            const char* a2 = last ? nA : cA + (size_t)(t + 2) * kstep; const char* b2 = last ? nB : cB + (size_t)(t + 2) * kstep;
            const char* a3 = a2 + kstep; const char* b3 = b2 + kstep;
            if (last && has_next) S.a_ready(nxt);
            if constexpr (SP2) {
            PG8_LDB(B0, 0, 0); PG8_LDB(B1, 0, 1); PG8_SCHED; PG8_LDA(At, 0, 0); PG8_STAGE(PG8_SA(1, 1), a1 + hstep, voffA);
            PG8_WAIT_V(8); PG8_WAIT_L(0); PG8_BAR; PG8_MMA(0, 0, At, B0); PG8_MMA(0, 1, At, B1); PG8_BAR; PG8_SCHED;
            PG8_LDA(At, 0, 1); PG8_STAGE(PG8_SB(0, 0), b2, voffB); PG8_STAGE(PG8_SB(0, 1), b2 + hstep, voffB); PG8_STAGE(PG8_SA(0, 0), a2, voffA);
            PG8_WAIT_V(8); PG8_WAIT_L(0); PG8_BAR; PG8_MMA(1, 0, At, B0); PG8_MMA(1, 1, At, B1); PG8_BAR; PG8_SCHED;
            PG8_LDB(B0, 1, 0); PG8_LDB(B1, 1, 1); PG8_SCHED; PG8_LDA(At, 1, 0); PG8_STAGE(PG8_SA(0, 1), a2 + hstep, voffA);
            PG8_WAIT_V(8); PG8_WAIT_L(0); PG8_BAR; PG8_MMA(0, 0, At, B0); PG8_MMA(0, 1, At, B1); PG8_BAR; PG8_SCHED;
            PG8_LDA(At, 1, 1); PG8_STAGE(PG8_SB(1, 0), b3, voffB); PG8_STAGE(PG8_SB(1, 1), b3 + hstep, voffB); PG8_STAGE(PG8_SA(1, 0), a3, voffA);
            PG8_WAIT_V(8); PG8_WAIT_L(0); PG8_BAR; PG8_MMA(1, 0, At, B0); PG8_MMA(1, 1, At, B1); PG8_BAR; PG8_SCHED;
            } else {
            PG8_LDB(B0, 0, 0); PG8_SCHED; PG8_LDA(At, 0, 0); PG8_STAGE(PG8_SA(1, 1), a1 + hstep, voffA);
            PG8_WAIT_L(8); PG8_BAR; PG8_WAIT_L(0); PG8_MMA(0, 0, At, B0); PG8_BAR; PG8_SCHED;
            PG8_LDB(B1, 0, 1); PG8_STAGE(PG8_SB(0, 0), b2, voffB);
            PG8_BAR; PG8_WAIT_L(0); PG8_MMA(0, 1, At, B1); PG8_BAR;
            PG8_LDA(At, 0, 1); PG8_STAGE(PG8_SA(0, 0), a2, voffA);
            PG8_BAR; PG8_WAIT_L(0); PG8_MMA(1, 0, At, B0); PG8_BAR; PG8_SCHED;
            PG8_STAGE(PG8_SB(0, 1), b2 + hstep, voffB);
            PG8_WAIT_V(6); PG8_BAR; PG8_MMA(1, 1, At, B1); PG8_BAR;
            PG8_LDB(B0, 1, 0); PG8_SCHED; PG8_LDA(At, 1, 0); PG8_STAGE(PG8_SA(0, 1), a2 + hstep, voffA);
            PG8_WAIT_L(8); PG8_BAR; PG8_WAIT_L(0); PG8_MMA(0, 0, At, B0); PG8_BAR; PG8_SCHED;
            PG8_LDB(B1, 1, 1); PG8_STAGE(PG8_SB(1, 0), b3, voffB);
            PG8_BAR; PG8_WAIT_L(0); PG8_MMA(0, 1, At, B1); PG8_BAR;
            PG8_LDA(At, 1, 1); PG8_STAGE(PG8_SA(1, 0), a3, voffA);
            PG8_BAR; PG8_WAIT_L(0); PG8_MMA(1, 0, At, B0); PG8_BAR; PG8_SCHED;
            PG8_STAGE(PG8_SB(1, 1), b3 + hstep, voffB);
            PG8_WAIT_V(6); PG8_BAR; PG8_MMA(1, 1, At, B1); PG8_BAR;
            }
        }
        if constexpr (ALIGN_EPI) { if (wr == 0) PG8_BAR; }
        if constexpr (!Epi::AFTER_DRAIN) { E(acc, cur, wr, wc, fr, fq); S.done(cur); }
        if (!has_next) break;
#pragma unroll
        for (int a = 0; a < 2; ++a)
#pragma unroll
            for (int b = 0; b < 2; ++b)
#pragma unroll
                for (int m = 0; m < 4; ++m)
#pragma unroll
                    for (int n = 0; n < 2; ++n) acc[a][b][m][n] = (f32x4){0.f, 0.f, 0.f, 0.f};
        cur = nxt; cA = nA; cB = nB; ++ui;
        if constexpr (ALIGN_EPI) { if (wr == 1) PG8_BAR; }
    }
    PG8_WAIT_V(0);
    if constexpr (!ALIGN_EPI) { if (wr == 0) PG8_BAR; }
    PG8_BAR;
    if constexpr (Epi::AFTER_DRAIN) { E.fused(acc, cur, wr, wc, fr, fq, lds, wid, lane); S.done(cur); }
#undef PG8_SA
#undef PG8_SB
#undef PG8_STAGE
#undef PG8_LDA
#undef PG8_LDB
#undef PG8_MMA
#undef PG8_WAIT_V
#undef PG8_WAIT_L
#undef PG8_BAR
#undef PG8_SCHED
}
}
#define GAS __attribute__((address_space(1)))
#define LAS __attribute__((address_space(3)))
typedef unsigned short bf16;
typedef unsigned v4u __attribute__((ext_vector_type(4)));
typedef float f32x4 __attribute__((ext_vector_type(4)));
typedef short bf16x8 __attribute__((ext_vector_type(8)));
typedef GAS unsigned gu32;
typedef GAS unsigned long long gu64;
#define RLX_AGENT __ATOMIC_RELAXED, __HIP_MEMORY_SCOPE_AGENT
#define LDS_WAIT() asm volatile("s_waitcnt lgkmcnt(0)" ::: "memory")
#define VM_WAIT() asm volatile("s_waitcnt vmcnt(0)" ::: "memory")
__device__ __forceinline__ unsigned long long rt() { return __builtin_amdgcn_s_memrealtime(); }
__device__ __forceinline__ unsigned f2bf(float f) { unsigned u = __builtin_bit_cast(unsigned, f); return (u + 0x7fffu + ((u >> 16) & 1u)) >> 16; }
__device__ __forceinline__ unsigned pk2(float lo, float hi) { return f2bf(lo) | (f2bf(hi) << 16); }
#define XB_TMO      128
#define XB_XCNT(j)  (256  + 64 * (j))
#define XB_XSUB(j)  (1280 + 64 * (j))
#define XB_XGEN(j)  (2304 + 64 * (j))
#define XB_TOP      3328
#define XB_TOPGEN   3392
#define XCD_BAR_WORDS 3456
#define XB_SPIN_CAP (1u << 24)

__device__ __forceinline__ unsigned xb_ld(unsigned* p)              { return __hip_atomic_load(p, __ATOMIC_RELAXED, __HIP_MEMORY_SCOPE_AGENT); }
__device__ __forceinline__ unsigned xb_add(unsigned* p, unsigned v) { return __hip_atomic_fetch_add(p, v, __ATOMIC_RELAXED, __HIP_MEMORY_SCOPE_AGENT); }
__device__ __forceinline__ unsigned xb_xcc_id() { return (unsigned)__builtin_amdgcn_s_getreg((3 << 11) | 20) & 0xFu; }
#define XB_SPIN(cond, bar) do { unsigned _sp = 0; while (cond) { __builtin_amdgcn_s_sleep(1); \
    if ((++_sp & 255u) == 0u) { if (xb_ld(&(bar)[XB_TMO])) break; if (_sp > XB_SPIN_CAP) { atomicAdd(&(bar)[XB_TMO], 1u); break; } } } } while (0)

struct XcdBarrier {
    unsigned* bar; unsigned x;
    volatile LAS unsigned* st;
};

__device__ __forceinline__ XcdBarrier xcd_barrier_post(unsigned* bar, volatile LAS unsigned* st) {
    XcdBarrier b; b.bar = bar; b.x = xb_xcc_id(); b.st = st;
    if (threadIdx.x == 0) (void)xb_add(&bar[XB_XCNT(b.x)], 1u);
    return b;
}
__device__ __forceinline__ void xcd_barrier_complete(unsigned* bar, unsigned x, unsigned& nloc, unsigned& nx) {
    const unsigned G = gridDim.x * gridDim.y * gridDim.z;
    unsigned sum, cnt, mine, sp = 0u;
    for (;;) {
        sum = 0u; cnt = 0u; mine = 0u;
#pragma unroll
        for (unsigned j = 0; j < 16; ++j) { const unsigned c = xb_ld(&bar[XB_XCNT(j)]); sum += c; cnt += (c > 0u) ? 1u : 0u; mine = (j == x) ? c : mine; }
        if (sum == G) break;
        __builtin_amdgcn_s_sleep(1);
        if ((++sp & 255u) == 0u) { if (xb_ld(&bar[XB_TMO])) break; if (sp > XB_SPIN_CAP) { atomicAdd(&bar[XB_TMO], 1u); break; } }
    }
    nloc = mine > 0u ? mine : 1u; nx = cnt > 0u ? cnt : 1u;
}

__device__ __forceinline__ void xcd_barrier(const XcdBarrier& b) {
    asm volatile("s_waitcnt vmcnt(0)" ::: "memory");
    __syncthreads();
    if (threadIdx.x == 0) {
        unsigned* bar = b.bar;
        __builtin_amdgcn_s_waitcnt(0);
        unsigned nloc = b.st[0], nx = b.st[1];
        if (nloc == 0u) { xcd_barrier_complete(bar, b.x, nloc, nx); b.st[0] = nloc; b.st[1] = nx; }
        const unsigned old = xb_add(&bar[XB_XSUB(b.x)], 1u);
        const unsigned gen = old / nloc;
        if (old + 1u == (gen + 1u) * nloc) {
            __builtin_amdgcn_fence(__ATOMIC_RELEASE, "agent");
            asm volatile("s_waitcnt vmcnt(0)" ::: "memory");
            const unsigned og = xb_add(&bar[XB_TOP], 1u);
            const unsigned tg = og / nx;
            if (og + 1u == (tg + 1u) * nx) xb_add(&bar[XB_TOPGEN], 1u);
            else XB_SPIN(xb_ld(&bar[XB_TOPGEN]) == tg, bar);
            __builtin_amdgcn_fence(__ATOMIC_ACQUIRE, "agent");
            xb_add(&bar[XB_XGEN(b.x)], 1u);
            asm volatile("s_waitcnt vmcnt(0)" ::: "memory");
        } else {
            XB_SPIN(xb_ld(&bar[XB_XGEN(b.x)]) == gen, bar);
            __builtin_amdgcn_fence(__ATOMIC_ACQUIRE, "agent");
            asm volatile("s_waitcnt vmcnt(0)" ::: "memory");
        }
    }
    __syncthreads();
}
namespace mk {
using pg8::f32x4; using pg8::Unit; using pg8::bf16_t; using pg8::u32x4; using pg8::cvt_pk_bf16;
typedef unsigned u32x2 __attribute__((ext_vector_type(2)));
constexpr int B = 8, S = 4096, D = 1024, T = B * S, INW = 3584, DFF = 2816, NMOD = 6144, NGU = 2 * DFF;
constexpr float EPS = 1e-6f, LOG2E = 1.4426950408889634f, QSCALE = 0.125f * 1.4426950408889634f;
#define EPI_LANES() int lane_; asm volatile("v_mbcnt_lo_u32_b32 %0, -1, 0\n\tv_mbcnt_hi_u32_b32 %0, -1, %0" : "=&v"(lane_)); const int wr = wr_, wc = wc_, fr = lane_ & 15, fq = lane_ >> 4; (void)fr_; (void)fq_;
template <int CTRL> __device__ __forceinline__ float dpp_mov0(float v) { return __int_as_float(__builtin_amdgcn_update_dpp(0, __float_as_int(v), CTRL, 0xF, 0xF, false)); }
__device__ __forceinline__ float row_scan16(float s) { s += dpp_mov0<0x111>(s); s += dpp_mov0<0x112>(s); s += dpp_mov0<0x114>(s); s += dpp_mov0<0x118>(s); return s; }
__device__ __forceinline__ float row_sum16(float s) { s += dpp_mov0<0x128>(s); s += dpp_mov0<0x124>(s); s += dpp_mov0<0x122>(s); s += dpp_mov0<0x121>(s); return s; }
__device__ __forceinline__ float ex2(float x) { return __builtin_amdgcn_exp2f(x); }
__device__ __forceinline__ float lg2(float x) { return __builtin_amdgcn_logf(x); }
__device__ __forceinline__ float rcp(float x) { return __builtin_amdgcn_rcpf(x); }
__device__ __forceinline__ float rsq(float x) { return __builtin_amdgcn_rsqf(x); }
__device__ __forceinline__ float silu(float x) { return x * rcp(1.f + ex2(-x * LOG2E)); }
typedef short bf16x8 __attribute__((ext_vector_type(8)));
typedef float f32x2c __attribute__((ext_vector_type(2))); typedef __bf16 bf16x2c __attribute__((ext_vector_type(2)));
__device__ __forceinline__ unsigned pk2r(float lo, float hi) { const f32x2c v = {lo, hi}; return __builtin_bit_cast(unsigned, __builtin_convertvector(v, bf16x2c)); }
__device__ __forceinline__ float bf2f(unsigned short h) { return __uint_as_float(((unsigned)h) << 16); }
__device__ __forceinline__ float bflo(unsigned w) { return __uint_as_float(w << 16); }
__device__ __forceinline__ float bfhi(unsigned w) { return __uint_as_float(w & 0xffff0000u); }

struct EpiIn {
    static constexpr bool PERM = true, AFTER_DRAIN = false;
    bf16_t *QT, *KT, *VH, *SG, *AQ, *AK, *AV; float* DEC; const float* lb;
    __device__ __forceinline__ void operator()(f32x4 (&acc)[2][2][4][2], const Unit& u, int wr_, int wc_, int fr_, int fq_) const {
        EPI_LANES();
        const int pn = u.pn; const unsigned row0 = (unsigned)(u.pm * 256 + wr * 64 + fr);
#ifndef NO_HGRN_EPI
        if (pn < 4) {
            const int cb = pn * 128 + wc * 32 + 8 * fq;
            const f32x4 l0 = *(const f32x4*)(lb + cb), l1 = *(const f32x4*)(lb + cb + 4);
#pragma unroll
            for (int ai = 0; ai < 2; ++ai) {
                const unsigned chunk = (unsigned)(u.pm * 4 + ai * 2 + wr);
#pragma unroll
                for (int n = 0; n < 2; ++n) {
                    float dl[4];
#pragma unroll
                    for (int j = 0; j < 4; ++j) {
                        const float lbv = n == 0 ? l0[j] : l1[j], omlb = 1.f - lbv;
                        float lgv[4], b2[4]; float carry = 0.f;
#pragma unroll
                        for (int m = 0; m < 4; ++m) { const float e = ex2(-acc[ai][1][m][n][j] * LOG2E), sg = rcp(1.f + e); lgv[m] = lg2(lbv + omlb * sg); acc[ai][1][m][n][j] = omlb * (e * sg); }
#pragma unroll
                        for (int m = 0; m < 4; ++m) { const float s = row_scan16(lgv[m]), tot = row_sum16(lgv[m]); b2[m] = carry + s; carry += tot; }
                        dl[j] = ex2(carry);
#pragma unroll
                        for (int m = 0; m < 4; ++m) { acc[ai][0][m][n][j] = silu(acc[ai][0][m][n][j]) * ex2(b2[m]); acc[ai][1][m][n][j] *= ex2(-b2[m]); }
                        __builtin_amdgcn_sched_barrier(0);
                    }
                    *(f32x4*)(DEC + (chunk * 512u + (unsigned)(cb + 4 * n))) = (f32x4){dl[0], dl[1], dl[2], dl[3]};
#pragma unroll
                    for (int m = 0; m < 4; ++m) { const unsigned off = (row0 + ai * 128 + m * 16) * 512u + (unsigned)(cb + 4 * n);
                        const f32x4 q = acc[ai][0][m][n], k = acc[ai][1][m][n];
                        u32x2 w; w.x = pk2r(q[0], q[1]); w.y = pk2r(q[2], q[3]); *(u32x2*)(QT + off) = w;
                        u32x2 kw; kw.x = pk2r(k[0], k[1]); kw.y = pk2r(k[2], k[3]); *(u32x2*)(KT + off) = kw; }
                    __builtin_amdgcn_sched_barrier(0);
                }
            }
        } else
#endif
        {
            const int g = (pn - 4) >> 1; bf16_t* base = g == 0 ? VH : g == 1 ? SG : g == 2 ? AQ : g == 3 ? AK : AV;
            const unsigned col0 = (unsigned)(((pn - 4) & 1) * 256 + wc * 32 + 8 * fq);
#pragma unroll
            for (int ai = 0; ai < 2; ++ai)
#pragma unroll
                for (int m = 0; m < 4; ++m) { bf16_t* rowp = base + ((row0 + ai * 128 + m * 16) * 512u + col0);
#pragma unroll
                    for (int bj = 0; bj < 2; ++bj) { f32x4 v0 = acc[ai][bj][m][0], v1 = acc[ai][bj][m][1];
                        if (g == 1) {
#pragma unroll
                            for (int j = 0; j < 4; ++j) { v0[j] = silu(v0[j]); v1[j] = silu(v1[j]); } }
                        if (g == 2) { v0 = v0 * QSCALE; v1 = v1 * QSCALE; }
                        u32x4 w; w.x = pk2r(v0[0], v0[1]); w.y = pk2r(v0[2], v0[3]); w.z = pk2r(v1[0], v1[1]); w.w = pk2r(v1[2], v1[3]);
                        *(u32x4*)(rowp + bj * 128) = w; } }
        }
    }
};

struct EpiOut {
    static constexpr bool PERM = false, AFTER_DRAIN = false;
    const float* x; float* x1; bf16_t* A2; float* ssq; const float* mod; const float* g2;
    __device__ __forceinline__ void operator()(const f32x4 (&acc)[2][2][4][2], const Unit& u, int wr_, int wc_, int fr_, int fq_) const {
        EPI_LANES();
        const int b = u.pm >> 4, col0 = u.pn * 256 + wc * 32 + 4 * fq, rowb = u.pm * 256 + wr * 64 + fr; const float* modb = mod + b * NMOD;
        float ssr[2][4];
#pragma unroll
        for (int ai = 0; ai < 2; ++ai)
#pragma unroll
            for (int m = 0; m < 4; ++m) ssr[ai][m] = 0.f;
#pragma unroll
        for (int bj = 0; bj < 2; ++bj)
#pragma unroll
            for (int n = 0; n < 2; ++n) { const int c = col0 + bj * 128 + n * 16;
                const f32x4 gate = *(const f32x4*)(modb + 2048 + c), sc2 = *(const f32x4*)(modb + 4096 + c), gg = *(const f32x4*)(g2 + c); const f32x4 mul = gg * (sc2 + 1.0f);
#pragma unroll
                for (int ai = 0; ai < 2; ++ai)
#pragma unroll
                    for (int m = 0; m < 4; ++m) { const size_t off = (size_t)(rowb + ai * 128 + m * 16) * D + c;
                        const f32x4 v = *(const f32x4*)(x + off) + gate * acc[ai][bj][m][n]; *(f32x4*)(x1 + off) = v;
                        ssr[ai][m] += (v[0] * v[0] + v[1] * v[1]) + (v[2] * v[2] + v[3] * v[3]);
                        const f32x4 a = v * mul; u32x2 w; w.x = pk2r(a[0], a[1]); w.y = pk2r(a[2], a[3]); *(u32x2*)(A2 + off) = w; } }
#pragma unroll
        for (int ai = 0; ai < 2; ++ai)
#pragma unroll
            for (int m = 0; m < 4; ++m) { float s = ssr[ai][m]; s += __shfl_xor(s, 16); s += __shfl_xor(s, 32);
                if (fq == 0) ssq[(size_t)(rowb + ai * 128 + m * 16) * 16 + u.pn * 4 + wc] = s; }
    }
};

struct EpiGU {
    static constexpr bool PERM = true, AFTER_DRAIN = false;
    bf16_t* HID; const float* ssq; const float* bias2;
    __device__ __forceinline__ void operator()(const f32x4 (&acc)[2][2][4][2], const Unit& u, int wr_, int wc_, int fr_, int fq_) const {
        EPI_LANES();
        const int b = u.pm >> 4, rowb = u.pm * 256 + wr * 64 + fr; const float* bb = bias2 + b * NGU + u.pn * 256 + wc * 32 + 8 * fq;
        const f32x4 ba0 = *(const f32x4*)(bb), ba1 = *(const f32x4*)(bb + 4), bu0 = *(const f32x4*)(bb + 128), bu1 = *(const f32x4*)(bb + 132);
#pragma unroll
        for (int ai = 0; ai < 2; ++ai)
#pragma unroll
            for (int m = 0; m < 4; ++m) { const int row = rowb + ai * 128 + m * 16; const f32x4* sp = (const f32x4*)(ssq + (size_t)row * 16);
                const f32x4 s0 = sp[0], s1 = sp[1], s2 = sp[2], s3 = sp[3]; const f32x4 st = (s0 + s1) + (s2 + s3);
                const float rstd = rsq(((st[0] + st[1]) + (st[2] + st[3])) * (1.0f / D) + EPS);
                const f32x4 a0 = acc[ai][0][m][0] * rstd + ba0, a1 = acc[ai][0][m][1] * rstd + ba1, u0 = acc[ai][1][m][0] * rstd + bu0, u1 = acc[ai][1][m][1] * rstd + bu1;
                float h[8];
#pragma unroll
                for (int j = 0; j < 4; ++j) { h[j] = silu(a0[j]) * u0[j]; h[4 + j] = silu(a1[j]) * u1[j]; }
                u32x4 w; w.x = pk2r(h[0], h[1]); w.y = pk2r(h[2], h[3]); w.z = pk2r(h[4], h[5]); w.w = pk2r(h[6], h[7]);
                *(u32x4*)(HID + (size_t)row * DFF + u.pn * 128 + wc * 32 + 8 * fq) = w; }
    }
};

struct EpiDown {
    static constexpr bool PERM = false, AFTER_DRAIN = false;
    float* xio; const float* mod;
    __device__ __forceinline__ void operator()(const f32x4 (&acc)[2][2][4][2], const Unit& u, int wr_, int wc_, int fr_, int fq_) const {
        EPI_LANES();
        const int b = u.pm >> 4, col0 = u.pn * 256 + wc * 32 + 4 * fq, rowb = u.pm * 256 + wr * 64 + fr; const float* modb = mod + b * NMOD;
#pragma unroll
        for (int bj = 0; bj < 2; ++bj)
#pragma unroll
            for (int n = 0; n < 2; ++n) { const int c = col0 + bj * 128 + n * 16; const f32x4 gate = *(const f32x4*)(modb + 5120 + c);
#pragma unroll
                for (int ai = 0; ai < 2; ++ai)
#pragma unroll
                    for (int m = 0; m < 4; ++m) { const size_t off = (size_t)(rowb + ai * 128 + m * 16) * D + c; *(f32x4*)(xio + off) = *(const f32x4*)(xio + off) + gate * acc[ai][bj][m][n]; } }
    }
};
}
namespace mk {
constexpr int NWAVES = 8;
constexpr size_t MiB = 1u << 20;
constexpr size_t WS_CTL = 0, CTL_ZERO_BYTES = 64 * 1024;
constexpr size_t WS_MODP = 1 * MiB;
constexpr size_t WS_MOD = 3 * MiB, WS_LB = WS_MOD + 256 * 1024, WS_BIAS2 = WS_MOD + 512 * 1024;
constexpr size_t WS_WIN = 4 * MiB, WS_WOUT = 11 * MiB, WS_WGU = 13 * MiB, WS_WD = 24 * MiB;
constexpr size_t WS_DEC = 30 * MiB, WS_LSE = 31 * MiB, WS_SSQ1 = 34 * MiB;
constexpr size_t WS_BUFA = 40 * MiB;
constexpr size_t WS_BUFB = 104 * MiB;
constexpr size_t WS_R = 168 * MiB;
constexpr size_t WS_QT = WS_R, WS_KT = WS_R + 32 * MiB, WS_VH = WS_R + 64 * MiB, WS_SG = WS_R + 96 * MiB, WS_AQ = WS_R + 128 * MiB, WS_AK = WS_R + 160 * MiB, WS_AV = WS_R + 192 * MiB;
constexpr size_t WS_ST = WS_BUFA;
constexpr size_t WS_ATT0 = WS_R + 224 * MiB, WS_ATT1 = WS_R + 256 * MiB, WS_ATT2 = WS_R + 288 * MiB;
constexpr size_t WS_HID = WS_R;
constexpr size_t WS_END = WS_R + 320 * MiB;
constexpr int CW_BAR = 4096;
constexpr int RING_BYTES = 131072, LDSCTL_OFF = RING_BYTES, MISC_OFF = LDSCTL_OFF + 320, LDS_BYTES = 147456;

__device__ __forceinline__ const float* karg_ptr(int i) {
    asm volatile("" : "+s"(i));
    typedef const float* cfp;
    const __attribute__((address_space(4))) cfp* ka = (const __attribute__((address_space(4))) cfp*)__builtin_amdgcn_kernarg_segment_ptr();
    return ka[i];
}

__device__ __forceinline__ void transpose_item(const float* W, int K, int N, bf16* WT, int mode, LAS float* scr, int item, int lane) {
    const int nblk = N / 32, kb = item / nblk, nb = item % nblk, k0 = 64 * kb, n0 = 32 * nb;
    int r0 = n0;
    if (mode == 1) { if (n0 < 512) r0 = (n0 >> 7) * 256 + (n0 & 127); else if (n0 < 1024) r0 = ((n0 - 512) >> 7) * 256 + 128 + (n0 & 127); }
    if (mode == 2) { if (n0 < DFF) r0 = (n0 >> 7) * 256 + (n0 & 127); else r0 = ((n0 - DFF) >> 7) * 256 + 128 + ((n0 - DFF) & 127); }
#pragma unroll 8
    for (int i = 0; i < 32; ++i) { const int kk = 2 * i + (lane >> 5); scr[kk * 33 + (lane & 31)] = W[(size_t)(k0 + kk) * N + n0 + (lane & 31)]; }
    LDS_WAIT(); asm volatile("" ::: "memory");
    const int c = lane & 7;
#pragma unroll
    for (int j = 0; j < 4; ++j) { const int n = (lane >> 3) + 8 * j; const LAS float* s = scr + (8 * c) * 33 + n;
        v4u o; o.x = pk2(s[0 * 33], s[1 * 33]); o.y = pk2(s[2 * 33], s[3 * 33]); o.z = pk2(s[4 * 33], s[5 * 33]); o.w = pk2(s[6 * 33], s[7 * 33]);
        *(GAS v4u*)(WT + (size_t)(r0 + n) * K + k0 + 8 * c) = o; }
    LDS_WAIT(); asm volatile("" ::: "memory");
}
__device__ __forceinline__ void mod_partial(const float* Pc, const float* Pw_ada, float* modp, LAS float* scr, int it, int lane) {
    const int cg = it % 96, ks = it / 96, n = cg * 64 + lane;
#pragma unroll
    for (int i = 0; i < 16; ++i) { const int idx = i * 64 + lane, kk = idx & 127, b = idx >> 7; scr[kk * 8 + b] = silu(Pc[b * D + ks * 128 + kk]); }
    LDS_WAIT(); asm volatile("" ::: "memory");
    float acc[8];
#pragma unroll
    for (int b = 0; b < 8; ++b) acc[b] = 0.f;
    const float* wp = Pw_ada + (size_t)(ks * 128) * NMOD + n;
#pragma unroll 16
    for (int kk = 0; kk < 128; ++kk) { const float w = wp[(size_t)kk * NMOD]; const f32x4 c0 = *(const LAS f32x4*)(scr + kk * 8), c1 = *(const LAS f32x4*)(scr + kk * 8 + 4);
        acc[0] += c0[0] * w; acc[1] += c0[1] * w; acc[2] += c0[2] * w; acc[3] += c0[3] * w; acc[4] += c1[0] * w; acc[5] += c1[1] * w; acc[6] += c1[2] * w; acc[7] += c1[3] * w; }
#pragma unroll
    for (int b = 0; b < 8; ++b) modp[(size_t)(ks * 8 + b) * NMOD + n] = acc[b];
    LDS_WAIT(); asm volatile("" ::: "memory");
}
__device__ __forceinline__ float wsum64(float v) {
#pragma unroll
    for (int o = 1; o < 64; o <<= 1) v += __shfl_xor(v, o);
    return v;
}
__device__ __forceinline__ float wmax64(float v) {
#pragma unroll
    for (int o = 1; o < 64; o <<= 1) v = fmaxf(v, __shfl_xor(v, o));
    return v;
}

typedef short s16x4v __attribute__((ext_vector_type(4)));
#define LBAR() asm volatile("s_waitcnt lgkmcnt(0)\n\ts_barrier" ::: "memory")
#define TOPBAR() asm volatile("s_waitcnt vmcnt(0) lgkmcnt(0)\n\ts_barrier" ::: "memory")
#define TOUCH(x) asm volatile("" : "+v"(x))
__device__ __forceinline__ void glds16(const void* gsrc, unsigned lds_dst) { unsigned keep;
    asm volatile("s_mov_b32 %0, m0\n\ts_mov_b32 m0, %2\n\ts_nop 0\n\tglobal_load_lds_dwordx4 %1, off\n\ts_mov_b32 m0, %0" : "=&s"(keep) : "v"(gsrc), "s"(lds_dst) : "memory"); }
__device__ __forceinline__ unsigned lds_addr(const LAS unsigned char* p) { return (unsigned)(size_t)p; }
template <int SW> __device__ __forceinline__ int swz(int R) { return SW == 0 ? (R & 15) : SW == 1 ? (((R & 3) << 1) | (((R >> 3) & 1) << 3)) : ((R & 7) << 1); }
template <int SW> __device__ __forceinline__ void tile_dma(LAS unsigned char* lds, int to, const bf16* src, size_t tok0, int col0, int wave, int lane) {
#pragma unroll
    for (int pi = 0; pi < 2; ++pi) { const int piece = wave + 8 * pi, R = 4 * piece + (lane >> 4); const int gch = (lane & 15) ^ swz<SW>(R);
        glds16(src + (tok0 + R) * 512 + col0 + gch * 8, (unsigned)__builtin_amdgcn_readfirstlane(lds_addr(lds) + to + piece * 1024)); }
}
template <int SW> __device__ __forceinline__ bf16x8 tr_frag(const LAS unsigned char* tile, int r0a, int r0b, int c0, int i16) {
    const int q = i16 >> 2, ch = (c0 >> 3) + ((i16 & 3) >> 1), bo = (i16 & 1) * 8; const int Ra = r0a + q, Rb = r0b + q;
    const s16x4v va = __builtin_amdgcn_ds_read_tr16_b64_v4i16((LAS s16x4v*)(tile + Ra * 256 + ((ch ^ swz<SW>(Ra)) << 4) + bo));
    const s16x4v vb = __builtin_amdgcn_ds_read_tr16_b64_v4i16((LAS s16x4v*)(tile + Rb * 256 + ((ch ^ swz<SW>(Rb)) << 4) + bo));
    return (bf16x8){va[0], va[1], va[2], va[3], vb[0], vb[1], vb[2], vb[3]};
}
__device__ __forceinline__ bf16x8 row_frag(const LAS unsigned char* tile, int R, int ch) { return *(const LAS bf16x8*)(tile + R * 256 + ((ch ^ (R & 15)) << 4)); }

__device__ __forceinline__ void hgrn_scan(LAS unsigned char* lds, const bf16* KT, const bf16* VH, const float* DEC, bf16* ST, int bh, int wave, int lane) {
    const int b = bh >> 2, h = bh & 3, i16 = lane & 15, g4 = lane >> 4; const size_t tokb = (size_t)b * S;
    f32x4 acc[8];
#pragma unroll
    for (int vt = 0; vt < 8; ++vt) acc[vt] = (f32x4){0.f, 0.f, 0.f, 0.f};
    tile_dma<1>(lds, 0, KT, tokb, h * 128, wave, lane); tile_dma<1>(lds, 16384, VH, tokb, h * 128, wave, lane);
    f32x4 dvn = *(const f32x4*)(DEC + ((size_t)(b * 64) * 512 + h * 128 + 16 * wave + 4 * g4));
    for (int c = 0; c < 63; ++c) {
        const int cur = c & 1;
        TOPBAR();
        TOUCH(dvn); const f32x4 dv = dvn;
        if (c + 1 < 63) { tile_dma<1>(lds, (cur ^ 1) * 32768, KT, tokb + 64 * (c + 1), h * 128, wave, lane); tile_dma<1>(lds, (cur ^ 1) * 32768 + 16384, VH, tokb + 64 * (c + 1), h * 128, wave, lane);
            dvn = *(const f32x4*)(DEC + ((size_t)(b * 64 + c + 1) * 512 + h * 128 + 16 * wave + 4 * g4)); }
        const LAS unsigned char* Kt = lds + cur * 32768; const LAS unsigned char* Vt = Kt + 16384;
#pragma unroll
        for (int ks = 0; ks < 2; ++ks) { const int r0 = 32 * ks + 8 * g4;
            const bf16x8 af = tr_frag<1>(Kt, r0, r0 + 4, 16 * wave, i16);
#pragma unroll
            for (int vt = 0; vt < 8; ++vt) { const bf16x8 bfv = tr_frag<1>(Vt, r0, r0 + 4, 16 * vt, i16);
                acc[vt] = __builtin_amdgcn_mfma_f32_16x16x32_bf16(af, bfv, acc[vt], 0, 0, 0); } }
        bf16* sp = ST + (((size_t)(bh * 64 + c) * 128 + i16) * 128 + 16 * wave + 4 * g4);
#pragma unroll
        for (int vt = 0; vt < 8; ++vt) { acc[vt] = acc[vt] * dv;
            u32x2 w; w.x = pk2r(acc[vt][0], acc[vt][1]); w.y = pk2r(acc[vt][2], acc[vt][3]); *(u32x2*)(sp + (size_t)vt * 16 * 128) = w; }
    }
    __syncthreads();
}

__device__ __forceinline__ void hgrn_out_units(LAS unsigned char* lds, const bf16* QT, const bf16* KT, const bf16* VH, const bf16* SG, const bf16* ST, const float* hg_on, bf16* MIXIN, int wave, int lane, int ulo, int uhi) {
    const int i16 = lane & 15, g4 = lane >> 4;
    LAS unsigned char* Pl = lds + 98304; LAS float* ssq = (LAS float*)(lds + 106496);
    bf16x8 san[4];
    { const int bh = ulo >> 6, c = ulo & 63, b = bh >> 2, h = bh & 3; const size_t tok0 = (size_t)b * S + 64 * c;
      tile_dma<0>(lds, 0, QT, tok0, h * 128, wave, lane); tile_dma<0>(lds, 16384, KT, tok0, h * 128, wave, lane); tile_dma<2>(lds, 32768, VH, tok0, h * 128, wave, lane);
      if (c > 0) { const bf16* sp = ST + (((size_t)(bh * 64 + c - 1) * 128 + 16 * wave + i16) * 128 + 8 * g4);
#pragma unroll
          for (int ks = 0; ks < 4; ++ks) san[ks] = *(const bf16x8*)(sp + 32 * ks); }
      else {
#pragma unroll
          for (int ks = 0; ks < 4; ++ks) san[ks] = (bf16x8){0, 0, 0, 0, 0, 0, 0, 0}; } }
    for (int u = ulo; u < uhi; ++u) {
        const int cur = (u - ulo) & 1; const int bh = u >> 6, c = u & 63, b = bh >> 2, h = bh & 3; const size_t tok0 = (size_t)b * S + 64 * c;
        TOPBAR();
        TOUCH(san[0]); TOUCH(san[1]); TOUCH(san[2]); TOUCH(san[3]);
        const bf16x8 sa[4] = {san[0], san[1], san[2], san[3]};
        if (u + 1 < uhi) { const int bh2 = (u + 1) >> 6, c2 = (u + 1) & 63; const size_t t2 = (size_t)(bh2 >> 2) * S + 64 * c2; const int h2 = bh2 & 3, o2 = (cur ^ 1) * 49152;
            tile_dma<0>(lds, o2, QT, t2, h2 * 128, wave, lane); tile_dma<0>(lds, o2 + 16384, KT, t2, h2 * 128, wave, lane); tile_dma<2>(lds, o2 + 32768, VH, t2, h2 * 128, wave, lane);
            if (c2 > 0) { const bf16* sp = ST + (((size_t)(bh2 * 64 + c2 - 1) * 128 + 16 * wave + i16) * 128 + 8 * g4);
#pragma unroll
                for (int ks = 0; ks < 4; ++ks) san[ks] = *(const bf16x8*)(sp + 32 * ks); }
            else {
#pragma unroll
                for (int ks = 0; ks < 4; ++ks) san[ks] = (bf16x8){0, 0, 0, 0, 0, 0, 0, 0}; } }
        const LAS unsigned char* Qt = lds + cur * 49152; const LAS unsigned char* Kt = Qt + 16384; const LAS unsigned char* Vt = Qt + 32768;
#pragma unroll
        for (int q = 0; q < 2; ++q) { const int id = 2 * wave + q, si = id >> 2, ti = id & 3; f32x4 a = {0.f, 0.f, 0.f, 0.f};
            if (si <= ti) {
#pragma unroll
                for (int ks = 0; ks < 4; ++ks) a = __builtin_amdgcn_mfma_f32_16x16x32_bf16(row_frag(Kt, 16 * si + i16, g4 + 4 * ks), row_frag(Qt, 16 * ti + i16, g4 + 4 * ks), a, 0, 0, 0);
                if (si == ti) {
#pragma unroll
                    for (int reg = 0; reg < 4; ++reg) if (4 * g4 + reg > i16) a[reg] = 0.f; } }
            u32x2 w; w.x = pk2r(a[0], a[1]); w.y = pk2r(a[2], a[3]); *(LAS u32x2*)(Pl + id * 512 + lane * 8) = w; }
        LBAR();
        f32x4 o[4];
#pragma unroll
        for (int tt = 0; tt < 4; ++tt) { o[tt] = (f32x4){0.f, 0.f, 0.f, 0.f};
#pragma unroll
            for (int ks = 0; ks < 4; ++ks) o[tt] = __builtin_amdgcn_mfma_f32_16x16x32_bf16(sa[ks], row_frag(Qt, 16 * tt + i16, g4 + 4 * ks), o[tt], 0, 0, 0);
#pragma unroll
            for (int kp = 0; kp < 2; ++kp) { if (2 * kp <= tt) {
                    const u32x2 pa = *(const LAS u32x2*)(Pl + ((2 * kp) * 4 + tt) * 512 + lane * 8), pb = *(const LAS u32x2*)(Pl + ((2 * kp + 1) * 4 + tt) * 512 + lane * 8);
                    const v4u pw = {pa.x, pa.y, pb.x, pb.y};
                    const bf16x8 vf = tr_frag<2>(Vt, 32 * kp + 4 * g4, 32 * kp + 16 + 4 * g4, 16 * wave, i16);
                    o[tt] = __builtin_amdgcn_mfma_f32_16x16x32_bf16(vf, __builtin_bit_cast(bf16x8, pw), o[tt], 0, 0, 0); } } }
#pragma unroll
        for (int tt = 0; tt < 4; ++tt) { float ss = (o[tt][0] * o[tt][0] + o[tt][1] * o[tt][1]) + (o[tt][2] * o[tt][2] + o[tt][3] * o[tt][3]); ss += __shfl_xor(ss, 16); ss += __shfl_xor(ss, 32);
            if (g4 == 0) ssq[wave * 64 + 16 * tt + i16] = ss; }
        LBAR();
        const f32x4 gon = *(const f32x4*)(hg_on + 16 * wave + 4 * g4);
#pragma unroll
        for (int tt = 0; tt < 4; ++tt) { float tot = 0.f;
#pragma unroll
            for (int w8 = 0; w8 < 8; ++w8) tot += ssq[w8 * 64 + 16 * tt + i16];
            const float rstd = rsq(tot * (1.f / 128.f) + EPS);
            const size_t tok = tok0 + 16 * tt + i16; const int col = h * 128 + 16 * wave + 4 * g4;
            const u32x2 sg = *(const u32x2*)(SG + tok * 512 + col);
            u32x2 w; w.x = pk2r(o[tt][0] * rstd * gon[0] * bflo(sg.x), o[tt][1] * rstd * gon[1] * bfhi(sg.x)); w.y = pk2r(o[tt][2] * rstd * gon[2] * bflo(sg.y), o[tt][3] * rstd * gon[3] * bfhi(sg.y));
            *(u32x2*)(MIXIN + tok * D + col) = w; }
    }
    __syncthreads();
}

struct AttU { int b, h, dsh, r, n, br; };
__device__ __forceinline__ AttU att_decode(int g) {
    AttU U; const int bh = g / 96, u = g % 96; U.b = bh >> 3; U.h = bh & 7;
    if (u < 32) { U.dsh = 0; U.r = 0; U.n = u; U.br = 0; }
    else if (u < 64) { U.dsh = 2; U.r = (u - 32) >> 3; U.n = (u - 32) & 7; U.br = 1; }
    else { U.dsh = 4; U.r = (u - 64) >> 1; U.n = (u - 64) & 1; U.br = 2; }
    return U;
}
__device__ __forceinline__ void att_dma(LAS unsigned char* lds, int bufo, const bf16* AK, const bf16* AV, const AttU& U, int wave, int lane) {
    const int gch = (lane & 7) ^ (lane >> 3);
#pragma unroll
    for (int pi = 0; pi < 4; ++pi) { const int piece = wave + 8 * pi, row = piece * 8 + (lane >> 3); int m = 128 * (U.n - 1) + row; if (m < 0) m += 128;
        const size_t eoff = ((size_t)U.b * S + (size_t)((m << U.dsh) + U.r)) * 512 + U.h * 64 + gch * 8;
        glds16(AK + eoff, (unsigned)__builtin_amdgcn_readfirstlane(lds_addr(lds) + bufo + piece * 1024));
        glds16(AV + eoff, (unsigned)__builtin_amdgcn_readfirstlane(lds_addr(lds) + bufo + 32768 + piece * 1024)); }
}
__device__ __forceinline__ void attn_units(LAS unsigned char* lds, const bf16* AQ, const bf16* AK, const bf16* AV, unsigned char* ws, float* LSE, int wave, int lane, int glo, int ghi) {
    const int i16 = lane & 15, g4 = lane >> 4;
    AttU U = att_decode(glo);
    att_dma(lds, 0, AK, AV, U, wave, lane);
    bf16x8 qn0, qn1;
    { const bf16* qp = AQ + (((size_t)U.b * S + (size_t)(((128 * U.n + 16 * wave + i16) << U.dsh) + U.r)) * 512 + U.h * 64 + 8 * g4); qn0 = *(const bf16x8*)qp; qn1 = *(const bf16x8*)(qp + 32); }
    for (int gu = glo; gu < ghi; ++gu) {
        const int cur = (gu - glo) & 1; const AttU C = U;
        TOPBAR();
        TOUCH(qn0); TOUCH(qn1); const bf16x8 qf0 = qn0, qf1 = qn1;
        if (gu + 1 < ghi) { U = att_decode(gu + 1); att_dma(lds, (cur ^ 1) * 65536, AK, AV, U, wave, lane);
            const bf16* qp = AQ + (((size_t)U.b * S + (size_t)(((128 * U.n + 16 * wave + i16) << U.dsh) + U.r)) * 512 + U.h * 64 + 8 * g4); qn0 = *(const bf16x8*)qp; qn1 = *(const bf16x8*)(qp + 32); }
        const LAS unsigned char* Kb = lds + cur * 65536; const LAS unsigned char* Vb = Kb + 32768;
        f32x4 st[9];
#pragma unroll
        for (int t = 0; t < 9; ++t) { const int R = 16 * (wave + t) + i16; const LAS unsigned char* kp = Kb + R * 128;
            const bf16x8 a0 = *(const LAS bf16x8*)(kp + ((g4 ^ (R & 7)) << 4)), a1 = *(const LAS bf16x8*)(kp + (((g4 + 4) ^ (R & 7)) << 4));
            f32x4 z = {0.f, 0.f, 0.f, 0.f};
            z = __builtin_amdgcn_mfma_f32_16x16x32_bf16(a0, qf0, z, 0, 0, 0); st[t] = __builtin_amdgcn_mfma_f32_16x16x32_bf16(a1, qf1, z, 0, 0, 0); }
        const int qi = 16 * wave + i16; const float NEG = -INFINITY;
#pragma unroll
        for (int reg = 0; reg < 4; ++reg) { const int kj0 = 16 * wave + 4 * g4 + reg; if (kj0 < qi) st[0][reg] = NEG; if (kj0 + 128 > qi + 128) st[8][reg] = NEG; }
        if (C.n == 0) {
#pragma unroll
            for (int t = 0; t < 8; ++t)
#pragma unroll
                for (int reg = 0; reg < 4; ++reg) { if (16 * (wave + t) + 4 * g4 + reg < 128) st[t][reg] = NEG; } }
        float mx = st[0][0];
#pragma unroll
        for (int t = 0; t < 9; ++t)
#pragma unroll
            for (int reg = 0; reg < 4; ++reg) mx = fmaxf(mx, st[t][reg]);
        mx = fmaxf(mx, __shfl_xor(mx, 16)); mx = fmaxf(mx, __shfl_xor(mx, 32));
        float l = 0.f;
#pragma unroll
        for (int t = 0; t < 9; ++t)
#pragma unroll
            for (int reg = 0; reg < 4; ++reg) { const float pv = ex2(st[t][reg] - mx); st[t][reg] = pv; l += pv; }
        l += __shfl_xor(l, 16); l += __shfl_xor(l, 32);
        f32x4 o[4];
#pragma unroll
        for (int et = 0; et < 4; ++et) o[et] = (f32x4){0.f, 0.f, 0.f, 0.f};
#pragma unroll
        for (int ks = 0; ks < 5; ++ks) {
            const int ta = 2 * ks, tb = (ks < 4) ? 2 * ks + 1 : 2 * ks;
            v4u pw; pw.x = pk2r(st[ta][0], st[ta][1]); pw.y = pk2r(st[ta][2], st[ta][3]);
            if (ks < 4) { pw.z = pk2r(st[tb][0], st[tb][1]); pw.w = pk2r(st[tb][2], st[tb][3]); } else { pw.z = 0u; pw.w = 0u; }
            const bf16x8 pf = __builtin_bit_cast(bf16x8, pw);
            const int Ra = 16 * (wave + ta) + 4 * g4 + (i16 >> 2), Rb = 16 * (wave + tb) + 4 * g4 + (i16 >> 2);
#pragma unroll
            for (int et = 0; et < 4; ++et) { const int ch = 2 * et + ((i16 & 3) >> 1), bo = (i16 & 1) * 8;
                const s16x4v va = __builtin_amdgcn_ds_read_tr16_b64_v4i16((LAS s16x4v*)(Vb + Ra * 128 + ((ch ^ (Ra & 7)) << 4) + bo));
                const s16x4v vb = __builtin_amdgcn_ds_read_tr16_b64_v4i16((LAS s16x4v*)(Vb + Rb * 128 + ((ch ^ (Rb & 7)) << 4) + bo));
                const bf16x8 vf = {va[0], va[1], va[2], va[3], vb[0], vb[1], vb[2], vb[3]};
                o[et] = __builtin_amdgcn_mfma_f32_16x16x32_bf16(vf, pf, o[et], 0, 0, 0); }
        }
        const float il = rcp(l);
        const size_t orow = (size_t)C.b * S + (size_t)(((128 * C.n + qi) << C.dsh) + C.r);
        bf16* AO = (bf16*)(ws + (C.br == 0 ? WS_ATT0 : C.br == 1 ? WS_ATT1 : WS_ATT2)) + orow * 512 + C.h * 64 + 4 * g4;
#pragma unroll
        for (int et = 0; et < 4; ++et) { u32x2 w; w.x = pk2r(o[et][0] * il, o[et][1] * il); w.y = pk2r(o[et][2] * il, o[et][3] * il); *(u32x2*)(AO + 16 * et) = w; }
        if (g4 == 0) LSE[(size_t)C.br * T * 8 + orow * 8 + C.h] = mx + lg2(l);
    }
    __syncthreads();
}

struct Args { const float* in[14]; float* out; unsigned char* ws; };
__global__ void __launch_bounds__(NWAVES * 64, 2) mk_fwd(Args args) {
    extern __shared__ __attribute__((aligned(16))) unsigned char lds_raw[];
    LAS unsigned char* lds = (LAS unsigned char*)lds_raw;
    volatile LAS unsigned* MISC = (volatile LAS unsigned*)(lds + MISC_OFF);
    const int wave = __builtin_amdgcn_readfirstlane(threadIdx.x >> 6);
    const int G = gridDim.x, bx = blockIdx.x; const int vcu = (G % 8 == 0) ? (bx % 8) * (G / 8) + bx / 8 : bx;
    const int gw = vcu * NWAVES + wave, NGW = G * NWAVES;
    (void)args;
#define INP(i) karg_ptr(i)
#define P_x INP(0)
#define P_c INP(1)
#define P_w_ada INP(2)
#define P_b_ada INP(3)
#define P_g1 INP(4)
#define P_w_in INP(5)
#define P_lbl INP(6)
#define P_hg_on INP(7)
#define P_att_on INP(8)
#define P_w_out INP(9)
#define P_g2 INP(10)
#define P_w_gu INP(11)
#define P_w_down INP(12)
#define P_gf INP(13)
#define P_out ((float*)INP(14))
    unsigned char* const ws = (unsigned char*)INP(15);
    gu32* ctl = (gu32*)(ws + WS_CTL);
#define MODP ((float*)(ws + WS_MODP))
#define MOD ((float*)(ws + WS_MOD))
#define LB ((float*)(ws + WS_LB))
#define BIAS2 ((float*)(ws + WS_BIAS2))
#define WIN_T ((bf16*)(ws + WS_WIN))
#define WOUT_T ((bf16*)(ws + WS_WOUT))
#define WGU_T ((bf16*)(ws + WS_WGU))
#define WD_T ((bf16*)(ws + WS_WD))
#define DEC ((float*)(ws + WS_DEC))
#define LSE ((float*)(ws + WS_LSE))
#define SSQ1 ((float*)(ws + WS_SSQ1))
#define XN ((bf16*)(ws + WS_BUFA))
#define A2 ((bf16*)(ws + WS_BUFA))
#define MIXIN ((bf16*)(ws + WS_BUFB))
#define QT ((bf16*)(ws + WS_QT))
#define KT ((bf16*)(ws + WS_KT))
#define VH ((bf16*)(ws + WS_VH))
#define SG ((bf16*)(ws + WS_SG))
#define AQ ((bf16*)(ws + WS_AQ))
#define AK ((bf16*)(ws + WS_AK))
#define AV ((bf16*)(ws + WS_AV))
#define STB ((bf16*)(ws + WS_ST))
#define HID ((bf16*)(ws + WS_HID))
#define PHASE_TID() int lane; asm volatile("v_mbcnt_lo_u32_b32 %0, -1, 0\n\tv_mbcnt_hi_u32_b32 %0, -1, %0" : "=&v"(lane)); const int tid = wave * 64 + lane; (void)tid;

    for (int u = threadIdx.x; u < (LDS_BYTES - LDSCTL_OFF) / 4; u += NWAVES * 64) ((LAS unsigned*)(lds + LDSCTL_OFF))[u] = 0u;
    __syncthreads();
    XcdBarrier bar = xcd_barrier_post((unsigned*)(ctl + CW_BAR), MISC + 8);

    {   PHASE_TID();
        LAS float* scr = (LAS float*)(lds + wave * 16384);
        constexpr int I_MOD = 768, I_IN = 16 * (INW / 32), I_OUT = 16 * (D / 32), I_GU = 16 * (NGU / 32), I_DN = (DFF / 64) * (D / 32);
        constexpr int NTASK = I_MOD + I_IN + I_OUT + I_GU + I_DN + 1;
        for (int it = gw; it < NTASK; it += NGW) {
            int r = it;
            if (r < I_MOD) { mod_partial(P_c, P_w_ada, MODP, scr, r, lane); continue; } r -= I_MOD;
            if (r < I_IN) { transpose_item(P_w_in, D, INW, WIN_T, 1, scr, r, lane); continue; } r -= I_IN;
            if (r < I_OUT) { transpose_item(P_w_out, D, D, WOUT_T, 0, scr, r, lane); continue; } r -= I_OUT;
            if (r < I_GU) { transpose_item(P_w_gu, D, NGU, WGU_T, 2, scr, r, lane); continue; } r -= I_GU;
            if (r < I_DN) { transpose_item(P_w_down, DFF, D, WD_T, 0, scr, r, lane); continue; }
#pragma unroll
            for (int i = 0; i < 8; ++i) { const int j = lane + 64 * i; LB[j] = rcp(1.f + ex2((P_lbl[512 + j] - P_lbl[j]) * LOG2E)); }
        }
    }
    xcd_barrier(bar);

    {   PHASE_TID();
        LAS float* ms = (LAS float*)lds; LAS float* sh = ms + D;
        if (tid < 192) { const int idx = bx * 192 + tid; const int b = idx / NMOD, n = idx % NMOD; float v = P_b_ada[n];
#pragma unroll
            for (int ks = 0; ks < 8; ++ks) v += MODP[(size_t)(ks * 8 + b) * NMOD + n];
            MOD[idx] = v; }
        const int rows_per = T / G, row0 = bx * rows_per, b = row0 / S;
#pragma unroll
        for (int i = 0; i < 2; ++i) { const int k = tid + 512 * i; float s1 = P_b_ada[k], c1 = P_b_ada[1024 + k];
#pragma unroll
            for (int ks = 0; ks < 8; ++ks) { s1 += MODP[(size_t)(ks * 8 + b) * NMOD + k]; c1 += MODP[(size_t)(ks * 8 + b) * NMOD + 1024 + k]; }
            ms[k] = P_g1[k] * (1.f + c1); sh[k] = s1; }
        __syncthreads();
        for (int r = wave; r < rows_per; r += NWAVES) {
            const int row = row0 + r; const GAS f32x4* xr = (const GAS f32x4*)(P_x + (size_t)row * D) + lane;
            f32x4 v[4]; float s = 0.f;
#pragma unroll
            for (int j = 0; j < 4; ++j) { v[j] = xr[64 * j]; s += (v[j].x * v[j].x + v[j].y * v[j].y) + (v[j].z * v[j].z + v[j].w * v[j].w); }
            const float rstd = rsq(wsum64(s) * (1.f / D) + EPS);
            GAS unsigned long long* o8 = (GAS unsigned long long*)(XN + (size_t)row * D) + lane;
#pragma unroll
            for (int j = 0; j < 4; ++j) { const f32x4 m4 = *(const LAS f32x4*)(ms + 256 * j + 4 * lane), s4 = *(const LAS f32x4*)(sh + 256 * j + 4 * lane); const f32x4 o = v[j] * rstd * m4 + s4;
                o8[64 * j] = (unsigned long long)pk2(o.x, o.y) | ((unsigned long long)pk2(o.z, o.w) << 32); }
        }
    }
    xcd_barrier(bar);

    {
        pg8::Gemm g{XN, WIN_T, T, INW, D}; pg8::StaticOrder So; So.init(T, INW, G, bx);
        EpiIn E{QT, KT, VH, SG, AQ, AK, AV, DEC, LB};
        pg8::gemm_phase<EpiIn, pg8::StaticOrder, true, true>(lds, g, So, E, wave);
    }
    xcd_barrier(bar);

    if (vcu < 32) {   PHASE_TID();
        hgrn_scan(lds, KT, VH, DEC, STB, vcu, wave, lane);
    }
    {   PHASE_TID();
        attn_units(lds, AQ, AK, AV, ws, LSE, wave, lane, vcu * 24, vcu * 24 + 24);
    }
    xcd_barrier(bar);

    {   PHASE_TID();
        hgrn_out_units(lds, QT, KT, VH, SG, STB, P_hg_on, MIXIN, wave, lane, vcu * 8, vcu * 8 + 8);
        for (int t = gw; t < T; t += NGW) {
            const int c8 = lane * 8;
            {   const int h = lane >> 3;
                const float l0 = LSE[(size_t)t * 8 + h], l1 = LSE[(size_t)T * 8 + (size_t)t * 8 + h], l2 = LSE[(size_t)2 * T * 8 + (size_t)t * 8 + h];
                const float mx = fmaxf(l0, fmaxf(l1, l2)); float w0 = ex2(l0 - mx), w1 = ex2(l1 - mx), w2 = ex2(l2 - mx); const float inv = rcp(w0 + w1 + w2); w0 *= inv; w1 *= inv; w2 *= inv;
                const v4u a0 = *(const v4u*)((const bf16*)(ws + WS_ATT0) + (size_t)t * 512 + c8), a1 = *(const v4u*)((const bf16*)(ws + WS_ATT1) + (size_t)t * 512 + c8), a2 = *(const v4u*)((const bf16*)(ws + WS_ATT2) + (size_t)t * 512 + c8);
                float a[8];
                a[0] = w0 * bflo(a0.x) + w1 * bflo(a1.x) + w2 * bflo(a2.x); a[1] = w0 * bfhi(a0.x) + w1 * bfhi(a1.x) + w2 * bfhi(a2.x);
                a[2] = w0 * bflo(a0.y) + w1 * bflo(a1.y) + w2 * bflo(a2.y); a[3] = w0 * bfhi(a0.y) + w1 * bfhi(a1.y) + w2 * bfhi(a2.y);
                a[4] = w0 * bflo(a0.z) + w1 * bflo(a1.z) + w2 * bflo(a2.z); a[5] = w0 * bfhi(a0.z) + w1 * bfhi(a1.z) + w2 * bfhi(a2.z);
                a[6] = w0 * bflo(a0.w) + w1 * bflo(a1.w) + w2 * bflo(a2.w); a[7] = w0 * bfhi(a0.w) + w1 * bfhi(a1.w) + w2 * bfhi(a2.w);
                float ss = 0.f;
#pragma unroll
                for (int i = 0; i < 8; ++i) ss += a[i] * a[i];
                const float rstd = rsq(wsum64(ss) * (1.f / 512.f) + EPS);
                const f32x4 n0 = *(const f32x4*)(P_att_on + c8), n1 = *(const f32x4*)(P_att_on + c8 + 4);
#pragma unroll
                for (int i = 0; i < 4; ++i) { a[i] = a[i] * rstd * n0[i]; a[4 + i] = a[4 + i] * rstd * n1[i]; }
                v4u w; w.x = pk2(a[0], a[1]); w.y = pk2(a[2], a[3]); w.z = pk2(a[4], a[5]); w.w = pk2(a[6], a[7]);
                *(v4u*)(MIXIN + (size_t)t * D + 512 + c8) = w; }
        }
        __syncthreads();
        LAS float* sh2 = (LAS float*)lds;
        for (int i = tid; i < 8 * D; i += NWAVES * 64) sh2[i] = MOD[(i >> 10) * NMOD + 3072 + (i & 1023)];
        __syncthreads();
        const int ncol = NGU / G;
        for (int j = wave; j < ncol; j += NWAVES) { const int n = bx * ncol + j;
            const v4u w0 = *(const v4u*)(WGU_T + (size_t)n * D + lane * 16), w1 = *(const v4u*)(WGU_T + (size_t)n * D + lane * 16 + 8);
            const float wv[16] = {bflo(w0.x), bfhi(w0.x), bflo(w0.y), bfhi(w0.y), bflo(w0.z), bfhi(w0.z), bflo(w0.w), bfhi(w0.w), bflo(w1.x), bfhi(w1.x), bflo(w1.y), bfhi(w1.y), bflo(w1.z), bfhi(w1.z), bflo(w1.w), bfhi(w1.w)};
#pragma unroll
            for (int b = 0; b < 8; ++b) { float s = 0.f;
#pragma unroll
                for (int q4 = 0; q4 < 4; ++q4) { const f32x4 sv = *(const LAS f32x4*)(sh2 + b * D + lane * 16 + q4 * 4); s += wv[q4 * 4] * sv[0] + wv[q4 * 4 + 1] * sv[1] + wv[q4 * 4 + 2] * sv[2] + wv[q4 * 4 + 3] * sv[3]; }
                s = wsum64(s); if (lane == 0) BIAS2[b * NGU + n] = s; }
        }
        __syncthreads();
    }
    xcd_barrier(bar);

    {
        pg8::Gemm g{MIXIN, WOUT_T, T, D, D}; pg8::StaticOrder So; So.init(T, D, G, bx);
        EpiOut E{P_x, P_out, A2, SSQ1, MOD, P_g2};
        pg8::gemm_phase<EpiOut, pg8::StaticOrder, true, true>(lds, g, So, E, wave);
    }
    xcd_barrier(bar);

    {
        pg8::Gemm g{A2, WGU_T, T, NGU, D}; pg8::StaticOrder So; So.init(T, NGU, G, bx);
        EpiGU E{HID, SSQ1, BIAS2};
        pg8::gemm_phase<EpiGU, pg8::StaticOrder, true, true>(lds, g, So, E, wave);
    }
    xcd_barrier(bar);

    {
        pg8::Gemm g{HID, WD_T, T, D, DFF}; pg8::StaticOrder So; So.init(T, D, G, bx);
        EpiDown E{P_out, MOD};
        pg8::gemm_phase<EpiDown, pg8::StaticOrder, true, true>(lds, g, So, E, wave);
    }
    xcd_barrier(bar);

    PHASE_TID();
    for (int row = gw; row < T; row += NGW) {
        GAS f32x4* xr = (GAS f32x4*)(P_out + (size_t)row * D) + lane;
        f32x4 v[4]; float s = 0.f;
#pragma unroll
        for (int j = 0; j < 4; ++j) { v[j] = xr[64 * j]; s += (v[j].x * v[j].x + v[j].y * v[j].y) + (v[j].z * v[j].z + v[j].w * v[j].w); }
        const float rstd = rsq(wsum64(s) * (1.f / D) + EPS);
#pragma unroll
        for (int j = 0; j < 4; ++j) { const f32x4 g4 = *(const f32x4*)(P_gf + 256 * j + 4 * lane); xr[64 * j] = v[j] * rstd * g4; }
    }
}
}

extern "C" void kernel_launch(void* const* d_in, const int* in_sizes, int n_in, void* d_out, int out_size, void* d_ws, size_t ws_size, hipStream_t stream) {
    using namespace mk;
    static int grid = 0;
    if (grid == 0) {
        if (n_in != 14 || in_sizes[0] != T * D || out_size != T * D || ws_size < WS_END) { fprintf(stderr, "kernel_launch: unexpected shapes (n_in %d, in0 %d, out %d, ws %zu); nothing launched\n", n_in, n_in > 0 ? in_sizes[0] : -1, out_size, ws_size); grid = -1; return; }
        int dev = 0, cus = 0, per_cu = 0;
        if (hipGetDevice(&dev) != hipSuccess || hipDeviceGetAttribute(&cus, hipDeviceAttributeMultiprocessorCount, dev) != hipSuccess) { grid = -1; return; }
        if (hipFuncSetAttribute((const void*)mk_fwd, hipFuncAttributeMaxDynamicSharedMemorySize, LDS_BYTES) != hipSuccess) { fprintf(stderr, "kernel_launch: hipFuncSetAttribute failed\n"); grid = -1; return; }
        if (hipOccupancyMaxActiveBlocksPerMultiprocessor(&per_cu, (const void*)mk_fwd, NWAVES * 64, LDS_BYTES) != hipSuccess || per_cu < 1) { fprintf(stderr, "kernel_launch: occupancy query says %d blocks per CU\n", per_cu); per_cu = 1; }
        (void)hipGetLastError();
        grid = cus;
        if (grid != 256) { fprintf(stderr, "kernel_launch: this kernel is laid out for a 256-CU device, found %d CUs; nothing launched\n", grid); grid = -1; return; }
    }
    if (grid < 0) return;
    if (hipMemsetAsync((char*)d_ws + WS_CTL, 0, CTL_ZERO_BYTES, stream) != hipSuccess) { fprintf(stderr, "kernel_launch: hipMemsetAsync failed\n"); return; }
    Args a{};
    for (int i = 0; i < 14; ++i) a.in[i] = (const float*)d_in[i];
    a.out = (float*)d_out; a.ws = (unsigned char*)d_ws;
    hipLaunchKernelGGL(mk_fwd, dim3(grid), dim3(NWAVES * 64), LDS_BYTES, stream, a);
    const hipError_t le = hipPeekAtLastError();
    if (le != hipSuccess) fprintf(stderr, "kernel_launch: launch failed: %s\n", hipGetErrorName(le));
}
```

```cpp
#include <hip/hip_runtime.h>
#include <cstdio>
#include <cstdint>
namespace pg8 {
#define PG8_LAS __attribute__((address_space(3)))
typedef unsigned short bf16_t;
typedef short bf16x8 __attribute__((ext_vector_type(8)));
typedef float f32x4 __attribute__((ext_vector_type(4)));
typedef unsigned u32x4 __attribute__((ext_vector_type(4)));
constexpr int BM = 256, BK = 64, HALF = 128, HTB = HALF * BK * 2  , STAGE_BYTES = 8 * HTB, NXCD = 8, WGM = 8;

__host__ __device__ __forceinline__ int lds_byte(int r, int c) { const int st = (r >> 4) * 2 + (c >> 5), rr = r & 15, cc = c & 31, ob = rr * 64 + cc * 2; return st * 1024 + (ob ^ (((ob >> 9) & 1) << 5)); }
__host__ __device__ __forceinline__ void stage_rc(int b, int& R, int& C) { const int st = b / 1024, sb = b % 1024, swz = sb ^ (((sb >> 9) & 1) << 5); R = (st >> 1) * 16 + swz / 64; C = (st & 1) * 32 + (swz % 64) / 2; }
__host__ __device__ __forceinline__ int perm32(int rho) { const int n = rho >> 4, i = rho & 15; return 8 * (i >> 2) + 4 * n + (i & 3); }

struct Unit { int pm, pn; };
struct Gemm { const bf16_t* A; const bf16_t* Bt; int M, N, K; };

struct StaticOrder {
    int nM, nN, nwg, G, c;
    __host__ __device__ void init(int M, int N, int G_, int c_) { nM = M / BM; nN = N / BM; nwg = nM * nN; G = G_; c = c_; }
    __host__ __device__ bool next(int i, Unit& u) const {
        const long L = (long)i * G + c; if (L >= nwg) return false;
        int wgid = (int)L; { const int q = nwg / NXCD, r = nwg % NXCD, xcd = wgid % NXCD, off = wgid / NXCD; wgid = (xcd < r ? xcd * (q + 1) : r * (q + 1) + (xcd - r) * q) + off; }
        const int nig = WGM * nN, gid = wgid / nig, fm = gid * WGM, gsz = (nM - fm) < WGM ? (nM - fm) : WGM;
        u.pm = fm + ((wgid % nig) % gsz); u.pn = (wgid % nig) / gsz; return true;
    }
    __device__ __forceinline__ void a_ready(const Unit&) const {}
    __device__ __forceinline__ void done(const Unit&) const {}
};

__device__ __forceinline__ unsigned cvt_pk_bf16(float lo, float hi) { unsigned r; asm volatile("v_cvt_pk_bf16_f32 %0, %1, %2" : "=v"(r) : "v"(lo), "v"(hi)); return r; }
typedef float f32x2 __attribute__((ext_vector_type(2)));
template <class Epi, class Sched, bool ALIGN_EPI = false, bool SP2 = false>
__device__ __forceinline__ void gemm_phase(PG8_LAS unsigned char* lds, const Gemm g, const Sched& S, const Epi& E, const int wid_in  ) {
    int lane_o; asm volatile("v_mbcnt_lo_u32_b32 %0, -1, 0\n\tv_mbcnt_hi_u32_b32 %0, -1, %0" : "=&v"(lane_o));
    const int wid = wid_in, lane = lane_o, tid = wid * 64 + lane, wr = wid >> 2, wc = wid & 3, fr = lane & 15, fq = lane >> 4;
    const int K = g.K, nt = K / BK;
    unsigned voffA[2], voffB[2];
#pragma unroll
    for (int i = 0; i < 2; ++i) { int R, C; stage_rc(tid * 16 + i * 8192, R, C); const int Rb = Epi::PERM ? ((R & ~31) + perm32(R & 31)) : R;
        voffA[i] = (unsigned)(R * K + C) * 2u; voffB[i] = (unsigned)(Rb * K + C) * 2u; }
    const size_t kstep = (size_t)(BK * 2);
    const size_t hstep = (size_t)HALF * K * 2;
    const size_t tstep = 2 * hstep;
    const unsigned ldsw = (unsigned)wid * 1024u;
    const int aoff = lds_byte(wr * 64 + fr, fq * 8), boff = lds_byte(wc * 32 + fr, fq * 8);
#define PG8_SA(b, h) (((b) * 2 + (h)) * HTB)
#define PG8_SB(b, h) ((4 + (b) * 2 + (h)) * HTB)
#define PG8_STAGE(bufoff, gbase, voff) do { _Pragma("unroll") for (int _i = 0; _i < 2; ++_i) \
        __builtin_amdgcn_global_load_lds((const unsigned*)((const char*)(gbase) + (voff)[_i]), (PG8_LAS unsigned*)(lds + (bufoff) + ldsw + _i * 8192), 16, 0, 0); } while (0)
#define PG8_LDA(dst, b, h) do { _Pragma("unroll") for (int m = 0; m < 4; ++m) _Pragma("unroll") for (int k = 0; k < 2; ++k) dst[m][k] = *(const PG8_LAS bf16x8*)(lds + PG8_SA(b, h) + aoff + m * 2048 + k * 1024); } while (0)
#define PG8_LDB(dst, b, h) do { _Pragma("unroll") for (int n = 0; n < 2; ++n) _Pragma("unroll") for (int k = 0; k < 2; ++k) dst[n][k] = *(const PG8_LAS bf16x8*)(lds + PG8_SB(b, h) + boff + n * 2048 + k * 1024); } while (0)
#define PG8_MMA(ai, bj, At, Bt) do { __builtin_amdgcn_s_setprio(1); _Pragma("unroll") for (int m = 0; m < 4; ++m) _Pragma("unroll") for (int n = 0; n < 2; ++n) _Pragma("unroll") for (int k = 0; k < 2; ++k) \
        acc[ai][bj][m][n] = __builtin_amdgcn_mfma_f32_16x16x32_bf16(Bt[n][k], At[m][k], acc[ai][bj][m][n], 0, 0, 0); __builtin_amdgcn_s_setprio(0); } while (0)
#define PG8_WAIT_V(n) asm volatile("s_waitcnt vmcnt(" #n ")" ::: "memory")
#define PG8_WAIT_L(n) asm volatile("s_waitcnt lgkmcnt(" #n ")" ::: "memory")
#define PG8_BAR __builtin_amdgcn_s_barrier()
#define PG8_SCHED __builtin_amdgcn_sched_barrier(0)
    Unit cur, nxt; int ui = 0;
    if (!S.next(0, cur)) return;
    f32x4 acc[2][2][4][2];
#pragma unroll
    for (int a = 0; a < 2; ++a)
#pragma unroll
        for (int b = 0; b < 2; ++b)
#pragma unroll
            for (int m = 0; m < 4; ++m)
#pragma unroll
                for (int n = 0; n < 2; ++n) acc[a][b][m][n] = (f32x4){0.f, 0.f, 0.f, 0.f};
    bf16x8 At[4][2], B0[2][2], B1[2][2];
    const char* cA = (const char*)g.A + (size_t)cur.pm * tstep; const char* cB = (const char*)g.Bt + (size_t)cur.pn * tstep;
    S.a_ready(cur);
    if constexpr (SP2) {
        PG8_STAGE(PG8_SB(0, 0), cB, voffB); PG8_STAGE(PG8_SB(0, 1), cB + hstep, voffB); PG8_STAGE(PG8_SA(0, 0), cA, voffA); PG8_STAGE(PG8_SA(0, 1), cA + hstep, voffA);
        if (wr == 1) PG8_BAR;
        PG8_WAIT_V(2); PG8_BAR;
        PG8_STAGE(PG8_SB(1, 0), cB + kstep, voffB); PG8_STAGE(PG8_SA(1, 0), cA + kstep, voffA); PG8_STAGE(PG8_SB(1, 1), cB + hstep + kstep, voffB);
        PG8_WAIT_V(6); PG8_BAR;
    } else {
        PG8_STAGE(PG8_SB(0, 0), cB, voffB); PG8_STAGE(PG8_SA(0, 0), cA, voffA); PG8_STAGE(PG8_SB(0, 1), cB + hstep, voffB); PG8_STAGE(PG8_SA(0, 1), cA + hstep, voffA);
        if (wr == 1) PG8_BAR;
        PG8_WAIT_V(4); PG8_BAR;
        PG8_STAGE(PG8_SB(1, 0), cB + kstep, voffB); PG8_STAGE(PG8_SA(1, 0), cA + kstep, voffA); PG8_STAGE(PG8_SB(1, 1), cB + hstep + kstep, voffB);
        PG8_WAIT_V(6); PG8_BAR;
    }
    for (;;) {
        const bool has_next = S.next(ui + 1, nxt);
        const char* nA = has_next ? (const char*)g.A + (size_t)nxt.pm * tstep : cA; const char* nB = has_next ? (const char*)g.Bt + (size_t)nxt.pn * tstep : cB;
        for (int t = 0; t < nt; t += 2) {
            const bool last = (t == nt - 2);
            const char* a1 = cA + (size_t)(t + 1) * kstep;
            const char* a2 = last ? nA : cA + (size_t)(t + 2) * kstep; const char* b2 = last ? nB : cB + (size_t)(t + 2) * kstep;
            const char* a3 = a2 + kstep; const char* b3 = b2 + kstep;
            if (last && has_next) S.a_ready(nxt);
            if constexpr (SP2) {
            PG8_LDB(B0, 0, 0); PG8_LDB(B1, 0, 1); PG8_SCHED; PG8_LDA(At, 0, 0); PG8_STAGE(PG8_SA(1, 1), a1 + hstep, voffA);
            PG8_WAIT_V(8); PG8_WAIT_L(0); PG8_BAR; PG8_MMA(0, 0, At, B0); PG8_MMA(0, 1, At, B1); PG8_BAR; PG8_SCHED;
            PG8_LDA(At, 0, 1); PG8_STAGE(PG8_SB(0, 0), b2, voffB); PG8_STAGE(PG8_SB(0, 1), b2 + hstep, voffB); PG8_STAGE(PG8_SA(0, 0), a2, voffA);
            PG8_WAIT_V(8); PG8_WAIT_L(0); PG8_BAR; PG8_MMA(1, 0, At, B0); PG8_MMA(1, 1, At, B1); PG8_BAR; PG8_SCHED;
            PG8_LDB(B0, 1, 0); PG8_LDB(B1, 1, 1); PG8_SCHED; PG8_LDA(At, 1, 0); PG8_STAGE(PG8_SA(0, 1), a2 + hstep, voffA);
            PG8_WAIT_V(8); PG8_WAIT_L(0); PG8_BAR; PG8_MMA(0, 0, At, B0); PG8_MMA(0, 1, At, B1); PG8_BAR; PG8_SCHED;
            PG8_LDA(At, 1, 1); PG8_STAGE(PG8_SB(1, 0), b3, voffB); PG8_STAGE(PG8_SB(1, 1), b3 + hstep, voffB); PG8_STAGE(PG8_SA(1, 0), a3, voffA);
            PG8_WAIT_V(8); PG8_WAIT_L(0); PG8_BAR; PG8_MMA(1, 0, At, B0); PG8_MMA(1, 1, At, B1); PG8_BAR; PG8_SCHED;
            } else {
            PG8_LDB(B0, 0, 0); PG8_SCHED; PG8_LDA(At, 0, 0); PG8_STAGE(PG8_SA(1, 1), a1 + hstep, voffA);
            PG8_WAIT_L(8); PG8_BAR; PG8_WAIT_L(0); PG8_MMA(0, 0, At, B0); PG8_BAR; PG8_SCHED;
            PG8_LDB(B1, 0, 1); PG8_STAGE(PG8_SB(0, 0), b2, voffB);
            PG8_BAR; PG8_WAIT_L(0); PG8_MMA(0, 1, At, B1); PG8_BAR;
            PG8_LDA(At, 0, 1); PG8_STAGE(PG8_SA(0, 0), a2, voffA);
            PG8_BAR; PG8_WAIT_L(0); PG8_MMA(1, 0, At, B0); PG8_BAR; PG8_SCHED;
            PG8_STAGE(PG8_SB(0, 1), b2 + hstep, voffB);
            PG8_WAIT_V(6); PG8_BAR; PG8_MMA(1, 1, At, B1); PG8_BAR;
            PG8_LDB(B0, 1, 0); PG8_SCHED; PG8_LDA(At, 1, 0); PG8_STAGE(PG8_SA(0, 1), a2 + hstep, voffA);
            PG8_WAIT_L(8); PG8_BAR; PG8_WAIT_L(0); PG8_MMA(0, 0, At, B0); PG8_BAR; PG8_SCHED;
            PG8_LDB(B1, 1, 1); PG8_STAGE(PG8_SB(1, 0), b3, voffB);
            PG8_BAR; PG8_WAIT_L(0); PG8_MMA(0, 1, At, B1); PG8_BAR;
            PG8_LDA(At, 1, 1); PG8_STAGE(PG8_SA(1, 0), a3, voffA);
            PG8_BAR; PG8_WAIT_L(0); PG8_MMA(1, 0, At, B0); PG8_BAR; PG8_SCHED;
            PG8_STAGE(PG8_SB(1, 1), b3 + hstep, voffB);
            PG8_WAIT_V(6); PG8_BAR; PG8_MMA(1, 1, At, B1); PG8_BAR;
            }
        }
        if constexpr (ALIGN_EPI) { if (wr == 0) PG8_BAR; }
        if constexpr (!Epi::AFTER_DRAIN) { E(acc, cur, wr, wc, fr, fq); S.done(cur); }
        if (!has_next) break;
#pragma unroll
        for (int a = 0; a < 2; ++a)
#pragma unroll
            for (int b = 0; b < 2; ++b)
#pragma unroll
                for (int m = 0; m < 4; ++m)
#pragma unroll
                    for (int n = 0; n < 2; ++n) acc[a][b][m][n] = (f32x4){0.f, 0.f, 0.f, 0.f};
        cur = nxt; cA = nA; cB = nB; ++ui;
        if constexpr (ALIGN_EPI) { if (wr == 1) PG8_BAR; }
    }
    PG8_WAIT_V(0);
    if constexpr (!ALIGN_EPI) { if (wr == 0) PG8_BAR; }
    PG8_BAR;
    if constexpr (Epi::AFTER_DRAIN) { E.fused(acc, cur, wr, wc, fr, fq, lds, wid, lane); S.done(cur); }
#undef PG8_SA
#undef PG8_SB
#undef PG8_STAGE
#undef PG8_LDA
#undef PG8_LDB
#undef PG8_MMA
#undef PG8_WAIT_V
#undef PG8_WAIT_L
#undef PG8_BAR
#undef PG8_SCHED
}
}
#define GAS __attribute__((address_space(1)))
#define LAS __attribute__((address_space(3)))
typedef unsigned short bf16;
typedef unsigned v4u __attribute__((ext_vector_type(4)));
typedef float f32x4 __attribute__((ext_vector_type(4)));
typedef short bf16x8 __attribute__((ext_vector_type(8)));
typedef GAS unsigned gu32;
typedef GAS unsigned long long gu64;
#define RLX_AGENT __ATOMIC_RELAXED, __HIP_MEMORY_SCOPE_AGENT
#define LDS_WAIT() asm volatile("s_waitcnt lgkmcnt(0)" ::: "memory")
#define VM_WAIT() asm volatile("s_waitcnt vmcnt(0)" ::: "memory")
__device__ __forceinline__ unsigned long long rt() { return __builtin_amdgcn_s_memrealtime(); }
__device__ __forceinline__ unsigned f2bf(float f) { unsigned u = __builtin_bit_cast(unsigned, f); return (u + 0x7fffu + ((u >> 16) & 1u)) >> 16; }
__device__ __forceinline__ unsigned pk2(float lo, float hi) { return f2bf(lo) | (f2bf(hi) << 16); }
#define XB_TMO      128
#define XB_XCNT(j)  (256  + 64 * (j))
#define XB_XSUB(j)  (1280 + 64 * (j))
#define XB_XGEN(j)  (2304 + 64 * (j))
#define XB_TOP      3328
#define XB_TOPGEN   3392
#define XCD_BAR_WORDS 3456
#define XB_SPIN_CAP (1u << 24)

__device__ __forceinline__ unsigned xb_ld(unsigned* p)              { return __hip_atomic_load(p, __ATOMIC_RELAXED, __HIP_MEMORY_SCOPE_AGENT); }
__device__ __forceinline__ unsigned xb_add(unsigned* p, unsigned v) { return __hip_atomic_fetch_add(p, v, __ATOMIC_RELAXED, __HIP_MEMORY_SCOPE_AGENT); }
__device__ __forceinline__ unsigned xb_xcc_id() { return (unsigned)__builtin_amdgcn_s_getreg((3 << 11) | 20) & 0xFu; }
#define XB_SPIN(cond, bar) do { unsigned _sp = 0; while (cond) { __builtin_amdgcn_s_sleep(1); \
    if ((++_sp & 255u) == 0u) { if (xb_ld(&(bar)[XB_TMO])) break; if (_sp > XB_SPIN_CAP) { atomicAdd(&(bar)[XB_TMO], 1u); break; } } } } while (0)

struct XcdBarrier {
    unsigned* bar; unsigned x;
    volatile LAS unsigned* st;
};

__device__ __forceinline__ XcdBarrier xcd_barrier_post(unsigned* bar, volatile LAS unsigned* st) {
    XcdBarrier b; b.bar = bar; b.x = xb_xcc_id(); b.st = st;
    if (threadIdx.x == 0) (void)xb_add(&bar[XB_XCNT(b.x)], 1u);
    return b;
}
__device__ __forceinline__ void xcd_barrier_complete(unsigned* bar, unsigned x, unsigned& nloc, unsigned& nx) {
    const unsigned G = gridDim.x * gridDim.y * gridDim.z;
    unsigned sum, cnt, mine, sp = 0u;
    for (;;) {
        sum = 0u; cnt = 0u; mine = 0u;
#pragma unroll
        for (unsigned j = 0; j < 16; ++j) { const unsigned c = xb_ld(&bar[XB_XCNT(j)]); sum += c; cnt += (c > 0u) ? 1u : 0u; mine = (j == x) ? c : mine; }
        if (sum == G) break;
        __builtin_amdgcn_s_sleep(1);
        if ((++sp & 255u) == 0u) { if (xb_ld(&bar[XB_TMO])) break; if (sp > XB_SPIN_CAP) { atomicAdd(&bar[XB_TMO], 1u); break; } }
    }
    nloc = mine > 0u ? mine : 1u; nx = cnt > 0u ? cnt : 1u;
}

__device__ __forceinline__ void xcd_barrier(const XcdBarrier& b) {
    asm volatile("s_waitcnt vmcnt(0)" ::: "memory");
    __syncthreads();
    if (threadIdx.x == 0) {
        unsigned* bar = b.bar;
        __builtin_amdgcn_s_waitcnt(0);
        unsigned nloc = b.st[0], nx = b.st[1];
        if (nloc == 0u) { xcd_barrier_complete(bar, b.x, nloc, nx); b.st[0] = nloc; b.st[1] = nx; }
        const unsigned old = xb_add(&bar[XB_XSUB(b.x)], 1u);
        const unsigned gen = old / nloc;
        if (old + 1u == (gen + 1u) * nloc) {
            __builtin_amdgcn_fence(__ATOMIC_RELEASE, "agent");
            asm volatile("s_waitcnt vmcnt(0)" ::: "memory");
            const unsigned og = xb_add(&bar[XB_TOP], 1u);
            const unsigned tg = og / nx;
            if (og + 1u == (tg + 1u) * nx) xb_add(&bar[XB_TOPGEN], 1u);
            else XB_SPIN(xb_ld(&bar[XB_TOPGEN]) == tg, bar);
            __builtin_amdgcn_fence(__ATOMIC_ACQUIRE, "agent");
            xb_add(&bar[XB_XGEN(b.x)], 1u);
            asm volatile("s_waitcnt vmcnt(0)" ::: "memory");
        } else {
            XB_SPIN(xb_ld(&bar[XB_XGEN(b.x)]) == gen, bar);
            __builtin_amdgcn_fence(__ATOMIC_ACQUIRE, "agent");
            asm volatile("s_waitcnt vmcnt(0)" ::: "memory");
        }
    }
    __syncthreads();
}
namespace mk {
using pg8::f32x4; using pg8::Unit; using pg8::bf16_t; using pg8::u32x4; using pg8::cvt_pk_bf16;
typedef unsigned u32x2 __attribute__((ext_vector_type(2)));
constexpr int B = 8, S = 4096, D = 1024, T = B * S, INW = 3584, DFF = 2816, NMOD = 6144, NGU = 2 * DFF;
constexpr float EPS = 1e-6f, LOG2E = 1.4426950408889634f, QSCALE = 0.125f * 1.4426950408889634f;
#define EPI_LANES() int lane_; asm volatile("v_mbcnt_lo_u32_b32 %0, -1, 0\n\tv_mbcnt_hi_u32_b32 %0, -1, %0" : "=&v"(lane_)); const int wr = wr_, wc = wc_, fr = lane_ & 15, fq = lane_ >> 4; (void)fr_; (void)fq_;
template <int CTRL> __device__ __forceinline__ float dpp_mov0(float v) { return __int_as_float(__builtin_amdgcn_update_dpp(0, __float_as_int(v), CTRL, 0xF, 0xF, false)); }
__device__ __forceinline__ float row_scan16(float s) { s += dpp_mov0<0x111>(s); s += dpp_mov0<0x112>(s); s += dpp_mov0<0x114>(s); s += dpp_mov0<0x118>(s); return s; }
__device__ __forceinline__ float row_sum16(float s) { s += dpp_mov0<0x128>(s); s += dpp_mov0<0x124>(s); s += dpp_mov0<0x122>(s); s += dpp_mov0<0x121>(s); return s; }
__device__ __forceinline__ float ex2(float x) { return __builtin_amdgcn_exp2f(x); }
__device__ __forceinline__ float lg2(float x) { return __builtin_amdgcn_logf(x); }
__device__ __forceinline__ float rcp(float x) { return __builtin_amdgcn_rcpf(x); }
__device__ __forceinline__ float rsq(float x) { return __builtin_amdgcn_rsqf(x); }
__device__ __forceinline__ float silu(float x) { return x * rcp(1.f + ex2(-x * LOG2E)); }
typedef short bf16x8 __attribute__((ext_vector_type(8)));
typedef float f32x2c __attribute__((ext_vector_type(2))); typedef __bf16 bf16x2c __attribute__((ext_vector_type(2)));
__device__ __forceinline__ unsigned pk2r(float lo, float hi) { const f32x2c v = {lo, hi}; return __builtin_bit_cast(unsigned, __builtin_convertvector(v, bf16x2c)); }
__device__ __forceinline__ float bf2f(unsigned short h) { return __uint_as_float(((unsigned)h) << 16); }
__device__ __forceinline__ float bflo(unsigned w) { return __uint_as_float(w << 16); }
__device__ __forceinline__ float bfhi(unsigned w) { return __uint_as_float(w & 0xffff0000u); }

struct EpiIn {
    static constexpr bool PERM = true, AFTER_DRAIN = false;
    bf16_t *QT, *KT, *VH, *SG, *AQ, *AK, *AV; float* DEC; const float* lb;
    __device__ __forceinline__ void operator()(f32x4 (&acc)[2][2][4][2], const Unit& u, int wr_, int wc_, int fr_, int fq_) const {
        EPI_LANES();
        const int pn = u.pn; const unsigned row0 = (unsigned)(u.pm * 256 + wr * 64 + fr);
#ifndef NO_HGRN_EPI
        if (pn < 4) {
            const int cb = pn * 128 + wc * 32 + 8 * fq;
            const f32x4 l0 = *(const f32x4*)(lb + cb), l1 = *(const f32x4*)(lb + cb + 4);
#pragma unroll
            for (int ai = 0; ai < 2; ++ai) {
                const unsigned chunk = (unsigned)(u.pm * 4 + ai * 2 + wr);
#pragma unroll
                for (int n = 0; n < 2; ++n) {
                    float dl[4];
#pragma unroll
                    for (int j = 0; j < 4; ++j) {
                        const float lbv = n == 0 ? l0[j] : l1[j], omlb = 1.f - lbv;
                        float lgv[4], b2[4]; float carry = 0.f;
#pragma unroll
                        for (int m = 0; m < 4; ++m) { const float e = ex2(-acc[ai][1][m][n][j] * LOG2E), sg = rcp(1.f + e); lgv[m] = lg2(lbv + omlb * sg); acc[ai][1][m][n][j] = omlb * (e * sg); }
#pragma unroll
                        for (int m = 0; m < 4; ++m) { const float s = row_scan16(lgv[m]), tot = row_sum16(lgv[m]); b2[m] = carry + s; carry += tot; }
                        dl[j] = ex2(carry);
#pragma unroll
                        for (int m = 0; m < 4; ++m) { acc[ai][0][m][n][j] = silu(acc[ai][0][m][n][j]) * ex2(b2[m]); acc[ai][1][m][n][j] *= ex2(-b2[m]); }
                        __builtin_amdgcn_sched_barrier(0);
                    }
                    *(f32x4*)(DEC + (chunk * 512u + (unsigned)(cb + 4 * n))) = (f32x4){dl[0], dl[1], dl[2], dl[3]};
#pragma unroll
                    for (int m = 0; m < 4; ++m) { const unsigned off = (row0 + ai * 128 + m * 16) * 512u + (unsigned)(cb + 4 * n);
                        const f32x4 q = acc[ai][0][m][n], k = acc[ai][1][m][n];
                        u32x2 w; w.x = pk2r(q[0], q[1]); w.y = pk2r(q[2], q[3]); *(u32x2*)(QT + off) = w;
                        u32x2 kw; kw.x = pk2r(k[0], k[1]); kw.y = pk2r(k[2], k[3]); *(u32x2*)(KT + off) = kw; }
                    __builtin_amdgcn_sched_barrier(0);
                }
            }
        } else
#endif
        {
            const int g = (pn - 4) >> 1; bf16_t* base = g == 0 ? VH : g == 1 ? SG : g == 2 ? AQ : g == 3 ? AK : AV;
            const unsigned col0 = (unsigned)(((pn - 4) & 1) * 256 + wc * 32 + 8 * fq);
#pragma unroll
            for (int ai = 0; ai < 2; ++ai)
#pragma unroll
                for (int m = 0; m < 4; ++m) { bf16_t* rowp = base + ((row0 + ai * 128 + m * 16) * 512u + col0);
#pragma unroll
                    for (int bj = 0; bj < 2; ++bj) { f32x4 v0 = acc[ai][bj][m][0], v1 = acc[ai][bj][m][1];
                        if (g == 1) {
#pragma unroll
                            for (int j = 0; j < 4; ++j) { v0[j] = silu(v0[j]); v1[j] = silu(v1[j]); } }
                        if (g == 2) { v0 = v0 * QSCALE; v1 = v1 * QSCALE; }
                        u32x4 w; w.x = pk2r(v0[0], v0[1]); w.y = pk2r(v0[2], v0[3]); w.z = pk2r(v1[0], v1[1]); w.w = pk2r(v1[2], v1[3]);
                        *(u32x4*)(rowp + bj * 128) = w; } }
        }
    }
};

struct EpiOut {
    static constexpr bool PERM = false, AFTER_DRAIN = false;
    const float* x; float* x1; bf16_t* A2; float* ssq; const float* mod; const float* g2;
    __device__ __forceinline__ void operator()(const f32x4 (&acc)[2][2][4][2], const Unit& u, int wr_, int wc_, int fr_, int fq_) const {
        EPI_LANES();
        const int b = u.pm >> 4, col0 = u.pn * 256 + wc * 32 + 4 * fq, rowb = u.pm * 256 + wr * 64 + fr; const float* modb = mod + b * NMOD;
        float ssr[2][4];
#pragma unroll
        for (int ai = 0; ai < 2; ++ai)
#pragma unroll
            for (int m = 0; m < 4; ++m) ssr[ai][m] = 0.f;
#pragma unroll
        for (int bj = 0; bj < 2; ++bj)
#pragma unroll
            for (int n = 0; n < 2; ++n) { const int c = col0 + bj * 128 + n * 16;
                const f32x4 gate = *(const f32x4*)(modb + 2048 + c), sc2 = *(const f32x4*)(modb + 4096 + c), gg = *(const f32x4*)(g2 + c); const f32x4 mul = gg * (sc2 + 1.0f);
#pragma unroll
                for (int ai = 0; ai < 2; ++ai)
#pragma unroll
                    for (int m = 0; m < 4; ++m) { const size_t off = (size_t)(rowb + ai * 128 + m * 16) * D + c;
                        const f32x4 v = *(const f32x4*)(x + off) + gate * acc[ai][bj][m][n]; *(f32x4*)(x1 + off) = v;
                        ssr[ai][m] += (v[0] * v[0] + v[1] * v[1]) + (v[2] * v[2] + v[3] * v[3]);
                        const f32x4 a = v * mul; u32x2 w; w.x = pk2r(a[0], a[1]); w.y = pk2r(a[2], a[3]); *(u32x2*)(A2 + off) = w; } }
#pragma unroll
        for (int ai = 0; ai < 2; ++ai)
#pragma unroll
            for (int m = 0; m < 4; ++m) { float s = ssr[ai][m]; s += __shfl_xor(s, 16); s += __shfl_xor(s, 32);
                if (fq == 0) ssq[(size_t)(rowb + ai * 128 + m * 16) * 16 + u.pn * 4 + wc] = s; }
    }
};

struct EpiGU {
    static constexpr bool PERM = true, AFTER_DRAIN = false;
    bf16_t* HID; const float* ssq; const float* bias2;
    __device__ __forceinline__ void operator()(const f32x4 (&acc)[2][2][4][2], const Unit& u, int wr_, int wc_, int fr_, int fq_) const {
        EPI_LANES();
        const int b = u.pm >> 4, rowb = u.pm * 256 + wr * 64 + fr; const float* bb = bias2 + b * NGU + u.pn * 256 + wc * 32 + 8 * fq;
        const f32x4 ba0 = *(const f32x4*)(bb), ba1 = *(const f32x4*)(bb + 4), bu0 = *(const f32x4*)(bb + 128), bu1 = *(const f32x4*)(bb + 132);
#pragma unroll
        for (int ai = 0; ai < 2; ++ai)
#pragma unroll
            for (int m = 0; m < 4; ++m) { const int row = rowb + ai * 128 + m * 16; const f32x4* sp = (const f32x4*)(ssq + (size_t)row * 16);
                const f32x4 s0 = sp[0], s1 = sp[1], s2 = sp[2], s3 = sp[3]; const f32x4 st = (s0 + s1) + (s2 + s3);
                const float rstd = rsq(((st[0] + st[1]) + (st[2] + st[3])) * (1.0f / D) + EPS);
                const f32x4 a0 = acc[ai][0][m][0] * rstd + ba0, a1 = acc[ai][0][m][1] * rstd + ba1, u0 = acc[ai][1][m][0] * rstd + bu0, u1 = acc[ai][1][m][1] * rstd + bu1;
                float h[8];
#pragma unroll
                for (int j = 0; j < 4; ++j) { h[j] = silu(a0[j]) * u0[j]; h[4 + j] = silu(a1[j]) * u1[j]; }
                u32x4 w; w.x = pk2r(h[0], h[1]); w.y = pk2r(h[2], h[3]); w.z = pk2r(h[4], h[5]); w.w = pk2r(h[6], h[7]);
                *(u32x4*)(HID + (size_t)row * DFF + u.pn * 128 + wc * 32 + 8 * fq) = w; }
    }
};

struct EpiDown {
    static constexpr bool PERM = false, AFTER_DRAIN = false;
    float* xio; const float* mod;
    __device__ __forceinline__ void operator()(const f32x4 (&acc)[2][2][4][2], const Unit& u, int wr_, int wc_, int fr_, int fq_) const {
        EPI_LANES();
        const int b = u.pm >> 4, col0 = u.pn * 256 + wc * 32 + 4 * fq, rowb = u.pm * 256 + wr * 64 + fr; const float* modb = mod + b * NMOD;
#pragma unroll
        for (int bj = 0; bj < 2; ++bj)
#pragma unroll
            for (int n = 0; n < 2; ++n) { const int c = col0 + bj * 128 + n * 16; const f32x4 gate = *(const f32x4*)(modb + 5120 + c);
#pragma unroll
                for (int ai = 0; ai < 2; ++ai)
#pragma unroll
                    for (int m = 0; m < 4; ++m) { const size_t off = (size_t)(rowb + ai * 128 + m * 16) * D + c; *(f32x4*)(xio + off) = *(const f32x4*)(xio + off) + gate * acc[ai][bj][m][n]; } }
    }
};
}
namespace mk {
constexpr int NWAVES = 8;
constexpr size_t MiB = 1u << 20;
constexpr size_t WS_CTL = 0, CTL_ZERO_BYTES = 64 * 1024;
constexpr size_t WS_MODP = 1 * MiB;
constexpr size_t WS_MOD = 3 * MiB, WS_LB = WS_MOD + 256 * 1024, WS_BIAS2 = WS_MOD + 512 * 1024;
constexpr size_t WS_WIN = 4 * MiB, WS_WOUT = 11 * MiB, WS_WGU = 13 * MiB, WS_WD = 24 * MiB;
constexpr size_t WS_DEC = 30 * MiB, WS_LSE = 31 * MiB, WS_SSQ1 = 34 * MiB;
constexpr size_t WS_BUFA = 40 * MiB;
constexpr size_t WS_BUFB = 104 * MiB;
constexpr size_t WS_R = 168 * MiB;
constexpr size_t WS_QT = WS_R, WS_KT = WS_R + 32 * MiB, WS_VH = WS_R + 64 * MiB, WS_SG = WS_R + 96 * MiB, WS_AQ = WS_R + 128 * MiB, WS_AK = WS_R + 160 * MiB, WS_AV = WS_R + 192 * MiB;
constexpr size_t WS_ST = WS_BUFA;
constexpr size_t WS_ATT0 = WS_R + 224 * MiB, WS_ATT1 = WS_R + 256 * MiB, WS_ATT2 = WS_R + 288 * MiB;
constexpr size_t WS_HID = WS_R;
constexpr size_t WS_END = WS_R + 320 * MiB;
constexpr int CW_BAR = 4096;
constexpr int RING_BYTES = 131072, LDS_BYTES = 163840, LDSCTL_OFF = LDS_BYTES - 512, MISC_OFF = LDSCTL_OFF + 320;

__device__ __forceinline__ const float* karg_ptr(int i) {
    asm volatile("" : "+s"(i));
    typedef const float* cfp;
    const __attribute__((address_space(4))) cfp* ka = (const __attribute__((address_space(4))) cfp*)__builtin_amdgcn_kernarg_segment_ptr();
    return ka[i];
}

__device__ __forceinline__ void transpose_item(const float* W, int K, int N, bf16* WT, int mode, LAS float* scr, int item, int lane) {
    const int nblk = N / 32, kb = item / nblk, nb = item % nblk, k0 = 64 * kb, n0 = 32 * nb;
    int r0 = n0;
    if (mode == 1) { if (n0 < 512) r0 = (n0 >> 7) * 256 + (n0 & 127); else if (n0 < 1024) r0 = ((n0 - 512) >> 7) * 256 + 128 + (n0 & 127); }
    if (mode == 2) { if (n0 < DFF) r0 = (n0 >> 7) * 256 + (n0 & 127); else r0 = ((n0 - DFF) >> 7) * 256 + 128 + ((n0 - DFF) & 127); }
#pragma unroll 8
    for (int i = 0; i < 32; ++i) { const int kk = 2 * i + (lane >> 5); scr[kk * 33 + (lane & 31)] = W[(size_t)(k0 + kk) * N + n0 + (lane & 31)]; }
    LDS_WAIT(); asm volatile("" ::: "memory");
    const int c = lane & 7;
#pragma unroll
    for (int j = 0; j < 4; ++j) { const int n = (lane >> 3) + 8 * j; const LAS float* s = scr + (8 * c) * 33 + n;
        v4u o; o.x = pk2(s[0 * 33], s[1 * 33]); o.y = pk2(s[2 * 33], s[3 * 33]); o.z = pk2(s[4 * 33], s[5 * 33]); o.w = pk2(s[6 * 33], s[7 * 33]);
        *(GAS v4u*)(WT + (size_t)(r0 + n) * K + k0 + 8 * c) = o; }
    LDS_WAIT(); asm volatile("" ::: "memory");
}
__device__ __forceinline__ void mod_partial(const float* Pc, const float* Pw_ada, float* modp, LAS float* scr, int it, int lane) {
    const int cg = it % 96, ks = it / 96, n = cg * 64 + lane;
#pragma unroll
    for (int i = 0; i < 16; ++i) { const int idx = i * 64 + lane, kk = idx & 127, b = idx >> 7; scr[kk * 8 + b] = silu(Pc[b * D + ks * 128 + kk]); }
    LDS_WAIT(); asm volatile("" ::: "memory");
    float acc[8];
#pragma unroll
    for (int b = 0; b < 8; ++b) acc[b] = 0.f;
    const float* wp = Pw_ada + (size_t)(ks * 128) * NMOD + n;
#pragma unroll 16
    for (int kk = 0; kk < 128; ++kk) { const float w = wp[(size_t)kk * NMOD]; const f32x4 c0 = *(const LAS f32x4*)(scr + kk * 8), c1 = *(const LAS f32x4*)(scr + kk * 8 + 4);
        acc[0] += c0[0] * w; acc[1] += c0[1] * w; acc[2] += c0[2] * w; acc[3] += c0[3] * w; acc[4] += c1[0] * w; acc[5] += c1[1] * w; acc[6] += c1[2] * w; acc[7] += c1[3] * w; }
#pragma unroll
    for (int b = 0; b < 8; ++b) modp[(size_t)(ks * 8 + b) * NMOD + n] = acc[b];
    LDS_WAIT(); asm volatile("" ::: "memory");
}
__device__ __forceinline__ float wsum64(float v) {
#pragma unroll
    for (int o = 1; o < 64; o <<= 1) v += __shfl_xor(v, o);
    return v;
}
__device__ __forceinline__ float wmax64(float v) {
#pragma unroll
    for (int o = 1; o < 64; o <<= 1) v = fmaxf(v, __shfl_xor(v, o));
    return v;
}

typedef short s16x4v __attribute__((ext_vector_type(4)));
#define LBAR() asm volatile("s_waitcnt lgkmcnt(0)\n\ts_barrier" ::: "memory")
#define TOPBAR() asm volatile("s_waitcnt vmcnt(0) lgkmcnt(0)\n\ts_barrier" ::: "memory")
#define TOUCH(x) asm volatile("" : "+v"(x))
__device__ __forceinline__ void glds16(const void* gsrc, unsigned lds_dst) { unsigned keep;
    asm volatile("s_mov_b32 %0, m0\n\ts_mov_b32 m0, %2\n\ts_nop 0\n\tglobal_load_lds_dwordx4 %1, off\n\ts_mov_b32 m0, %0" : "=&s"(keep) : "v"(gsrc), "s"(lds_dst) : "memory"); }
__device__ __forceinline__ void glds4(const void* gsrc, unsigned lds_dst) { unsigned keep;
    asm volatile("s_mov_b32 %0, m0\n\ts_mov_b32 m0, %2\n\ts_nop 0\n\tglobal_load_lds_dword %1, off\n\ts_mov_b32 m0, %0" : "=&s"(keep) : "v"(gsrc), "s"(lds_dst) : "memory"); }
__device__ __forceinline__ unsigned lds_addr(const LAS unsigned char* p) { return (unsigned)(size_t)p; }
template <int SW> __device__ __forceinline__ int swz(int R) { return SW == 0 ? (R & 15) : SW == 1 ? (((R & 3) << 1) | (((R >> 3) & 1) << 3)) : ((R & 7) << 1); }
template <int SW> __device__ __forceinline__ void tile_dma(LAS unsigned char* lds, int to, const bf16* src, size_t tok0, int col0, int wave, int lane) {
#pragma unroll
    for (int pi = 0; pi < 2; ++pi) { const int piece = wave + 8 * pi, R = 4 * piece + (lane >> 4); const int gch = (lane & 15) ^ swz<SW>(R);
        glds16(src + (tok0 + R) * 512 + col0 + gch * 8, (unsigned)__builtin_amdgcn_readfirstlane(lds_addr(lds) + to + piece * 1024)); }
}
template <int SW> __device__ __forceinline__ bf16x8 tr_frag(const LAS unsigned char* tile, int r0a, int r0b, int c0, int i16) {
    const int q = i16 >> 2, ch = (c0 >> 3) + ((i16 & 3) >> 1), bo = (i16 & 1) * 8; const int Ra = r0a + q, Rb = r0b + q;
    const s16x4v va = __builtin_amdgcn_ds_read_tr16_b64_v4i16((LAS s16x4v*)(tile + Ra * 256 + ((ch ^ swz<SW>(Ra)) << 4) + bo));
    const s16x4v vb = __builtin_amdgcn_ds_read_tr16_b64_v4i16((LAS s16x4v*)(tile + Rb * 256 + ((ch ^ swz<SW>(Rb)) << 4) + bo));
    return (bf16x8){va[0], va[1], va[2], va[3], vb[0], vb[1], vb[2], vb[3]};
}
__device__ __forceinline__ bf16x8 row_frag(const LAS unsigned char* tile, int R, int ch) { return *(const LAS bf16x8*)(tile + R * 256 + ((ch ^ (R & 15)) << 4)); }

__device__ __forceinline__ void scan_issue(LAS unsigned char* lds, const bf16* KT, const bf16* VH, const float* DEC, int b, int h, int c, int wave, int lane) {
    const int bo = (c & 3) * 32768; const size_t tok = (size_t)b * S + 64 * c;
    tile_dma<1>(lds, bo, KT, tok, h * 128, wave, lane); tile_dma<1>(lds, bo + 16384, VH, tok, h * 128, wave, lane);
    glds4(DEC + ((size_t)(b * 64 + c) * 512 + h * 128 + 16 * wave + (lane & 15)), (unsigned)__builtin_amdgcn_readfirstlane(lds_addr(lds) + 131072 + (c & 3) * 2048 + wave * 256));
}
__device__ __forceinline__ void hgrn_scan(LAS unsigned char* lds, const bf16* KT, const bf16* VH, const float* DEC, bf16* ST, int bh, int wave, int lane) {
    const int b = bh >> 2, h = bh & 3, i16 = lane & 15, g4 = lane >> 4;
    f32x4 acc[8];
#pragma unroll
    for (int vt = 0; vt < 8; ++vt) acc[vt] = (f32x4){0.f, 0.f, 0.f, 0.f};
    scan_issue(lds, KT, VH, DEC, b, h, 0, wave, lane); scan_issue(lds, KT, VH, DEC, b, h, 1, wave, lane); scan_issue(lds, KT, VH, DEC, b, h, 2, wave, lane);
    for (int c = 0; c < 63; ++c) {
        if (c < 3 || c >= 61) asm volatile("s_waitcnt vmcnt(0) lgkmcnt(0)\n\ts_barrier" ::: "memory");
        else asm volatile("s_waitcnt vmcnt(34) lgkmcnt(0)\n\ts_barrier" ::: "memory");
        if (c + 3 < 63) scan_issue(lds, KT, VH, DEC, b, h, c + 3, wave, lane);
        const LAS unsigned char* Kt = lds + (c & 3) * 32768; const LAS unsigned char* Vt = Kt + 16384;
        const f32x4 dv = *(const LAS f32x4*)(lds + 131072 + (c & 3) * 2048 + wave * 256 + 16 * g4);
#pragma unroll
        for (int ks = 0; ks < 2; ++ks) { const int r0 = 32 * ks + 8 * g4;
            const bf16x8 af = tr_frag<1>(Kt, r0, r0 + 4, 16 * wave, i16);
#pragma unroll
            for (int vt = 0; vt < 8; ++vt) { const bf16x8 bfv = tr_frag<1>(Vt, r0, r0 + 4, 16 * vt, i16);
                acc[vt] = __builtin_amdgcn_mfma_f32_16x16x32_bf16(af, bfv, acc[vt], 0, 0, 0); } }
        bf16* sp = ST + (((size_t)(bh * 64 + c) * 128 + i16) * 128 + 16 * wave + 4 * g4);
#pragma unroll
        for (int vt = 0; vt < 8; ++vt) { acc[vt] = acc[vt] * dv;
            u32x2 w; w.x = pk2r(acc[vt][0], acc[vt][1]); w.y = pk2r(acc[vt][2], acc[vt][3]); *(u32x2*)(sp + (size_t)vt * 16 * 128) = w; }
    }
    asm volatile("s_waitcnt vmcnt(0) lgkmcnt(0)\n\ts_barrier" ::: "memory");
}

__device__ __forceinline__ void hgrn_out_units(LAS unsigned char* lds, const bf16* QT, const bf16* KT, const bf16* VH, const bf16* SG, const bf16* ST, const float* hg_on, bf16* MIXIN, int wave, int lane, int ulo, int uhi) {
    const int i16 = lane & 15, g4 = lane >> 4;
    LAS unsigned char* Pl = lds + 98304; LAS float* ssq = (LAS float*)(lds + 106496);
    bf16x8 san[4];
    { const int bh = ulo >> 6, c = ulo & 63, b = bh >> 2, h = bh & 3; const size_t tok0 = (size_t)b * S + 64 * c;
      tile_dma<0>(lds, 0, QT, tok0, h * 128, wave, lane); tile_dma<0>(lds, 16384, KT, tok0, h * 128, wave, lane); tile_dma<2>(lds, 32768, VH, tok0, h * 128, wave, lane);
      if (c > 0) { const bf16* sp = ST + (((size_t)(bh * 64 + c - 1) * 128 + 16 * wave + i16) * 128 + 8 * g4);
#pragma unroll
          for (int ks = 0; ks < 4; ++ks) san[ks] = *(const bf16x8*)(sp + 32 * ks); }
      else {
#pragma unroll
          for (int ks = 0; ks < 4; ++ks) san[ks] = (bf16x8){0, 0, 0, 0, 0, 0, 0, 0}; } }
    for (int u = ulo; u < uhi; ++u) {
        const int cur = (u - ulo) & 1; const int bh = u >> 6, c = u & 63, b = bh >> 2, h = bh & 3; const size_t tok0 = (size_t)b * S + 64 * c;
        TOPBAR();
        TOUCH(san[0]); TOUCH(san[1]); TOUCH(san[2]); TOUCH(san[3]);
        const bf16x8 sa[4] = {san[0], san[1], san[2], san[3]};
        if (u + 1 < uhi) { const int bh2 = (u + 1) >> 6, c2 = (u + 1) & 63; const size_t t2 = (size_t)(bh2 >> 2) * S + 64 * c2; const int h2 = bh2 & 3, o2 = (cur ^ 1) * 49152;
            tile_dma<0>(lds, o2, QT, t2, h2 * 128, wave, lane); tile_dma<0>(lds, o2 + 16384, KT, t2, h2 * 128, wave, lane); tile_dma<2>(lds, o2 + 32768, VH, t2, h2 * 128, wave, lane);
            if (c2 > 0) { const bf16* sp = ST + (((size_t)(bh2 * 64 + c2 - 1) * 128 + 16 * wave + i16) * 128 + 8 * g4);
#pragma unroll
                for (int ks = 0; ks < 4; ++ks) san[ks] = *(const bf16x8*)(sp + 32 * ks); }
            else {
#pragma unroll
                for (int ks = 0; ks < 4; ++ks) san[ks] = (bf16x8){0, 0, 0, 0, 0, 0, 0, 0}; } }
        const LAS unsigned char* Qt = lds + cur * 49152; const LAS unsigned char* Kt = Qt + 16384; const LAS unsigned char* Vt = Qt + 32768;
#pragma unroll
        for (int q = 0; q < 2; ++q) { const int id = 2 * wave + q, si = id >> 2, ti = id & 3; f32x4 a = {0.f, 0.f, 0.f, 0.f};
            if (si <= ti) {
#pragma unroll
                for (int ks = 0; ks < 4; ++ks) a = __builtin_amdgcn_mfma_f32_16x16x32_bf16(row_frag(Kt, 16 * si + i16, g4 + 4 * ks), row_frag(Qt, 16 * ti + i16, g4 + 4 * ks), a, 0, 0, 0);
                if (si == ti) {
#pragma unroll
                    for (int reg = 0; reg < 4; ++reg) if (4 * g4 + reg > i16) a[reg] = 0.f; } }
            u32x2 w; w.x = pk2r(a[0], a[1]); w.y = pk2r(a[2], a[3]); *(LAS u32x2*)(Pl + id * 512 + lane * 8) = w; }
        LBAR();
        f32x4 o[4];
#pragma unroll
        for (int tt = 0; tt < 4; ++tt) { o[tt] = (f32x4){0.f, 0.f, 0.f, 0.f};
#pragma unroll
            for (int ks = 0; ks < 4; ++ks) o[tt] = __builtin_amdgcn_mfma_f32_16x16x32_bf16(sa[ks], row_frag(Qt, 16 * tt + i16, g4 + 4 * ks), o[tt], 0, 0, 0);
#pragma unroll
            for (int kp = 0; kp < 2; ++kp) { if (2 * kp <= tt) {
                    const u32x2 pa = *(const LAS u32x2*)(Pl + ((2 * kp) * 4 + tt) * 512 + lane * 8), pb = *(const LAS u32x2*)(Pl + ((2 * kp + 1) * 4 + tt) * 512 + lane * 8);
                    const v4u pw = {pa.x, pa.y, pb.x, pb.y};
                    const bf16x8 vf = tr_frag<2>(Vt, 32 * kp + 4 * g4, 32 * kp + 16 + 4 * g4, 16 * wave, i16);
                    o[tt] = __builtin_amdgcn_mfma_f32_16x16x32_bf16(vf, __builtin_bit_cast(bf16x8, pw), o[tt], 0, 0, 0); } } }
#pragma unroll
        for (int tt = 0; tt < 4; ++tt) { float ss = (o[tt][0] * o[tt][0] + o[tt][1] * o[tt][1]) + (o[tt][2] * o[tt][2] + o[tt][3] * o[tt][3]); ss += __shfl_xor(ss, 16); ss += __shfl_xor(ss, 32);
            if (g4 == 0) ssq[wave * 64 + 16 * tt + i16] = ss; }
        LBAR();
        const f32x4 gon = *(const f32x4*)(hg_on + 16 * wave + 4 * g4);
#pragma unroll
        for (int tt = 0; tt < 4; ++tt) { float tot = 0.f;
#pragma unroll
            for (int w8 = 0; w8 < 8; ++w8) tot += ssq[w8 * 64 + 16 * tt + i16];
            const float rstd = rsq(tot * (1.f / 128.f) + EPS);
            const size_t tok = tok0 + 16 * tt + i16; const int col = h * 128 + 16 * wave + 4 * g4;
            const u32x2 sg = *(const u32x2*)(SG + tok * 512 + col);
            u32x2 w; w.x = pk2r(o[tt][0] * rstd * gon[0] * bflo(sg.x), o[tt][1] * rstd * gon[1] * bfhi(sg.x)); w.y = pk2r(o[tt][2] * rstd * gon[2] * bflo(sg.y), o[tt][3] * rstd * gon[3] * bfhi(sg.y));
            *(u32x2*)(MIXIN + tok * D + col) = w; }
    }
    __syncthreads();
}

struct AttU { int b, h, dsh, r, n, br; };
__device__ __forceinline__ AttU att_decode(int g) {
    AttU U; const int bh = g / 96, u = g % 96; U.b = bh >> 3; U.h = bh & 7;
    if (u < 32) { U.dsh = 0; U.r = 0; U.n = u; U.br = 0; }
    else if (u < 64) { U.dsh = 2; U.r = (u - 32) >> 3; U.n = (u - 32) & 7; U.br = 1; }
    else { U.dsh = 4; U.r = (u - 64) >> 1; U.n = (u - 64) & 1; U.br = 2; }
    return U;
}
__device__ __forceinline__ void att_dma(LAS unsigned char* lds, int bufo, const bf16* AK, const bf16* AV, const AttU& U, int wave, int lane) {
    const int gch = (lane & 7) ^ (lane >> 3);
#pragma unroll
    for (int pi = 0; pi < 4; ++pi) { const int piece = wave + 8 * pi, row = piece * 8 + (lane >> 3); int m = 128 * (U.n - 1) + row; if (m < 0) m += 128;
        const size_t eoff = ((size_t)U.b * S + (size_t)((m << U.dsh) + U.r)) * 512 + U.h * 64 + gch * 8;
        glds16(AK + eoff, (unsigned)__builtin_amdgcn_readfirstlane(lds_addr(lds) + bufo + piece * 1024));
        glds16(AV + eoff, (unsigned)__builtin_amdgcn_readfirstlane(lds_addr(lds) + bufo + 32768 + piece * 1024)); }
}
__device__ __forceinline__ void attn_units(LAS unsigned char* lds, const bf16* AQ, const bf16* AK, const bf16* AV, unsigned char* ws, float* LSE, int wave, int lane, int glo, int ghi) {
    const int i16 = lane & 15, g4 = lane >> 4;
    AttU U = att_decode(glo);
    att_dma(lds, 0, AK, AV, U, wave, lane);
    bf16x8 qn0, qn1;
    { const bf16* qp = AQ + (((size_t)U.b * S + (size_t)(((128 * U.n + 16 * wave + i16) << U.dsh) + U.r)) * 512 + U.h * 64 + 8 * g4); qn0 = *(const bf16x8*)qp; qn1 = *(const bf16x8*)(qp + 32); }
    for (int gu = glo; gu < ghi; ++gu) {
        const int cur = (gu - glo) & 1; const AttU C = U;
        TOPBAR();
        TOUCH(qn0); TOUCH(qn1); const bf16x8 qf0 = qn0, qf1 = qn1;
        if (gu + 1 < ghi) { U = att_decode(gu + 1); att_dma(lds, (cur ^ 1) * 65536, AK, AV, U, wave, lane);
            const bf16* qp = AQ + (((size_t)U.b * S + (size_t)(((128 * U.n + 16 * wave + i16) << U.dsh) + U.r)) * 512 + U.h * 64 + 8 * g4); qn0 = *(const bf16x8*)qp; qn1 = *(const bf16x8*)(qp + 32); }
        const LAS unsigned char* Kb = lds + cur * 65536; const LAS unsigned char* Vb = Kb + 32768;
        f32x4 st[9];
#pragma unroll
        for (int t = 0; t < 9; ++t) { const int R = 16 * (wave + t) + i16; const LAS unsigned char* kp = Kb + R * 128;
            const bf16x8 a0 = *(const LAS bf16x8*)(kp + ((g4 ^ (R & 7)) << 4)), a1 = *(const LAS bf16x8*)(kp + (((g4 + 4) ^ (R & 7)) << 4));
            f32x4 z = {0.f, 0.f, 0.f, 0.f};
            z = __builtin_amdgcn_mfma_f32_16x16x32_bf16(a0, qf0, z, 0, 0, 0); st[t] = __builtin_amdgcn_mfma_f32_16x16x32_bf16(a1, qf1, z, 0, 0, 0); }
        const int qi = 16 * wave + i16; const float NEG = -INFINITY;
#pragma unroll
        for (int reg = 0; reg < 4; ++reg) { const int kj0 = 16 * wave + 4 * g4 + reg; if (kj0 < qi) st[0][reg] = NEG; if (kj0 + 128 > qi + 128) st[8][reg] = NEG; }
        if (C.n == 0) {
#pragma unroll
            for (int t = 0; t < 8; ++t)
#pragma unroll
                for (int reg = 0; reg < 4; ++reg) { if (16 * (wave + t) + 4 * g4 + reg < 128) st[t][reg] = NEG; } }
        float mx = st[0][0];
#pragma unroll
        for (int t = 0; t < 9; ++t)
#pragma unroll
            for (int reg = 0; reg < 4; ++reg) mx = fmaxf(mx, st[t][reg]);
        mx = fmaxf(mx, __shfl_xor(mx, 16)); mx = fmaxf(mx, __shfl_xor(mx, 32));
        float l = 0.f;
#pragma unroll
        for (int t = 0; t < 9; ++t)
#pragma unroll
            for (int reg = 0; reg < 4; ++reg) { const float pv = ex2(st[t][reg] - mx); st[t][reg] = pv; l += pv; }
        l += __shfl_xor(l, 16); l += __shfl_xor(l, 32);
        f32x4 o[4];
#pragma unroll
        for (int et = 0; et < 4; ++et) o[et] = (f32x4){0.f, 0.f, 0.f, 0.f};
#pragma unroll
        for (int ks = 0; ks < 5; ++ks) {
            const int ta = 2 * ks, tb = (ks < 4) ? 2 * ks + 1 : 2 * ks;
            v4u pw; pw.x = pk2r(st[ta][0], st[ta][1]); pw.y = pk2r(st[ta][2], st[ta][3]);
            if (ks < 4) { pw.z = pk2r(st[tb][0], st[tb][1]); pw.w = pk2r(st[tb][2], st[tb][3]); } else { pw.z = 0u; pw.w = 0u; }
            const bf16x8 pf = __builtin_bit_cast(bf16x8, pw);
            const int Ra = 16 * (wave + ta) + 4 * g4 + (i16 >> 2), Rb = 16 * (wave + tb) + 4 * g4 + (i16 >> 2);
#pragma unroll
            for (int et = 0; et < 4; ++et) { const int ch = 2 * et + ((i16 & 3) >> 1), bo = (i16 & 1) * 8;
                const s16x4v va = __builtin_amdgcn_ds_read_tr16_b64_v4i16((LAS s16x4v*)(Vb + Ra * 128 + ((ch ^ (Ra & 7)) << 4) + bo));
                const s16x4v vb = __builtin_amdgcn_ds_read_tr16_b64_v4i16((LAS s16x4v*)(Vb + Rb * 128 + ((ch ^ (Rb & 7)) << 4) + bo));
                const bf16x8 vf = {va[0], va[1], va[2], va[3], vb[0], vb[1], vb[2], vb[3]};
                o[et] = __builtin_amdgcn_mfma_f32_16x16x32_bf16(vf, pf, o[et], 0, 0, 0); }
        }
        const float il = rcp(l);
        const size_t orow = (size_t)C.b * S + (size_t)(((128 * C.n + qi) << C.dsh) + C.r);
        bf16* AO = (bf16*)(ws + (C.br == 0 ? WS_ATT0 : C.br == 1 ? WS_ATT1 : WS_ATT2)) + orow * 512 + C.h * 64 + 4 * g4;
#pragma unroll
        for (int et = 0; et < 4; ++et) { u32x2 w; w.x = pk2r(o[et][0] * il, o[et][1] * il); w.y = pk2r(o[et][2] * il, o[et][3] * il); *(u32x2*)(AO + 16 * et) = w; }
        if (g4 == 0) LSE[(size_t)C.br * T * 8 + orow * 8 + C.h] = mx + lg2(l);
    }
    __syncthreads();
}

struct Args { const float* in[14]; float* out; unsigned char* ws; };
__global__ void __launch_bounds__(NWAVES * 64, 2) mk_fwd(Args args) {
    extern __shared__ __attribute__((aligned(16))) unsigned char lds_raw[];
    LAS unsigned char* lds = (LAS unsigned char*)lds_raw;
    volatile LAS unsigned* MISC = (volatile LAS unsigned*)(lds + MISC_OFF);
    const int wave = __builtin_amdgcn_readfirstlane(threadIdx.x >> 6);
    const int G = gridDim.x, bx = blockIdx.x; const int vcu = (G % 8 == 0) ? (bx % 8) * (G / 8) + bx / 8 : bx;
    const int gw = vcu * NWAVES + wave, NGW = G * NWAVES;
    (void)args;
#define INP(i) karg_ptr(i)
#define P_x INP(0)
#define P_c INP(1)
#define P_w_ada INP(2)
#define P_b_ada INP(3)
#define P_g1 INP(4)
#define P_w_in INP(5)
#define P_lbl INP(6)
#define P_hg_on INP(7)
#define P_att_on INP(8)
#define P_w_out INP(9)
#define P_g2 INP(10)
#define P_w_gu INP(11)
#define P_w_down INP(12)
#define P_gf INP(13)
#define P_out ((float*)INP(14))
    unsigned char* const ws = (unsigned char*)INP(15);
    gu32* ctl = (gu32*)(ws + WS_CTL);
#define MODP ((float*)(ws + WS_MODP))
#define MOD ((float*)(ws + WS_MOD))
#define LB ((float*)(ws + WS_LB))
#define BIAS2 ((float*)(ws + WS_BIAS2))
#define WIN_T ((bf16*)(ws + WS_WIN))
#define WOUT_T ((bf16*)(ws + WS_WOUT))
#define WGU_T ((bf16*)(ws + WS_WGU))
#define WD_T ((bf16*)(ws + WS_WD))
#define DEC ((float*)(ws + WS_DEC))
#define LSE ((float*)(ws + WS_LSE))
#define SSQ1 ((float*)(ws + WS_SSQ1))
#define XN ((bf16*)(ws + WS_BUFA))
#define A2 ((bf16*)(ws + WS_BUFA))
#define MIXIN ((bf16*)(ws + WS_BUFB))
#define QT ((bf16*)(ws + WS_QT))
#define KT ((bf16*)(ws + WS_KT))
#define VH ((bf16*)(ws + WS_VH))
#define SG ((bf16*)(ws + WS_SG))
#define AQ ((bf16*)(ws + WS_AQ))
#define AK ((bf16*)(ws + WS_AK))
#define AV ((bf16*)(ws + WS_AV))
#define STB ((bf16*)(ws + WS_ST))
#define HID ((bf16*)(ws + WS_HID))
#define PHASE_TID() int lane; asm volatile("v_mbcnt_lo_u32_b32 %0, -1, 0\n\tv_mbcnt_hi_u32_b32 %0, -1, %0" : "=&v"(lane)); const int tid = wave * 64 + lane; (void)tid;

    for (int u = threadIdx.x; u < (LDS_BYTES - LDSCTL_OFF) / 4; u += NWAVES * 64) ((LAS unsigned*)(lds + LDSCTL_OFF))[u] = 0u;
    __syncthreads();
    XcdBarrier bar = xcd_barrier_post((unsigned*)(ctl + CW_BAR), MISC + 8);

    {   PHASE_TID();
        LAS float* scr = (LAS float*)(lds + wave * 16384);
        constexpr int I_MOD = 768, I_IN = 16 * (INW / 32), I_OUT = 16 * (D / 32), I_GU = 16 * (NGU / 32), I_DN = (DFF / 64) * (D / 32);
        constexpr int NTASK = I_MOD + I_IN + I_OUT + I_GU + I_DN + 1;
        for (int it = gw; it < NTASK; it += NGW) {
            int r = it;
            if (r < I_MOD) { mod_partial(P_c, P_w_ada, MODP, scr, r, lane); continue; } r -= I_MOD;
            if (r < I_IN) { transpose_item(P_w_in, D, INW, WIN_T, 1, scr, r, lane); continue; } r -= I_IN;
            if (r < I_OUT) { transpose_item(P_w_out, D, D, WOUT_T, 0, scr, r, lane); continue; } r -= I_OUT;
            if (r < I_GU) { transpose_item(P_w_gu, D, NGU, WGU_T, 2, scr, r, lane); continue; } r -= I_GU;
            if (r < I_DN) { transpose_item(P_w_down, DFF, D, WD_T, 0, scr, r, lane); continue; }
#pragma unroll
            for (int i = 0; i < 8; ++i) { const int j = lane + 64 * i; LB[j] = rcp(1.f + ex2((P_lbl[512 + j] - P_lbl[j]) * LOG2E)); }
        }
    }
    xcd_barrier(bar);

    {   PHASE_TID();
        LAS float* ms = (LAS float*)lds; LAS float* sh = ms + D;
        if (tid < 192) { const int idx = bx * 192 + tid; const int b = idx / NMOD, n = idx % NMOD; float v = P_b_ada[n];
#pragma unroll
            for (int ks = 0; ks < 8; ++ks) v += MODP[(size_t)(ks * 8 + b) * NMOD + n];
            MOD[idx] = v; }
        const int rows_per = T / G, row0 = bx * rows_per, b = row0 / S;
#pragma unroll
        for (int i = 0; i < 2; ++i) { const int k = tid + 512 * i; float s1 = P_b_ada[k], c1 = P_b_ada[1024 + k];
#pragma unroll
            for (int ks = 0; ks < 8; ++ks) { s1 += MODP[(size_t)(ks * 8 + b) * NMOD + k]; c1 += MODP[(size_t)(ks * 8 + b) * NMOD + 1024 + k]; }
            ms[k] = P_g1[k] * (1.f + c1); sh[k] = s1; }
        __syncthreads();
        for (int r = wave; r < rows_per; r += NWAVES) {
            const int row = row0 + r; const GAS f32x4* xr = (const GAS f32x4*)(P_x + (size_t)row * D) + lane;
            f32x4 v[4]; float s = 0.f;
#pragma unroll
            for (int j = 0; j < 4; ++j) { v[j] = xr[64 * j]; s += (v[j].x * v[j].x + v[j].y * v[j].y) + (v[j].z * v[j].z + v[j].w * v[j].w); }
            const float rstd = rsq(wsum64(s) * (1.f / D) + EPS);
            GAS unsigned long long* o8 = (GAS unsigned long long*)(XN + (size_t)row * D) + lane;
#pragma unroll
            for (int j = 0; j < 4; ++j) { const f32x4 m4 = *(const LAS f32x4*)(ms + 256 * j + 4 * lane), s4 = *(const LAS f32x4*)(sh + 256 * j + 4 * lane); const f32x4 o = v[j] * rstd * m4 + s4;
                o8[64 * j] = (unsigned long long)pk2(o.x, o.y) | ((unsigned long long)pk2(o.z, o.w) << 32); }
        }
    }
    xcd_barrier(bar);

    {
        pg8::Gemm g{XN, WIN_T, T, INW, D}; pg8::StaticOrder So; So.init(T, INW, G, bx);
        EpiIn E{QT, KT, VH, SG, AQ, AK, AV, DEC, LB};
        pg8::gemm_phase<EpiIn, pg8::StaticOrder, true, true>(lds, g, So, E, wave);
    }
    xcd_barrier(bar);

    if (vcu < 32) {   PHASE_TID();
        hgrn_scan(lds, KT, VH, DEC, STB, vcu, wave, lane);
    }
    {   PHASE_TID();
        attn_units(lds, AQ, AK, AV, ws, LSE, wave, lane, vcu * 24, vcu * 24 + 24);
    }
    xcd_barrier(bar);

    {   PHASE_TID();
        hgrn_out_units(lds, QT, KT, VH, SG, STB, P_hg_on, MIXIN, wave, lane, vcu * 8, vcu * 8 + 8);
        for (int t = gw; t < T; t += NGW) {
            const int c8 = lane * 8;
            {   const int h = lane >> 3;
                const float l0 = LSE[(size_t)t * 8 + h], l1 = LSE[(size_t)T * 8 + (size_t)t * 8 + h], l2 = LSE[(size_t)2 * T * 8 + (size_t)t * 8 + h];
                const float mx = fmaxf(l0, fmaxf(l1, l2)); float w0 = ex2(l0 - mx), w1 = ex2(l1 - mx), w2 = ex2(l2 - mx); const float inv = rcp(w0 + w1 + w2); w0 *= inv; w1 *= inv; w2 *= inv;
                const v4u a0 = *(const v4u*)((const bf16*)(ws + WS_ATT0) + (size_t)t * 512 + c8), a1 = *(const v4u*)((const bf16*)(ws + WS_ATT1) + (size_t)t * 512 + c8), a2 = *(const v4u*)((const bf16*)(ws + WS_ATT2) + (size_t)t * 512 + c8);
                float a[8];
                a[0] = w0 * bflo(a0.x) + w1 * bflo(a1.x) + w2 * bflo(a2.x); a[1] = w0 * bfhi(a0.x) + w1 * bfhi(a1.x) + w2 * bfhi(a2.x);
                a[2] = w0 * bflo(a0.y) + w1 * bflo(a1.y) + w2 * bflo(a2.y); a[3] = w0 * bfhi(a0.y) + w1 * bfhi(a1.y) + w2 * bfhi(a2.y);
                a[4] = w0 * bflo(a0.z) + w1 * bflo(a1.z) + w2 * bflo(a2.z); a[5] = w0 * bfhi(a0.z) + w1 * bfhi(a1.z) + w2 * bfhi(a2.z);
                a[6] = w0 * bflo(a0.w) + w1 * bflo(a1.w) + w2 * bflo(a2.w); a[7] = w0 * bfhi(a0.w) + w1 * bfhi(a1.w) + w2 * bfhi(a2.w);
                float ss = 0.f;
#pragma unroll
                for (int i = 0; i < 8; ++i) ss += a[i] * a[i];
                const float rstd = rsq(wsum64(ss) * (1.f / 512.f) + EPS);
                const f32x4 n0 = *(const f32x4*)(P_att_on + c8), n1 = *(const f32x4*)(P_att_on + c8 + 4);
#pragma unroll
                for (int i = 0; i < 4; ++i) { a[i] = a[i] * rstd * n0[i]; a[4 + i] = a[4 + i] * rstd * n1[i]; }
                v4u w; w.x = pk2(a[0], a[1]); w.y = pk2(a[2], a[3]); w.z = pk2(a[4], a[5]); w.w = pk2(a[6], a[7]);
                *(v4u*)(MIXIN + (size_t)t * D + 512 + c8) = w; }
        }
        __syncthreads();
        LAS float* sh2 = (LAS float*)lds;
        for (int i = tid; i < 8 * D; i += NWAVES * 64) sh2[i] = MOD[(i >> 10) * NMOD + 3072 + (i & 1023)];
        __syncthreads();
        const int ncol = NGU / G;
        for (int j = wave; j < ncol; j += NWAVES) { const int n = bx * ncol + j;
            const v4u w0 = *(const v4u*)(WGU_T + (size_t)n * D + lane * 16), w1 = *(const v4u*)(WGU_T + (size_t)n * D + lane * 16 + 8);
            const float wv[16] = {bflo(w0.x), bfhi(w0.x), bflo(w0.y), bfhi(w0.y), bflo(w0.z), bfhi(w0.z), bflo(w0.w), bfhi(w0.w), bflo(w1.x), bfhi(w1.x), bflo(w1.y), bfhi(w1.y), bflo(w1.z), bfhi(w1.z), bflo(w1.w), bfhi(w1.w)};
#pragma unroll
            for (int b = 0; b < 8; ++b) { float s = 0.f;
#pragma unroll
                for (int q4 = 0; q4 < 4; ++q4) { const f32x4 sv = *(const LAS f32x4*)(sh2 + b * D + lane * 16 + q4 * 4); s += wv[q4 * 4] * sv[0] + wv[q4 * 4 + 1] * sv[1] + wv[q4 * 4 + 2] * sv[2] + wv[q4 * 4 + 3] * sv[3]; }
                s = wsum64(s); if (lane == 0) BIAS2[b * NGU + n] = s; }
        }
        __syncthreads();
    }
    xcd_barrier(bar);

    {
        pg8::Gemm g{MIXIN, WOUT_T, T, D, D}; pg8::StaticOrder So; So.init(T, D, G, bx);
        EpiOut E{P_x, P_out, A2, SSQ1, MOD, P_g2};
        pg8::gemm_phase<EpiOut, pg8::StaticOrder, true, true>(lds, g, So, E, wave);
    }
    xcd_barrier(bar);

    {
        pg8::Gemm g{A2, WGU_T, T, NGU, D}; pg8::StaticOrder So; So.init(T, NGU, G, bx);
        EpiGU E{HID, SSQ1, BIAS2};
        pg8::gemm_phase<EpiGU, pg8::StaticOrder, true, true>(lds, g, So, E, wave);
    }
    xcd_barrier(bar);

    {
        pg8::Gemm g{HID, WD_T, T, D, DFF}; pg8::StaticOrder So; So.init(T, D, G, bx);
        EpiDown E{P_out, MOD};
        pg8::gemm_phase<EpiDown, pg8::StaticOrder, true, true>(lds, g, So, E, wave);
    }
    xcd_barrier(bar);

    PHASE_TID();
    for (int row = gw; row < T; row += NGW) {
        GAS f32x4* xr = (GAS f32x4*)(P_out + (size_t)row * D) + lane;
        f32x4 v[4]; float s = 0.f;
#pragma unroll
        for (int j = 0; j < 4; ++j) { v[j] = xr[64 * j]; s += (v[j].x * v[j].x + v[j].y * v[j].y) + (v[j].z * v[j].z + v[j].w * v[j].w); }
        const float rstd = rsq(wsum64(s) * (1.f / D) + EPS);
#pragma unroll
        for (int j = 0; j < 4; ++j) { const f32x4 g4 = *(const f32x4*)(P_gf + 256 * j + 4 * lane); xr[64 * j] = v[j] * rstd * g4; }
    }
}
}

extern "C" void kernel_launch(void* const* d_in, const int* in_sizes, int n_in, void* d_out, int out_size, void* d_ws, size_t ws_size, hipStream_t stream) {
    using namespace mk;
    static int grid = 0;
    if (grid == 0) {
        if (n_in != 14 || in_sizes[0] != T * D || out_size != T * D || ws_size < WS_END) { fprintf(stderr, "kernel_launch: unexpected shapes (n_in %d, in0 %d, out %d, ws %zu); nothing launched\n", n_in, n_in > 0 ? in_sizes[0] : -1, out_size, ws_size); grid = -1; return; }
        int dev = 0, cus = 0, per_cu = 0;
        if (hipGetDevice(&dev) != hipSuccess || hipDeviceGetAttribute(&cus, hipDeviceAttributeMultiprocessorCount, dev) != hipSuccess) { grid = -1; return; }
        if (hipFuncSetAttribute((const void*)mk_fwd, hipFuncAttributeMaxDynamicSharedMemorySize, LDS_BYTES) != hipSuccess) { fprintf(stderr, "kernel_launch: hipFuncSetAttribute failed\n"); grid = -1; return; }
        if (hipOccupancyMaxActiveBlocksPerMultiprocessor(&per_cu, (const void*)mk_fwd, NWAVES * 64, LDS_BYTES) != hipSuccess || per_cu < 1) { fprintf(stderr, "kernel_launch: occupancy query says %d blocks per CU\n", per_cu); per_cu = 1; }
        (void)hipGetLastError();
        grid = cus;
        if (grid != 256) { fprintf(stderr, "kernel_launch: this kernel is laid out for a 256-CU device, found %d CUs; nothing launched\n", grid); grid = -1; return; }
    }
    if (grid < 0) return;
    if (hipMemsetAsync((char*)d_ws + WS_CTL, 0, CTL_ZERO_BYTES, stream) != hipSuccess) { fprintf(stderr, "kernel_launch: hipMemsetAsync failed\n"); return; }
    Args a{};
    for (int i = 0; i < 14; ++i) a.in[i] = (const float*)d_in[i];
    a.out = (float*)d_out; a.ws = (unsigned char*)d_ws;
    hipLaunchKernelGGL(mk_fwd, dim3(grid), dim3(NWAVES * 64), LDS_BYTES, stream, a);
    const hipError_t le = hipPeekAtLastError();
    if (le != hipSuccess) fprintf(stderr, "kernel_launch: launch failed: %s\n", hipGetErrorName(le));
}
```

```cpp
#include <hip/hip_runtime.h>
#include <cstdio>
#include <cstdint>
namespace pg8 {
#define PG8_LAS __attribute__((address_space(3)))
typedef unsigned short bf16_t;
typedef short bf16x8 __attribute__((ext_vector_type(8)));
typedef float f32x4 __attribute__((ext_vector_type(4)));
typedef unsigned u32x4 __attribute__((ext_vector_type(4)));
constexpr int BM = 256, BK = 64, HALF = 128, HTB = HALF * BK * 2  , STAGE_BYTES = 8 * HTB, NXCD = 8, WGM = 8;

__host__ __device__ __forceinline__ int lds_byte(int r, int c) { const int st = (r >> 4) * 2 + (c >> 5), rr = r & 15, cc = c & 31, ob = rr * 64 + cc * 2; return st * 1024 + (ob ^ (((ob >> 9) & 1) << 5)); }
__host__ __device__ __forceinline__ void stage_rc(int b, int& R, int& C) { const int st = b / 1024, sb = b % 1024, swz = sb ^ (((sb >> 9) & 1) << 5); R = (st >> 1) * 16 + swz / 64; C = (st & 1) * 32 + (swz % 64) / 2; }
__host__ __device__ __forceinline__ int perm32(int rho) { const int n = rho >> 4, i = rho & 15; return 8 * (i >> 2) + 4 * n + (i & 3); }

struct Unit { int pm, pn; };
struct Gemm { const bf16_t* A; const bf16_t* Bt; int M, N, K; };

struct StaticOrder {
    int nM, nN, nwg, G, c;
    __host__ __device__ void init(int M, int N, int G_, int c_) { nM = M / BM; nN = N / BM; nwg = nM * nN; G = G_; c = c_; }
    __host__ __device__ bool next(int i, Unit& u) const {
        const long L = (long)i * G + c; if (L >= nwg) return false;
        int wgid = (int)L; { const int q = nwg / NXCD, r = nwg % NXCD, xcd = wgid % NXCD, off = wgid / NXCD; wgid = (xcd < r ? xcd * (q + 1) : r * (q + 1) + (xcd - r) * q) + off; }
        const int nig = WGM * nN, gid = wgid / nig, fm = gid * WGM, gsz = (nM - fm) < WGM ? (nM - fm) : WGM;
        u.pm = fm + ((wgid % nig) % gsz); u.pn = (wgid % nig) / gsz; return true;
    }
    __device__ __forceinline__ void a_ready(const Unit&) const {}
    __device__ __forceinline__ void done(const Unit&) const {}
};

__device__ __forceinline__ unsigned cvt_pk_bf16(float lo, float hi) { unsigned r; asm volatile("v_cvt_pk_bf16_f32 %0, %1, %2" : "=v"(r) : "v"(lo), "v"(hi)); return r; }
typedef float f32x2 __attribute__((ext_vector_type(2)));
template <class Epi, class Sched, bool ALIGN_EPI = false, bool SP2 = false>
__device__ __forceinline__ void gemm_phase(PG8_LAS unsigned char* lds, const Gemm g, const Sched& S, const Epi& E, const int wid_in  ) {
    int lane_o; asm volatile("v_mbcnt_lo_u32_b32 %0, -1, 0\n\tv_mbcnt_hi_u32_b32 %0, -1, %0" : "=&v"(lane_o));
    const int wid = wid_in, lane = lane_o, tid = wid * 64 + lane, wr = wid >> 2, wc = wid & 3, fr = lane & 15, fq = lane >> 4;
    const int K = g.K, nt = K / BK;
    unsigned voffA[2], voffB[2];
#pragma unroll
    for (int i = 0; i < 2; ++i) { int R, C; stage_rc(tid * 16 + i * 8192, R, C); const int Rb = Epi::PERM ? ((R & ~31) + perm32(R & 31)) : R;
        voffA[i] = (unsigned)(R * K + C) * 2u; voffB[i] = (unsigned)(Rb * K + C) * 2u; }
    const size_t kstep = (size_t)(BK * 2);
    const size_t hstep = (size_t)HALF * K * 2;
    const size_t tstep = 2 * hstep;
    const unsigned ldsw = (unsigned)wid * 1024u;
    const int aoff = lds_byte(wr * 64 + fr, fq * 8), boff = lds_byte(wc * 32 + fr, fq * 8);
#define PG8_SA(b, h) (((b) * 2 + (h)) * HTB)
#define PG8_SB(b, h) ((4 + (b) * 2 + (h)) * HTB)
#define PG8_STAGE(bufoff, gbase, voff) do { _Pragma("unroll") for (int _i = 0; _i < 2; ++_i) \
        __builtin_amdgcn_global_load_lds((const unsigned*)((const char*)(gbase) + (voff)[_i]), (PG8_LAS unsigned*)(lds + (bufoff) + ldsw + _i * 8192), 16, 0, 0); } while (0)
#define PG8_LDA(dst, b, h) do { _Pragma("unroll") for (int m = 0; m < 4; ++m) _Pragma("unroll") for (int k = 0; k < 2; ++k) dst[m][k] = *(const PG8_LAS bf16x8*)(lds + PG8_SA(b, h) + aoff + m * 2048 + k * 1024); } while (0)
#define PG8_LDB(dst, b, h) do { _Pragma("unroll") for (int n = 0; n < 2; ++n) _Pragma("unroll") for (int k = 0; k < 2; ++k) dst[n][k] = *(const PG8_LAS bf16x8*)(lds + PG8_SB(b, h) + boff + n * 2048 + k * 1024); } while (0)
#define PG8_MMA(ai, bj, At, Bt) do { __builtin_amdgcn_s_setprio(1); _Pragma("unroll") for (int m = 0; m < 4; ++m) _Pragma("unroll") for (int n = 0; n < 2; ++n) _Pragma("unroll") for (int k = 0; k < 2; ++k) \
        acc[ai][bj][m][n] = __builtin_amdgcn_mfma_f32_16x16x32_bf16(Bt[n][k], At[m][k], acc[ai][bj][m][n], 0, 0, 0); __builtin_amdgcn_s_setprio(0); } while (0)
#define PG8_WAIT_V(n) asm volatile("s_waitcnt vmcnt(" #n ")" ::: "memory")
#define PG8_WAIT_L(n) asm volatile("s_waitcnt lgkmcnt(" #n ")" ::: "memory")
#define PG8_BAR __builtin_amdgcn_s_barrier()
#define PG8_SCHED __builtin_amdgcn_sched_barrier(0)
    Unit cur, nxt; int ui = 0;
    if (!S.next(0, cur)) return;
    f32x4 acc[2][2][4][2];
#pragma unroll
    for (int a = 0; a < 2; ++a)
#pragma unroll
        for (int b = 0; b < 2; ++b)
#pragma unroll
            for (int m = 0; m < 4; ++m)
#pragma unroll
                for (int n = 0; n < 2; ++n) acc[a][b][m][n] = (f32x4){0.f, 0.f, 0.f, 0.f};
    bf16x8 At[4][2], B0[2][2], B1[2][2];
    const char* cA = (const char*)g.A + (size_t)cur.pm * tstep; const char* cB = (const char*)g.Bt + (size_t)cur.pn * tstep;
    S.a_ready(cur);
    if constexpr (SP2) {
        PG8_STAGE(PG8_SB(0, 0), cB, voffB); PG8_STAGE(PG8_SB(0, 1), cB + hstep, voffB); PG8_STAGE(PG8_SA(0, 0), cA, voffA); PG8_STAGE(PG8_SA(0, 1), cA + hstep, voffA);
        if (wr == 1) PG8_BAR;
        PG8_WAIT_V(2); PG8_BAR;
        PG8_STAGE(PG8_SB(1, 0), cB + kstep, voffB); PG8_STAGE(PG8_SA(1, 0), cA + kstep, voffA); PG8_STAGE(PG8_SB(1, 1), cB + hstep + kstep, voffB);
        PG8_WAIT_V(6); PG8_BAR;
    } else {
        PG8_STAGE(PG8_SB(0, 0), cB, voffB); PG8_STAGE(PG8_SA(0, 0), cA, voffA); PG8_STAGE(PG8_SB(0, 1), cB + hstep, voffB); PG8_STAGE(PG8_SA(0, 1), cA + hstep, voffA);
        if (wr == 1) PG8_BAR;
        PG8_WAIT_V(4); PG8_BAR;
        PG8_STAGE(PG8_SB(1, 0), cB + kstep, voffB); PG8_STAGE(PG8_SA(1, 0), cA + kstep, voffA); PG8_STAGE(PG8_SB(1, 1), cB + hstep + kstep, voffB);
        PG8_WAIT_V(6); PG8_BAR;
    }
    for (;;) {
        const bool has_next = S.next(ui + 1, nxt);
        const char* nA = has_next ? (const char*)g.A + (size_t)nxt.pm * tstep : cA; const char* nB = has_next ? (const char*)g.Bt + (size_t)nxt.pn * tstep : cB;
        for (int t = 0; t < nt; t += 2) {
            const bool last = (t == nt - 2);
            const char* a1 = cA + (size_t)(t + 1) * kstep;
            const char* a2 = last ? nA : cA + (size_t)(t + 2) * kstep; const char* b2 = last ? nB : cB + (size_t)(t + 2) * kstep;
            const char* a3 = a2 + kstep; const char* b3 = b2 + kstep;
            if (last && has_next) S.a_ready(nxt);
            if constexpr (SP2) {
            PG8_LDB(B0, 0, 0); PG8_LDB(B1, 0, 1); PG8_SCHED; PG8_LDA(At, 0, 0); PG8_STAGE(PG8_SA(1, 1), a1 + hstep, voffA);
            PG8_WAIT_V(8); PG8_WAIT_L(0); PG8_BAR; PG8_MMA(0, 0, At, B0); PG8_MMA(0, 1, At, B1); PG8_BAR; PG8_SCHED;
            PG8_LDA(At, 0, 1); PG8_STAGE(PG8_SB(0, 0), b2, voffB); PG8_STAGE(PG8_SB(0, 1), b2 + hstep, voffB); PG8_STAGE(PG8_SA(0, 0), a2, voffA);
            PG8_WAIT_V(8); PG8_WAIT_L(0); PG8_BAR; PG8_MMA(1, 0, At, B0); PG8_MMA(1, 1, At, B1); PG8_BAR; PG8_SCHED;
            PG8_LDB(B0, 1, 0); PG8_LDB(B1, 1, 1); PG8_SCHED; PG8_LDA(At, 1, 0); PG8_STAGE(PG8_SA(0, 1), a2 + hstep, voffA);
            PG8_WAIT_V(8); PG8_WAIT_L(0); PG8_BAR; PG8_MMA(0, 0, At, B0); PG8_MMA(0, 1, At, B1); PG8_BAR; PG8_SCHED;
            PG8_LDA(At, 1, 1); PG8_STAGE(PG8_SB(1, 0), b3, voffB); PG8_STAGE(PG8_SB(1, 1), b3 + hstep, voffB); PG8_STAGE(PG8_SA(1, 0), a3, voffA);
            PG8_WAIT_V(8); PG8_WAIT_L(0); PG8_BAR; PG8_MMA(1, 0, At, B0); PG8_MMA(1, 1, At, B1); PG8_BAR; PG8_SCHED;
            } else {
            PG8_LDB(B0, 0, 0); PG8_SCHED; PG8_LDA(At, 0, 0); PG8_STAGE(PG8_SA(1, 1), a1 + hstep, voffA);
            PG8_WAIT_L(8); PG8_BAR; PG8_WAIT_L(0); PG8_MMA(0, 0, At, B0); PG8_BAR; PG8_SCHED;
            PG8_LDB(B1, 0, 1); PG8_STAGE(PG8_SB(0, 0), b2, voffB);
            PG8_BAR; PG8_WAIT_L(0); PG8_MMA(0, 1, At, B1); PG8_BAR;
            PG8_LDA(At, 0, 1); PG8_STAGE(PG8_SA(0, 0), a2, voffA);
            PG8_BAR; PG8_WAIT_L(0); PG8_MMA(1, 0, At, B0); PG8_BAR; PG8_SCHED;
            PG8_STAGE(PG8_SB(0, 1), b2 + hstep, voffB);
            PG8_WAIT_V(6); PG8_BAR; PG8_MMA(1, 1, At, B1); PG8_BAR;
            PG8_LDB(B0, 1, 0); PG8_SCHED; PG8_LDA(At, 1, 0); PG8_STAGE(PG8_SA(0, 1), a2 + hstep, voffA);
            PG8_WAIT_L(8); PG8_BAR; PG8_WAIT_L(0); PG8_MMA(0, 0, At, B0); PG8_BAR; PG8_SCHED;
            PG8_LDB(B1, 1, 1); PG8_STAGE(PG8_SB(1, 0), b3, voffB);
            PG8_BAR; PG8_WAIT_L(0); PG8_MMA(0, 1, At, B1); PG8_BAR;
            PG8_LDA(At, 1, 1); PG8_STAGE(PG8_SA(1, 0), a3, voffA);
            PG8_BAR; PG8_WAIT_L(0); PG8_MMA(1, 0, At, B0); PG8_BAR; PG8_SCHED;
            PG8_STAGE(PG8_SB(1, 1), b3 + hstep, voffB);
            PG8_WAIT_V(6); PG8_BAR; PG8_MMA(1, 1, At, B1); PG8_BAR;
            }
        }
        if constexpr (ALIGN_EPI) { if (wr == 0) PG8_BAR; }
        if constexpr (!Epi::AFTER_DRAIN) { E(acc, cur, wr, wc, fr, fq); S.done(cur); }
        if (!has_next) break;
#pragma unroll
        for (int a = 0; a < 2; ++a)
#pragma unroll
            for (int b = 0; b < 2; ++b)
#pragma unroll
                for (int m = 0; m < 4; ++m)
#pragma unroll
                    for (int n = 0; n < 2; ++n) acc[a][b][m][n] = (f32x4){0.f, 0.f, 0.f, 0.f};
        cur = nxt; cA = nA; cB = nB; ++ui;
        if constexpr (ALIGN_EPI) { if (wr == 1) PG8_BAR; }
    }
    PG8_WAIT_V(0);
    if constexpr (!ALIGN_EPI) { if (wr == 0) PG8_BAR; }
    PG8_BAR;
    if constexpr (Epi::AFTER_DRAIN) { E.fused(acc, cur, wr, wc, fr, fq, lds, wid, lane); S.done(cur); }
#undef PG8_SA
#undef PG8_SB
#undef PG8_STAGE
#undef PG8_LDA
#undef PG8_LDB
#undef PG8_MMA
#undef PG8_WAIT_V
#undef PG8_WAIT_L
#undef PG8_BAR
#undef PG8_SCHED
}
}
#define GAS __attribute__((address_space(1)))
#define LAS __attribute__((address_space(3)))
typedef unsigned short bf16;
typedef unsigned v4u __attribute__((ext_vector_type(4)));
typedef float f32x4 __attribute__((ext_vector_type(4)));
typedef short bf16x8 __attribute__((ext_vector_type(8)));
typedef GAS unsigned gu32;
typedef GAS unsigned long long gu64;
#define RLX_AGENT __ATOMIC_RELAXED, __HIP_MEMORY_SCOPE_AGENT
#define LDS_WAIT() asm volatile("s_waitcnt lgkmcnt(0)" ::: "memory")
#define VM_WAIT() asm volatile("s_waitcnt vmcnt(0)" ::: "memory")
__device__ __forceinline__ unsigned long long rt() { return __builtin_amdgcn_s_memrealtime(); }
__device__ __forceinline__ unsigned f2bf(float f) { unsigned u = __builtin_bit_cast(unsigned, f); return (u + 0x7fffu + ((u >> 16) & 1u)) >> 16; }
__device__ __forceinline__ unsigned pk2(float lo, float hi) { return f2bf(lo) | (f2bf(hi) << 16); }
#define XB_TMO      128
#define XB_XCNT(j)  (256  + 64 * (j))
#define XB_XSUB(j)  (1280 + 64 * (j))
#define XB_XGEN(j)  (2304 + 64 * (j))
#define XB_TOP      3328
#define XB_TOPGEN   3392
#define XCD_BAR_WORDS 3456
#define XB_SPIN_CAP (1u << 24)

__device__ __forceinline__ unsigned xb_ld(unsigned* p)              { return __hip_atomic_load(p, __ATOMIC_RELAXED, __HIP_MEMORY_SCOPE_AGENT); }
__device__ __forceinline__ unsigned xb_add(unsigned* p, unsigned v) { return __hip_atomic_fetch_add(p, v, __ATOMIC_RELAXED, __HIP_MEMORY_SCOPE_AGENT); }
__device__ __forceinline__ unsigned xb_xcc_id() { return (unsigned)__builtin_amdgcn_s_getreg((3 << 11) | 20) & 0xFu; }
#define XB_SPIN(cond, bar) do { unsigned _sp = 0; while (cond) { __builtin_amdgcn_s_sleep(1); \
    if ((++_sp & 255u) == 0u) { if (xb_ld(&(bar)[XB_TMO])) break; if (_sp > XB_SPIN_CAP) { atomicAdd(&(bar)[XB_TMO], 1u); break; } } } } while (0)

struct XcdBarrier {
    unsigned* bar; unsigned x;
    volatile LAS unsigned* st;
};

__device__ __forceinline__ XcdBarrier xcd_barrier_post(unsigned* bar, volatile LAS unsigned* st) {
    XcdBarrier b; b.bar = bar; b.x = xb_xcc_id(); b.st = st;
    if (threadIdx.x == 0) (void)xb_add(&bar[XB_XCNT(b.x)], 1u);
    return b;
}
__device__ __forceinline__ void xcd_barrier_complete(unsigned* bar, unsigned x, unsigned& nloc, unsigned& nx) {
    const unsigned G = gridDim.x * gridDim.y * gridDim.z;
    unsigned sum, cnt, mine, sp = 0u;
    for (;;) {
        sum = 0u; cnt = 0u; mine = 0u;
#pragma unroll
        for (unsigned j = 0; j < 16; ++j) { const unsigned c = xb_ld(&bar[XB_XCNT(j)]); sum += c; cnt += (c > 0u) ? 1u : 0u; mine = (j == x) ? c : mine; }
        if (sum == G) break;
        __builtin_amdgcn_s_sleep(1);
        if ((++sp & 255u) == 0u) { if (xb_ld(&bar[XB_TMO])) break; if (sp > XB_SPIN_CAP) { atomicAdd(&bar[XB_TMO], 1u); break; } }
    }
    nloc = mine > 0u ? mine : 1u; nx = cnt > 0u ? cnt : 1u;
}

__device__ __forceinline__ void xcd_barrier(const XcdBarrier& b) {
    asm volatile("s_waitcnt vmcnt(0)" ::: "memory");
    __syncthreads();
    if (threadIdx.x == 0) {
        unsigned* bar = b.bar;
        __builtin_amdgcn_s_waitcnt(0);
        unsigned nloc = b.st[0], nx = b.st[1];
        if (nloc == 0u) { xcd_barrier_complete(bar, b.x, nloc, nx); b.st[0] = nloc; b.st[1] = nx; }
        const unsigned old = xb_add(&bar[XB_XSUB(b.x)], 1u);
        const unsigned gen = old / nloc;
        if (old + 1u == (gen + 1u) * nloc) {
            __builtin_amdgcn_fence(__ATOMIC_RELEASE, "agent");
            asm volatile("s_waitcnt vmcnt(0)" ::: "memory");
            const unsigned og = xb_add(&bar[XB_TOP], 1u);
            const unsigned tg = og / nx;
            if (og + 1u == (tg + 1u) * nx) xb_add(&bar[XB_TOPGEN], 1u);
            else XB_SPIN(xb_ld(&bar[XB_TOPGEN]) == tg, bar);
            __builtin_amdgcn_fence(__ATOMIC_ACQUIRE, "agent");
            xb_add(&bar[XB_XGEN(b.x)], 1u);
            asm volatile("s_waitcnt vmcnt(0)" ::: "memory");
        } else {
            XB_SPIN(xb_ld(&bar[XB_XGEN(b.x)]) == gen, bar);
            __builtin_amdgcn_fence(__ATOMIC_ACQUIRE, "agent");
            asm volatile("s_waitcnt vmcnt(0)" ::: "memory");
        }
    }
    __syncthreads();
}
namespace mk {
using pg8::f32x4; using pg8::Unit; using pg8::bf16_t; using pg8::u32x4; using pg8::cvt_pk_bf16;
typedef unsigned u32x2 __attribute__((ext_vector_type(2)));
constexpr int B = 8, S = 4096, D = 1024, T = B * S, INW = 3584, DFF = 2816, NMOD = 6144, NGU = 2 * DFF;
constexpr float EPS = 1e-6f, LOG2E = 1.4426950408889634f, QSCALE = 0.125f * 1.4426950408889634f;
#define EPI_LANES() int lane_; asm volatile("v_mbcnt_lo_u32_b32 %0, -1, 0\n\tv_mbcnt_hi_u32_b32 %0, -1, %0" : "=&v"(lane_)); const int wr = wr_, wc = wc_, fr = lane_ & 15, fq = lane_ >> 4; (void)fr_; (void)fq_;
template <int CTRL> __device__ __forceinline__ float dpp_mov0(float v) { return __int_as_float(__builtin_amdgcn_update_dpp(0, __float_as_int(v), CTRL, 0xF, 0xF, false)); }
__device__ __forceinline__ float row_scan16(float s) { s += dpp_mov0<0x111>(s); s += dpp_mov0<0x112>(s); s += dpp_mov0<0x114>(s); s += dpp_mov0<0x118>(s); return s; }
__device__ __forceinline__ float row_sum16(float s) { s += dpp_mov0<0x128>(s); s += dpp_mov0<0x124>(s); s += dpp_mov0<0x122>(s); s += dpp_mov0<0x121>(s); return s; }
__device__ __forceinline__ float ex2(float x) { return __builtin_amdgcn_exp2f(x); }
__device__ __forceinline__ float lg2(float x) { return __builtin_amdgcn_logf(x); }
__device__ __forceinline__ float rcp(float x) { return __builtin_amdgcn_rcpf(x); }
__device__ __forceinline__ float rsq(float x) { return __builtin_amdgcn_rsqf(x); }
__device__ __forceinline__ float silu(float x) { return x * rcp(1.f + ex2(-x * LOG2E)); }
typedef short bf16x8 __attribute__((ext_vector_type(8)));
typedef float f32x2c __attribute__((ext_vector_type(2))); typedef __bf16 bf16x2c __attribute__((ext_vector_type(2)));
__device__ __forceinline__ unsigned pk2r(float lo, float hi) { const f32x2c v = {lo, hi}; return __builtin_bit_cast(unsigned, __builtin_convertvector(v, bf16x2c)); }
__device__ __forceinline__ float bf2f(unsigned short h) { return __uint_as_float(((unsigned)h) << 16); }
__device__ __forceinline__ float bflo(unsigned w) { return __uint_as_float(w << 16); }
__device__ __forceinline__ float bfhi(unsigned w) { return __uint_as_float(w & 0xffff0000u); }

struct EpiIn {
    static constexpr bool PERM = true, AFTER_DRAIN = false;
    bf16_t *QT, *KT, *VH, *SG, *AQ, *AK, *AV; float* DEC; const float* lb;
    __device__ __forceinline__ void operator()(f32x4 (&acc)[2][2][4][2], const Unit& u, int wr_, int wc_, int fr_, int fq_) const {
        EPI_LANES();
        const int pn = u.pn; const unsigned row0 = (unsigned)(u.pm * 256 + wr * 64 + fr);
#ifndef NO_HGRN_EPI
        if (pn < 4) {
            const int cb = pn * 128 + wc * 32 + 8 * fq;
            const f32x4 l0 = *(const f32x4*)(lb + cb), l1 = *(const f32x4*)(lb + cb + 4);
#pragma unroll
            for (int ai = 0; ai < 2; ++ai) {
                const unsigned chunk = (unsigned)(u.pm * 4 + ai * 2 + wr);
#pragma unroll
                for (int n = 0; n < 2; ++n) {
                    float dl[4];
#pragma unroll
                    for (int j = 0; j < 4; ++j) {
                        const float lbv = n == 0 ? l0[j] : l1[j], omlb = 1.f - lbv;
                        float lgv[4], b2[4]; float carry = 0.f;
#pragma unroll
                        for (int m = 0; m < 4; ++m) { const float e = ex2(-acc[ai][1][m][n][j] * LOG2E), sg = rcp(1.f + e); lgv[m] = lg2(lbv + omlb * sg); acc[ai][1][m][n][j] = omlb * (e * sg); }
#pragma unroll
                        for (int m = 0; m < 4; ++m) { const float s = row_scan16(lgv[m]), tot = row_sum16(lgv[m]); b2[m] = carry + s; carry += tot; }
                        dl[j] = ex2(carry);
#pragma unroll
                        for (int m = 0; m < 4; ++m) { acc[ai][0][m][n][j] = silu(acc[ai][0][m][n][j]) * ex2(b2[m]); acc[ai][1][m][n][j] *= ex2(-b2[m]); }
                        __builtin_amdgcn_sched_barrier(0);
                    }
                    *(f32x4*)(DEC + (chunk * 512u + (unsigned)(cb + 4 * n))) = (f32x4){dl[0], dl[1], dl[2], dl[3]};
#pragma unroll
                    for (int m = 0; m < 4; ++m) { const unsigned off = (row0 + ai * 128 + m * 16) * 512u + (unsigned)(cb + 4 * n);
                        const f32x4 q = acc[ai][0][m][n], k = acc[ai][1][m][n];
                        u32x2 w; w.x = pk2r(q[0], q[1]); w.y = pk2r(q[2], q[3]); *(u32x2*)(QT + off) = w;
                        u32x2 kw; kw.x = pk2r(k[0], k[1]); kw.y = pk2r(k[2], k[3]); *(u32x2*)(KT + off) = kw; }
                    __builtin_amdgcn_sched_barrier(0);
                }
            }
        } else
#endif
        {
            const int g = (pn - 4) >> 1; bf16_t* base = g == 0 ? VH : g == 1 ? SG : g == 2 ? AQ : g == 3 ? AK : AV;
            const unsigned col0 = (unsigned)(((pn - 4) & 1) * 256 + wc * 32 + 8 * fq);
#pragma unroll
            for (int ai = 0; ai < 2; ++ai)
#pragma unroll
                for (int m = 0; m < 4; ++m) { bf16_t* rowp = base + ((row0 + ai * 128 + m * 16) * 512u + col0);
#pragma unroll
                    for (int bj = 0; bj < 2; ++bj) { f32x4 v0 = acc[ai][bj][m][0], v1 = acc[ai][bj][m][1];
                        if (g == 1) {
#pragma unroll
                            for (int j = 0; j < 4; ++j) { v0[j] = silu(v0[j]); v1[j] = silu(v1[j]); } }
                        if (g == 2) { v0 = v0 * QSCALE; v1 = v1 * QSCALE; }
                        u32x4 w; w.x = pk2r(v0[0], v0[1]); w.y = pk2r(v0[2], v0[3]); w.z = pk2r(v1[0], v1[1]); w.w = pk2r(v1[2], v1[3]);
                        *(u32x4*)(rowp + bj * 128) = w; } }
        }
    }
};

struct EpiOut {
    static constexpr bool PERM = false, AFTER_DRAIN = false;
    const float* x; float* x1; bf16_t* A2; float* ssq; const float* mod; const float* g2;
    __device__ __forceinline__ void operator()(const f32x4 (&acc)[2][2][4][2], const Unit& u, int wr_, int wc_, int fr_, int fq_) const {
        EPI_LANES();
        const int b = u.pm >> 4, col0 = u.pn * 256 + wc * 32 + 4 * fq, rowb = u.pm * 256 + wr * 64 + fr; const float* modb = mod + b * NMOD;
        float ssr[2][4];
#pragma unroll
        for (int ai = 0; ai < 2; ++ai)
#pragma unroll
            for (int m = 0; m < 4; ++m) ssr[ai][m] = 0.f;
#pragma unroll
        for (int bj = 0; bj < 2; ++bj)
#pragma unroll
            for (int n = 0; n < 2; ++n) { const int c = col0 + bj * 128 + n * 16;
                const f32x4 gate = *(const f32x4*)(modb + 2048 + c), sc2 = *(const f32x4*)(modb + 4096 + c), gg = *(const f32x4*)(g2 + c); const f32x4 mul = gg * (sc2 + 1.0f);
#pragma unroll
                for (int ai = 0; ai < 2; ++ai)
#pragma unroll
                    for (int m = 0; m < 4; ++m) { const size_t off = (size_t)(rowb + ai * 128 + m * 16) * D + c;
                        const f32x4 v = *(const f32x4*)(x + off) + gate * acc[ai][bj][m][n]; *(f32x4*)(x1 + off) = v;
                        ssr[ai][m] += (v[0] * v[0] + v[1] * v[1]) + (v[2] * v[2] + v[3] * v[3]);
                        const f32x4 a = v * mul; u32x2 w; w.x = pk2r(a[0], a[1]); w.y = pk2r(a[2], a[3]); *(u32x2*)(A2 + off) = w; } }
#pragma unroll
        for (int ai = 0; ai < 2; ++ai)
#pragma unroll
            for (int m = 0; m < 4; ++m) { float s = ssr[ai][m]; s += __shfl_xor(s, 16); s += __shfl_xor(s, 32);
                if (fq == 0) ssq[(size_t)(rowb + ai * 128 + m * 16) * 16 + u.pn * 4 + wc] = s; }
    }
};

struct EpiGU {
    static constexpr bool PERM = true, AFTER_DRAIN = false;
    bf16_t* HID; const float* ssq; const float* bias2;
    __device__ __forceinline__ void operator()(const f32x4 (&acc)[2][2][4][2], const Unit& u, int wr_, int wc_, int fr_, int fq_) const {
        EPI_LANES();
        const int b = u.pm >> 4, rowb = u.pm * 256 + wr * 64 + fr; const float* bb = bias2 + b * NGU + u.pn * 256 + wc * 32 + 8 * fq;
        const f32x4 ba0 = *(const f32x4*)(bb), ba1 = *(const f32x4*)(bb + 4), bu0 = *(const f32x4*)(bb + 128), bu1 = *(const f32x4*)(bb + 132);
#pragma unroll
        for (int ai = 0; ai < 2; ++ai)
#pragma unroll
            for (int m = 0; m < 4; ++m) { const int row = rowb + ai * 128 + m * 16; const f32x4* sp = (const f32x4*)(ssq + (size_t)row * 16);
                const f32x4 s0 = sp[0], s1 = sp[1], s2 = sp[2], s3 = sp[3]; const f32x4 st = (s0 + s1) + (s2 + s3);
                const float rstd = rsq(((st[0] + st[1]) + (st[2] + st[3])) * (1.0f / D) + EPS);
                const f32x4 a0 = acc[ai][0][m][0] * rstd + ba0, a1 = acc[ai][0][m][1] * rstd + ba1, u0 = acc[ai][1][m][0] * rstd + bu0, u1 = acc[ai][1][m][1] * rstd + bu1;
                float h[8];
#pragma unroll
                for (int j = 0; j < 4; ++j) { h[j] = silu(a0[j]) * u0[j]; h[4 + j] = silu(a1[j]) * u1[j]; }
                u32x4 w; w.x = pk2r(h[0], h[1]); w.y = pk2r(h[2], h[3]); w.z = pk2r(h[4], h[5]); w.w = pk2r(h[6], h[7]);
                *(u32x4*)(HID + (size_t)row * DFF + u.pn * 128 + wc * 32 + 8 * fq) = w; }
    }
};

struct EpiDown {
    static constexpr bool PERM = false, AFTER_DRAIN = false;
    float* xio; const float* mod;
    __device__ __forceinline__ void operator()(const f32x4 (&acc)[2][2][4][2], const Unit& u, int wr_, int wc_, int fr_, int fq_) const {
        EPI_LANES();
        const int b = u.pm >> 4, col0 = u.pn * 256 + wc * 32 + 4 * fq, rowb = u.pm * 256 + wr * 64 + fr; const float* modb = mod + b * NMOD;
#pragma unroll
        for (int bj = 0; bj < 2; ++bj)
#pragma unroll
            for (int n = 0; n < 2; ++n) { const int c = col0 + bj * 128 + n * 16; const f32x4 gate = *(const f32x4*)(modb + 5120 + c);
#pragma unroll
                for (int ai = 0; ai < 2; ++ai)
#pragma unroll
                    for (int m = 0; m < 4; ++m) { const size_t off = (size_t)(rowb + ai * 128 + m * 16) * D + c; *(f32x4*)(xio + off) = *(const f32x4*)(xio + off) + gate * acc[ai][bj][m][n]; } }
    }
};
}
namespace mk {
constexpr int NWAVES = 8;
constexpr size_t MiB = 1u << 20;
constexpr size_t WS_CTL = 0, CTL_ZERO_BYTES = 64 * 1024;
constexpr size_t WS_MODP = 1 * MiB;
constexpr size_t WS_MOD = 3 * MiB, WS_LB = WS_MOD + 256 * 1024, WS_BIAS2 = WS_MOD + 512 * 1024;
constexpr size_t WS_WIN = 4 * MiB, WS_WOUT = 11 * MiB, WS_WGU = 13 * MiB, WS_WD = 24 * MiB;
constexpr size_t WS_DEC = 30 * MiB, WS_LSE = 31 * MiB, WS_SSQ1 = 34 * MiB;
constexpr size_t WS_BUFA = 40 * MiB;
constexpr size_t WS_BUFB = 104 * MiB;
constexpr size_t WS_R = 168 * MiB;
constexpr size_t WS_QT = WS_R, WS_KT = WS_R + 32 * MiB, WS_VH = WS_R + 64 * MiB, WS_SG = WS_R + 96 * MiB, WS_AQ = WS_R + 128 * MiB, WS_AK = WS_R + 160 * MiB, WS_AV = WS_R + 192 * MiB;
constexpr size_t WS_ST = WS_BUFA;
constexpr size_t WS_ATT0 = WS_R + 224 * MiB, WS_ATT1 = WS_R + 256 * MiB, WS_ATT2 = WS_R + 288 * MiB;
constexpr size_t WS_HID = WS_R;
constexpr size_t WS_END = WS_R + 320 * MiB;
constexpr int CW_BAR = 4096;
constexpr int RING_BYTES = 131072, LDS_BYTES = 163840, LDSCTL_OFF = LDS_BYTES - 512, MISC_OFF = LDSCTL_OFF + 320;

__device__ __forceinline__ const float* karg_ptr(int i) {
    asm volatile("" : "+s"(i));
    typedef const float* cfp;
    const __attribute__((address_space(4))) cfp* ka = (const __attribute__((address_space(4))) cfp*)__builtin_amdgcn_kernarg_segment_ptr();
    return ka[i];
}

__device__ __forceinline__ void transpose_item(const float* W, int K, int N, bf16* WT, int mode, LAS float* scr, int item, int lane) {
    const int nblk = N / 32, kb = item / nblk, nb = item % nblk, k0 = 64 * kb, n0 = 32 * nb;
    int r0 = n0;
    if (mode == 1) { if (n0 < 512) r0 = (n0 >> 7) * 256 + (n0 & 127); else if (n0 < 1024) r0 = ((n0 - 512) >> 7) * 256 + 128 + (n0 & 127); }
    if (mode == 2) { if (n0 < DFF) r0 = (n0 >> 7) * 256 + (n0 & 127); else r0 = ((n0 - DFF) >> 7) * 256 + 128 + ((n0 - DFF) & 127); }
#pragma unroll 8
    for (int i = 0; i < 32; ++i) { const int kk = 2 * i + (lane >> 5); scr[kk * 33 + (lane & 31)] = W[(size_t)(k0 + kk) * N + n0 + (lane & 31)]; }
    LDS_WAIT(); asm volatile("" ::: "memory");
    const int c = lane & 7;
#pragma unroll
    for (int j = 0; j < 4; ++j) { const int n = (lane >> 3) + 8 * j; const LAS float* s = scr + (8 * c) * 33 + n;
        v4u o; o.x = pk2(s[0 * 33], s[1 * 33]); o.y = pk2(s[2 * 33], s[3 * 33]); o.z = pk2(s[4 * 33], s[5 * 33]); o.w = pk2(s[6 * 33], s[7 * 33]);
        *(GAS v4u*)(WT + (size_t)(r0 + n) * K + k0 + 8 * c) = o; }
    LDS_WAIT(); asm volatile("" ::: "memory");
}
__device__ __forceinline__ void mod_partial(const float* Pc, const float* Pw_ada, float* modp, LAS float* scr, int it, int lane) {
    const int cg = it % 96, ks = it / 96, n = cg * 64 + lane;
#pragma unroll
    for (int i = 0; i < 16; ++i) { const int idx = i * 64 + lane, kk = idx & 127, b = idx >> 7; scr[kk * 8 + b] = silu(Pc[b * D + ks * 128 + kk]); }
    LDS_WAIT(); asm volatile("" ::: "memory");
    float acc[8];
#pragma unroll
    for (int b = 0; b < 8; ++b) acc[b] = 0.f;
    const float* wp = Pw_ada + (size_t)(ks * 128) * NMOD + n;
#pragma unroll 16
    for (int kk = 0; kk < 128; ++kk) { const float w = wp[(size_t)kk * NMOD]; const f32x4 c0 = *(const LAS f32x4*)(scr + kk * 8), c1 = *(const LAS f32x4*)(scr + kk * 8 + 4);
        acc[0] += c0[0] * w; acc[1] += c0[1] * w; acc[2] += c0[2] * w; acc[3] += c0[3] * w; acc[4] += c1[0] * w; acc[5] += c1[1] * w; acc[6] += c1[2] * w; acc[7] += c1[3] * w; }
#pragma unroll
    for (int b = 0; b < 8; ++b) modp[(size_t)(ks * 8 + b) * NMOD + n] = acc[b];
    LDS_WAIT(); asm volatile("" ::: "memory");
}
__device__ __forceinline__ float wsum64(float v) {
#pragma unroll
    for (int o = 1; o < 64; o <<= 1) v += __shfl_xor(v, o);
    return v;
}
__device__ __forceinline__ float wmax64(float v) {
#pragma unroll
    for (int o = 1; o < 64; o <<= 1) v = fmaxf(v, __shfl_xor(v, o));
    return v;
}

typedef short s16x4v __attribute__((ext_vector_type(4)));
#define LBAR() asm volatile("s_waitcnt lgkmcnt(0)\n\ts_barrier" ::: "memory")
#define TOPBAR() asm volatile("s_waitcnt vmcnt(0) lgkmcnt(0)\n\ts_barrier" ::: "memory")
#define TOUCH(x) asm volatile("" : "+v"(x))
__device__ __forceinline__ void glds16(const void* gsrc, unsigned lds_dst) { unsigned keep;
    asm volatile("s_mov_b32 %0, m0\n\ts_mov_b32 m0, %2\n\ts_nop 0\n\tglobal_load_lds_dwordx4 %1, off\n\ts_mov_b32 m0, %0" : "=&s"(keep) : "v"(gsrc), "s"(lds_dst) : "memory"); }
__device__ __forceinline__ void glds4(const void* gsrc, unsigned lds_dst) { unsigned keep;
    asm volatile("s_mov_b32 %0, m0\n\ts_mov_b32 m0, %2\n\ts_nop 0\n\tglobal_load_lds_dword %1, off\n\ts_mov_b32 m0, %0" : "=&s"(keep) : "v"(gsrc), "s"(lds_dst) : "memory"); }
__device__ __forceinline__ unsigned lds_addr(const LAS unsigned char* p) { return (unsigned)(size_t)p; }
template <int SW> __device__ __forceinline__ int swz(int R) { return SW == 0 ? (R & 15) : SW == 1 ? (((R & 3) << 1) | (((R >> 3) & 1) << 3)) : ((R & 7) << 1); }
template <int SW> __device__ __forceinline__ void tile_dma(LAS unsigned char* lds, int to, const bf16* src, size_t tok0, int col0, int wave, int lane) {
#pragma unroll
    for (int pi = 0; pi < 2; ++pi) { const int piece = wave + 8 * pi, R = 4 * piece + (lane >> 4); const int gch = (lane & 15) ^ swz<SW>(R);
        glds16(src + (tok0 + R) * 512 + col0 + gch * 8, (unsigned)__builtin_amdgcn_readfirstlane(lds_addr(lds) + to + piece * 1024)); }
}
template <int SW> __device__ __forceinline__ bf16x8 tr_frag(const LAS unsigned char* tile, int r0a, int r0b, int c0, int i16) {
    const int q = i16 >> 2, ch = (c0 >> 3) + ((i16 & 3) >> 1), bo = (i16 & 1) * 8; const int Ra = r0a + q, Rb = r0b + q;
    const s16x4v va = __builtin_amdgcn_ds_read_tr16_b64_v4i16((LAS s16x4v*)(tile + Ra * 256 + ((ch ^ swz<SW>(Ra)) << 4) + bo));
    const s16x4v vb = __builtin_amdgcn_ds_read_tr16_b64_v4i16((LAS s16x4v*)(tile + Rb * 256 + ((ch ^ swz<SW>(Rb)) << 4) + bo));
    return (bf16x8){va[0], va[1], va[2], va[3], vb[0], vb[1], vb[2], vb[3]};
}
__device__ __forceinline__ bf16x8 row_frag(const LAS unsigned char* tile, int R, int ch) { return *(const LAS bf16x8*)(tile + R * 256 + ((ch ^ (R & 15)) << 4)); }

__device__ __forceinline__ void scan_issue(LAS unsigned char* lds, const bf16* KT, const bf16* VH, const float* DEC, int b, int h, int c, int wave, int lane) {
    const int bo = (c % 3) * 32768; const size_t tok = (size_t)b * S + 64 * c;
    tile_dma<1>(lds, bo, KT, tok, h * 128, wave, lane); tile_dma<1>(lds, bo + 16384, VH, tok, h * 128, wave, lane);
    glds4(DEC + ((size_t)(b * 64 + c) * 512 + h * 128 + 16 * wave + (lane & 15)), (unsigned)__builtin_amdgcn_readfirstlane(lds_addr(lds) + 131072 + (c % 3) * 2048 + wave * 256));
}
__device__ __forceinline__ void hgrn_scan(LAS unsigned char* lds, const bf16* KT, const bf16* VH, const float* DEC, bf16* ST, int bh, int wave, int lane) {
    const int b = bh >> 2, h = bh & 3, i16 = lane & 15, g4 = lane >> 4;
    LAS unsigned char* stg = lds + 98304;
    f32x4 acc[8];
#pragma unroll
    for (int vt = 0; vt < 8; ++vt) acc[vt] = (f32x4){0.f, 0.f, 0.f, 0.f};
    scan_issue(lds, KT, VH, DEC, b, h, 0, wave, lane); scan_issue(lds, KT, VH, DEC, b, h, 1, wave, lane);
    for (int c = 0; c < 63; ++c) {
        if (c < 2 || c >= 61) asm volatile("s_waitcnt vmcnt(0) lgkmcnt(0)\n\ts_barrier" ::: "memory");
        else asm volatile("s_waitcnt vmcnt(13) lgkmcnt(0)\n\ts_barrier" ::: "memory");
        if (c + 2 < 63) scan_issue(lds, KT, VH, DEC, b, h, c + 2, wave, lane);
        const LAS unsigned char* Kt = lds + (c % 3) * 32768; const LAS unsigned char* Vt = Kt + 16384;
        const f32x4 dv = *(const LAS f32x4*)(lds + 131072 + (c % 3) * 2048 + wave * 256 + 16 * g4);
#pragma unroll
        for (int ks = 0; ks < 2; ++ks) { const int r0 = 32 * ks + 8 * g4;
            const bf16x8 af = tr_frag<1>(Kt, r0, r0 + 4, 16 * wave, i16);
#pragma unroll
            for (int vt = 0; vt < 8; ++vt) { const bf16x8 bfv = tr_frag<1>(Vt, r0, r0 + 4, 16 * vt, i16);
                acc[vt] = __builtin_amdgcn_mfma_f32_16x16x32_bf16(af, bfv, acc[vt], 0, 0, 0); } }
#pragma unroll
        for (int vt = 0; vt < 8; ++vt) { acc[vt] = acc[vt] * dv;
            u32x2 w; w.x = pk2r(acc[vt][0], acc[vt][1]); w.y = pk2r(acc[vt][2], acc[vt][3]);
            *(LAS u32x2*)(stg + (16 * vt + i16) * 256 + (((4 * wave + g4) ^ (i16 << 1)) << 3)) = w; }
        LBAR();
        { unsigned char* gp = (unsigned char*)(ST + (size_t)(bh * 64 + c) * 16384);
#pragma unroll
          for (int q4 = 0; q4 < 4; ++q4) { const int r = 16 * wave + 4 * q4 + (lane >> 4), ch = lane & 15;
              const v4u x = *(const LAS v4u*)(stg + r * 256 + ((ch ^ (r & 15)) << 4)); *(v4u*)(gp + r * 256 + ch * 16) = x; } }
    }
    asm volatile("s_waitcnt vmcnt(0) lgkmcnt(0)\n\ts_barrier" ::: "memory");
}

__device__ __forceinline__ void hgrn_out_units(LAS unsigned char* lds, const bf16* QT, const bf16* KT, const bf16* VH, const bf16* SG, const bf16* ST, const float* hg_on, bf16* MIXIN, int wave, int lane, int ulo, int uhi) {
    const int i16 = lane & 15, g4 = lane >> 4;
    LAS unsigned char* Pl = lds + 98304; LAS float* ssq = (LAS float*)(lds + 106496);
    bf16x8 san[4];
    { const int bh = ulo >> 6, c = ulo & 63, b = bh >> 2, h = bh & 3; const size_t tok0 = (size_t)b * S + 64 * c;
      tile_dma<0>(lds, 0, QT, tok0, h * 128, wave, lane); tile_dma<0>(lds, 16384, KT, tok0, h * 128, wave, lane); tile_dma<2>(lds, 32768, VH, tok0, h * 128, wave, lane);
      if (c > 0) { const bf16* sp = ST + (((size_t)(bh * 64 + c - 1) * 128 + 16 * wave + i16) * 128 + 8 * g4);
#pragma unroll
          for (int ks = 0; ks < 4; ++ks) san[ks] = *(const bf16x8*)(sp + 32 * ks); }
      else {
#pragma unroll
          for (int ks = 0; ks < 4; ++ks) san[ks] = (bf16x8){0, 0, 0, 0, 0, 0, 0, 0}; } }
    for (int u = ulo; u < uhi; ++u) {
        const int cur = (u - ulo) & 1; const int bh = u >> 6, c = u & 63, b = bh >> 2, h = bh & 3; const size_t tok0 = (size_t)b * S + 64 * c;
        TOPBAR();
        TOUCH(san[0]); TOUCH(san[1]); TOUCH(san[2]); TOUCH(san[3]);
        const bf16x8 sa[4] = {san[0], san[1], san[2], san[3]};
        if (u + 1 < uhi) { const int bh2 = (u + 1) >> 6, c2 = (u + 1) & 63; const size_t t2 = (size_t)(bh2 >> 2) * S + 64 * c2; const int h2 = bh2 & 3, o2 = (cur ^ 1) * 49152;
            tile_dma<0>(lds, o2, QT, t2, h2 * 128, wave, lane); tile_dma<0>(lds, o2 + 16384, KT, t2, h2 * 128, wave, lane); tile_dma<2>(lds, o2 + 32768, VH, t2, h2 * 128, wave, lane);
            if (c2 > 0) { const bf16* sp = ST + (((size_t)(bh2 * 64 + c2 - 1) * 128 + 16 * wave + i16) * 128 + 8 * g4);
#pragma unroll
                for (int ks = 0; ks < 4; ++ks) san[ks] = *(const bf16x8*)(sp + 32 * ks); }
            else {
#pragma unroll
                for (int ks = 0; ks < 4; ++ks) san[ks] = (bf16x8){0, 0, 0, 0, 0, 0, 0, 0}; } }
        const LAS unsigned char* Qt = lds + cur * 49152; const LAS unsigned char* Kt = Qt + 16384; const LAS unsigned char* Vt = Qt + 32768;
#pragma unroll
        for (int q = 0; q < 2; ++q) { const int id = 2 * wave + q, si = id >> 2, ti = id & 3; f32x4 a = {0.f, 0.f, 0.f, 0.f};
            if (si <= ti) {
#pragma unroll
                for (int ks = 0; ks < 4; ++ks) a = __builtin_amdgcn_mfma_f32_16x16x32_bf16(row_frag(Kt, 16 * si + i16, g4 + 4 * ks), row_frag(Qt, 16 * ti + i16, g4 + 4 * ks), a, 0, 0, 0);
                if (si == ti) {
#pragma unroll
                    for (int reg = 0; reg < 4; ++reg) if (4 * g4 + reg > i16) a[reg] = 0.f; } }
            u32x2 w; w.x = pk2r(a[0], a[1]); w.y = pk2r(a[2], a[3]); *(LAS u32x2*)(Pl + id * 512 + lane * 8) = w; }
        LBAR();
        f32x4 o[4];
#pragma unroll
        for (int tt = 0; tt < 4; ++tt) { o[tt] = (f32x4){0.f, 0.f, 0.f, 0.f};
#pragma unroll
            for (int ks = 0; ks < 4; ++ks) o[tt] = __builtin_amdgcn_mfma_f32_16x16x32_bf16(sa[ks], row_frag(Qt, 16 * tt + i16, g4 + 4 * ks), o[tt], 0, 0, 0);
#pragma unroll
            for (int kp = 0; kp < 2; ++kp) { if (2 * kp <= tt) {
                    const u32x2 pa = *(const LAS u32x2*)(Pl + ((2 * kp) * 4 + tt) * 512 + lane * 8), pb = *(const LAS u32x2*)(Pl + ((2 * kp + 1) * 4 + tt) * 512 + lane * 8);
                    const v4u pw = {pa.x, pa.y, pb.x, pb.y};
                    const bf16x8 vf = tr_frag<2>(Vt, 32 * kp + 4 * g4, 32 * kp + 16 + 4 * g4, 16 * wave, i16);
                    o[tt] = __builtin_amdgcn_mfma_f32_16x16x32_bf16(vf, __builtin_bit_cast(bf16x8, pw), o[tt], 0, 0, 0); } } }
#pragma unroll
        for (int tt = 0; tt < 4; ++tt) { float ss = (o[tt][0] * o[tt][0] + o[tt][1] * o[tt][1]) + (o[tt][2] * o[tt][2] + o[tt][3] * o[tt][3]); ss += __shfl_xor(ss, 16); ss += __shfl_xor(ss, 32);
            if (g4 == 0) ssq[wave * 64 + 16 * tt + i16] = ss; }
        LBAR();
        const f32x4 gon = *(const f32x4*)(hg_on + 16 * wave + 4 * g4);
#pragma unroll
        for (int tt = 0; tt < 4; ++tt) { float tot = 0.f;
#pragma unroll
            for (int w8 = 0; w8 < 8; ++w8) tot += ssq[w8 * 64 + 16 * tt + i16];
            const float rstd = rsq(tot * (1.f / 128.f) + EPS);
            const size_t tok = tok0 + 16 * tt + i16; const int col = h * 128 + 16 * wave + 4 * g4;
            const u32x2 sg = *(const u32x2*)(SG + tok * 512 + col);
            u32x2 w; w.x = pk2r(o[tt][0] * rstd * gon[0] * bflo(sg.x), o[tt][1] * rstd * gon[1] * bfhi(sg.x)); w.y = pk2r(o[tt][2] * rstd * gon[2] * bflo(sg.y), o[tt][3] * rstd * gon[3] * bfhi(sg.y));
            *(u32x2*)(MIXIN + tok * D + col) = w; }
    }
    __syncthreads();
}

struct AttU { int b, h, dsh, r, n, br; };
__device__ __forceinline__ AttU att_decode(int g) {
    AttU U; const int bh = g / 96, u = g % 96; U.b = bh >> 3; U.h = bh & 7;
    if (u < 32) { U.dsh = 0; U.r = 0; U.n = u; U.br = 0; }
    else if (u < 64) { U.dsh = 2; U.r = (u - 32) >> 3; U.n = (u - 32) & 7; U.br = 1; }
    else { U.dsh = 4; U.r = (u - 64) >> 1; U.n = (u - 64) & 1; U.br = 2; }
    return U;
}
__device__ __forceinline__ void att_dma(LAS unsigned char* lds, int bufo, const bf16* AK, const bf16* AV, const AttU& U, int wave, int lane) {
    const int gch = (lane & 7) ^ (lane >> 3);
#pragma unroll
    for (int pi = 0; pi < 4; ++pi) { const int piece = wave + 8 * pi, row = piece * 8 + (lane >> 3); int m = 128 * (U.n - 1) + row; if (m < 0) m += 128;
        const size_t eoff = ((size_t)U.b * S + (size_t)((m << U.dsh) + U.r)) * 512 + U.h * 64 + gch * 8;
        glds16(AK + eoff, (unsigned)__builtin_amdgcn_readfirstlane(lds_addr(lds) + bufo + piece * 1024));
        glds16(AV + eoff, (unsigned)__builtin_amdgcn_readfirstlane(lds_addr(lds) + bufo + 32768 + piece * 1024)); }
}
__device__ __forceinline__ void attn_units(LAS unsigned char* lds, const bf16* AQ, const bf16* AK, const bf16* AV, unsigned char* ws, float* LSE, int wave, int lane, int glo, int ghi) {
    const int i16 = lane & 15, g4 = lane >> 4;
    AttU U = att_decode(glo);
    att_dma(lds, 0, AK, AV, U, wave, lane);
    bf16x8 qn0, qn1;
    { const bf16* qp = AQ + (((size_t)U.b * S + (size_t)(((128 * U.n + 16 * wave + i16) << U.dsh) + U.r)) * 512 + U.h * 64 + 8 * g4); qn0 = *(const bf16x8*)qp; qn1 = *(const bf16x8*)(qp + 32); }
    for (int gu = glo; gu < ghi; ++gu) {
        const int cur = (gu - glo) & 1; const AttU C = U;
        TOPBAR();
        TOUCH(qn0); TOUCH(qn1); const bf16x8 qf0 = qn0, qf1 = qn1;
        if (gu + 1 < ghi) { U = att_decode(gu + 1); att_dma(lds, (cur ^ 1) * 65536, AK, AV, U, wave, lane);
            const bf16* qp = AQ + (((size_t)U.b * S + (size_t)(((128 * U.n + 16 * wave + i16) << U.dsh) + U.r)) * 512 + U.h * 64 + 8 * g4); qn0 = *(const bf16x8*)qp; qn1 = *(const bf16x8*)(qp + 32); }
        const LAS unsigned char* Kb = lds + cur * 65536; const LAS unsigned char* Vb = Kb + 32768;
        f32x4 st[9];
#pragma unroll
        for (int t = 0; t < 9; ++t) { const int R = 16 * (wave + t) + i16; const LAS unsigned char* kp = Kb + R * 128;
            const bf16x8 a0 = *(const LAS bf16x8*)(kp + ((g4 ^ (R & 7)) << 4)), a1 = *(const LAS bf16x8*)(kp + (((g4 + 4) ^ (R & 7)) << 4));
            f32x4 z = {0.f, 0.f, 0.f, 0.f};
            z = __builtin_amdgcn_mfma_f32_16x16x32_bf16(a0, qf0, z, 0, 0, 0); st[t] = __builtin_amdgcn_mfma_f32_16x16x32_bf16(a1, qf1, z, 0, 0, 0); }
        const int qi = 16 * wave + i16; const float NEG = -INFINITY;
#pragma unroll
        for (int reg = 0; reg < 4; ++reg) { const int kj0 = 16 * wave + 4 * g4 + reg; if (kj0 < qi) st[0][reg] = NEG; if (kj0 + 128 > qi + 128) st[8][reg] = NEG; }
        if (C.n == 0) {
#pragma unroll
            for (int t = 0; t < 8; ++t)
#pragma unroll
                for (int reg = 0; reg < 4; ++reg) { if (16 * (wave + t) + 4 * g4 + reg < 128) st[t][reg] = NEG; } }
        float mx = st[0][0];
#pragma unroll
        for (int t = 0; t < 9; ++t)
#pragma unroll
            for (int reg = 0; reg < 4; ++reg) mx = fmaxf(mx, st[t][reg]);
        mx = fmaxf(mx, __shfl_xor(mx, 16)); mx = fmaxf(mx, __shfl_xor(mx, 32));
        float l = 0.f;
#pragma unroll
        for (int t = 0; t < 9; ++t)
#pragma unroll
            for (int reg = 0; reg < 4; ++reg) { const float pv = ex2(st[t][reg] - mx); st[t][reg] = pv; l += pv; }
        l += __shfl_xor(l, 16); l += __shfl_xor(l, 32);
        f32x4 o[4];
#pragma unroll
        for (int et = 0; et < 4; ++et) o[et] = (f32x4){0.f, 0.f, 0.f, 0.f};
#pragma unroll
        for (int ks = 0; ks < 5; ++ks) {
            const int ta = 2 * ks, tb = (ks < 4) ? 2 * ks + 1 : 2 * ks;
            v4u pw; pw.x = pk2r(st[ta][0], st[ta][1]); pw.y = pk2r(st[ta][2], st[ta][3]);
            if (ks < 4) { pw.z = pk2r(st[tb][0], st[tb][1]); pw.w = pk2r(st[tb][2], st[tb][3]); } else { pw.z = 0u; pw.w = 0u; }
            const bf16x8 pf = __builtin_bit_cast(bf16x8, pw);
            const int Ra = 16 * (wave + ta) + 4 * g4 + (i16 >> 2), Rb = 16 * (wave + tb) + 4 * g4 + (i16 >> 2);
#pragma unroll
            for (int et = 0; et < 4; ++et) { const int ch = 2 * et + ((i16 & 3) >> 1), bo = (i16 & 1) * 8;
                const s16x4v va = __builtin_amdgcn_ds_read_tr16_b64_v4i16((LAS s16x4v*)(Vb + Ra * 128 + ((ch ^ (Ra & 7)) << 4) + bo));
                const s16x4v vb = __builtin_amdgcn_ds_read_tr16_b64_v4i16((LAS s16x4v*)(Vb + Rb * 128 + ((ch ^ (Rb & 7)) << 4) + bo));
                const bf16x8 vf = {va[0], va[1], va[2], va[3], vb[0], vb[1], vb[2], vb[3]};
                o[et] = __builtin_amdgcn_mfma_f32_16x16x32_bf16(vf, pf, o[et], 0, 0, 0); }
        }
        const float il = rcp(l);
        const size_t orow = (size_t)C.b * S + (size_t)(((128 * C.n + qi) << C.dsh) + C.r);
        bf16* AO = (bf16*)(ws + (C.br == 0 ? WS_ATT0 : C.br == 1 ? WS_ATT1 : WS_ATT2)) + orow * 512 + C.h * 64 + 4 * g4;
#pragma unroll
        for (int et = 0; et < 4; ++et) { u32x2 w; w.x = pk2r(o[et][0] * il, o[et][1] * il); w.y = pk2r(o[et][2] * il, o[et][3] * il); *(u32x2*)(AO + 16 * et) = w; }
        if (g4 == 0) LSE[(size_t)C.br * T * 8 + orow * 8 + C.h] = mx + lg2(l);
    }
    __syncthreads();
}

struct Args { const float* in[14]; float* out; unsigned char* ws; };
__global__ void __launch_bounds__(NWAVES * 64, 2) mk_fwd(Args args) {
    extern __shared__ __attribute__((aligned(16))) unsigned char lds_raw[];
    LAS unsigned char* lds = (LAS unsigned char*)lds_raw;
    volatile LAS unsigned* MISC = (volatile LAS unsigned*)(lds + MISC_OFF);
    const int wave = __builtin_amdgcn_readfirstlane(threadIdx.x >> 6);
    const int G = gridDim.x, bx = blockIdx.x; const int vcu = (G % 8 == 0) ? (bx % 8) * (G / 8) + bx / 8 : bx;
    const int gw = vcu * NWAVES + wave, NGW = G * NWAVES;
    (void)args;
#define INP(i) karg_ptr(i)
#define P_x INP(0)
#define P_c INP(1)
#define P_w_ada INP(2)
#define P_b_ada INP(3)
#define P_g1 INP(4)
#define P_w_in INP(5)
#define P_lbl INP(6)
#define P_hg_on INP(7)
#define P_att_on INP(8)
#define P_w_out INP(9)
#define P_g2 INP(10)
#define P_w_gu INP(11)
#define P_w_down INP(12)
#define P_gf INP(13)
#define P_out ((float*)INP(14))
    unsigned char* const ws = (unsigned char*)INP(15);
    gu32* ctl = (gu32*)(ws + WS_CTL);
#define MODP ((float*)(ws + WS_MODP))
#define MOD ((float*)(ws + WS_MOD))
#define LB ((float*)(ws + WS_LB))
#define BIAS2 ((float*)(ws + WS_BIAS2))
#define WIN_T ((bf16*)(ws + WS_WIN))
#define WOUT_T ((bf16*)(ws + WS_WOUT))
#define WGU_T ((bf16*)(ws + WS_WGU))
#define WD_T ((bf16*)(ws + WS_WD))
#define DEC ((float*)(ws + WS_DEC))
#define LSE ((float*)(ws + WS_LSE))
#define SSQ1 ((float*)(ws + WS_SSQ1))
#define XN ((bf16*)(ws + WS_BUFA))
#define A2 ((bf16*)(ws + WS_BUFA))
#define MIXIN ((bf16*)(ws + WS_BUFB))
#define QT ((bf16*)(ws + WS_QT))
#define KT ((bf16*)(ws + WS_KT))
#define VH ((bf16*)(ws + WS_VH))
#define SG ((bf16*)(ws + WS_SG))
#define AQ ((bf16*)(ws + WS_AQ))
#define AK ((bf16*)(ws + WS_AK))
#define AV ((bf16*)(ws + WS_AV))
#define STB ((bf16*)(ws + WS_ST))
#define HID ((bf16*)(ws + WS_HID))
#define PHASE_TID() int lane; asm volatile("v_mbcnt_lo_u32_b32 %0, -1, 0\n\tv_mbcnt_hi_u32_b32 %0, -1, %0" : "=&v"(lane)); const int tid = wave * 64 + lane; (void)tid;

    for (int u = threadIdx.x; u < (LDS_BYTES - LDSCTL_OFF) / 4; u += NWAVES * 64) ((LAS unsigned*)(lds + LDSCTL_OFF))[u] = 0u;
    __syncthreads();
    XcdBarrier bar = xcd_barrier_post((unsigned*)(ctl + CW_BAR), MISC + 8);

    {   PHASE_TID();
        LAS float* scr = (LAS float*)(lds + wave * 16384);
        constexpr int I_MOD = 768, I_IN = 16 * (INW / 32), I_OUT = 16 * (D / 32), I_GU = 16 * (NGU / 32), I_DN = (DFF / 64) * (D / 32);
        constexpr int NTASK = I_MOD + I_IN + I_OUT + I_GU + I_DN + 1;
        for (int it = gw; it < NTASK; it += NGW) {
            int r = it;
            if (r < I_MOD) { mod_partial(P_c, P_w_ada, MODP, scr, r, lane); continue; } r -= I_MOD;
            if (r < I_IN) { transpose_item(P_w_in, D, INW, WIN_T, 1, scr, r, lane); continue; } r -= I_IN;
            if (r < I_OUT) { transpose_item(P_w_out, D, D, WOUT_T, 0, scr, r, lane); continue; } r -= I_OUT;
            if (r < I_GU) { transpose_item(P_w_gu, D, NGU, WGU_T, 2, scr, r, lane); continue; } r -= I_GU;
            if (r < I_DN) { transpose_item(P_w_down, DFF, D, WD_T, 0, scr, r, lane); continue; }
#pragma unroll
            for (int i = 0; i < 8; ++i) { const int j = lane + 64 * i; LB[j] = rcp(1.f + ex2((P_lbl[512 + j] - P_lbl[j]) * LOG2E)); }
        }
    }
    xcd_barrier(bar);

    {   PHASE_TID();
        LAS float* ms = (LAS float*)lds; LAS float* sh = ms + D;
        if (tid < 192) { const int idx = bx * 192 + tid; const int b = idx / NMOD, n = idx % NMOD; float v = P_b_ada[n];
#pragma unroll
            for (int ks = 0; ks < 8; ++ks) v += MODP[(size_t)(ks * 8 + b) * NMOD + n];
            MOD[idx] = v; }
        const int rows_per = T / G, row0 = bx * rows_per, b = row0 / S;
#pragma unroll
        for (int i = 0; i < 2; ++i) { const int k = tid + 512 * i; float s1 = P_b_ada[k], c1 = P_b_ada[1024 + k];
#pragma unroll
            for (int ks = 0; ks < 8; ++ks) { s1 += MODP[(size_t)(ks * 8 + b) * NMOD + k]; c1 += MODP[(size_t)(ks * 8 + b) * NMOD + 1024 + k]; }
            ms[k] = P_g1[k] * (1.f + c1); sh[k] = s1; }
        __syncthreads();
        for (int r = wave; r < rows_per; r += NWAVES) {
            const int row = row0 + r; const GAS f32x4* xr = (const GAS f32x4*)(P_x + (size_t)row * D) + lane;
            f32x4 v[4]; float s = 0.f;
#pragma unroll
            for (int j = 0; j < 4; ++j) { v[j] = xr[64 * j]; s += (v[j].x * v[j].x + v[j].y * v[j].y) + (v[j].z * v[j].z + v[j].w * v[j].w); }
            const float rstd = rsq(wsum64(s) * (1.f / D) + EPS);
            GAS unsigned long long* o8 = (GAS unsigned long long*)(XN + (size_t)row * D) + lane;
#pragma unroll
            for (int j = 0; j < 4; ++j) { const f32x4 m4 = *(const LAS f32x4*)(ms + 256 * j + 4 * lane), s4 = *(const LAS f32x4*)(sh + 256 * j + 4 * lane); const f32x4 o = v[j] * rstd * m4 + s4;
                o8[64 * j] = (unsigned long long)pk2(o.x, o.y) | ((unsigned long long)pk2(o.z, o.w) << 32); }
        }
    }
    xcd_barrier(bar);

    {
        pg8::Gemm g{XN, WIN_T, T, INW, D}; pg8::StaticOrder So; So.init(T, INW, G, bx);
        EpiIn E{QT, KT, VH, SG, AQ, AK, AV, DEC, LB};
        pg8::gemm_phase<EpiIn, pg8::StaticOrder, true, true>(lds, g, So, E, wave);
    }
    xcd_barrier(bar);

    if (vcu < 32) {   PHASE_TID();
        hgrn_scan(lds, KT, VH, DEC, STB, vcu, wave, lane);
    }
    {   PHASE_TID();
        attn_units(lds, AQ, AK, AV, ws, LSE, wave, lane, vcu * 24, vcu * 24 + 24);
    }
    xcd_barrier(bar);

    {   PHASE_TID();
        hgrn_out_units(lds, QT, KT, VH, SG, STB, P_hg_on, MIXIN, wave, lane, vcu * 8, vcu * 8 + 8);
        for (int t = gw; t < T; t += NGW) {
            const int c8 = lane * 8;
            {   const int h = lane >> 3;
                const float l0 = LSE[(size_t)t * 8 + h], l1 = LSE[(size_t)T * 8 + (size_t)t * 8 + h], l2 = LSE[(size_t)2 * T * 8 + (size_t)t * 8 + h];
                const float mx = fmaxf(l0, fmaxf(l1, l2)); float w0 = ex2(l0 - mx), w1 = ex2(l1 - mx), w2 = ex2(l2 - mx); const float inv = rcp(w0 + w1 + w2); w0 *= inv; w1 *= inv; w2 *= inv;
                const v4u a0 = *(const v4u*)((const bf16*)(ws + WS_ATT0) + (size_t)t * 512 + c8), a1 = *(const v4u*)((const bf16*)(ws + WS_ATT1) + (size_t)t * 512 + c8), a2 = *(const v4u*)((const bf16*)(ws + WS_ATT2) + (size_t)t * 512 + c8);
                float a[8];
                a[0] = w0 * bflo(a0.x) + w1 * bflo(a1.x) + w2 * bflo(a2.x); a[1] = w0 * bfhi(a0.x) + w1 * bfhi(a1.x) + w2 * bfhi(a2.x);
                a[2] = w0 * bflo(a0.y) + w1 * bflo(a1.y) + w2 * bflo(a2.y); a[3] = w0 * bfhi(a0.y) + w1 * bfhi(a1.y) + w2 * bfhi(a2.y);
                a[4] = w0 * bflo(a0.z) + w1 * bflo(a1.z) + w2 * bflo(a2.z); a[5] = w0 * bfhi(a0.z) + w1 * bfhi(a1.z) + w2 * bfhi(a2.z);
                a[6] = w0 * bflo(a0.w) + w1 * bflo(a1.w) + w2 * bflo(a2.w); a[7] = w0 * bfhi(a0.w) + w1 * bfhi(a1.w) + w2 * bfhi(a2.w);
                float ss = 0.f;
#pragma unroll
                for (int i = 0; i < 8; ++i) ss += a[i] * a[i];
                const float rstd = rsq(wsum64(ss) * (1.f / 512.f) + EPS);
                const f32x4 n0 = *(const f32x4*)(P_att_on + c8), n1 = *(const f32x4*)(P_att_on + c8 + 4);
#pragma unroll
                for (int i = 0; i < 4; ++i) { a[i] = a[i] * rstd * n0[i]; a[4 + i] = a[4 + i] * rstd * n1[i]; }
                v4u w; w.x = pk2(a[0], a[1]); w.y = pk2(a[2], a[3]); w.z = pk2(a[4], a[5]); w.w = pk2(a[6], a[7]);
                *(v4u*)(MIXIN + (size_t)t * D + 512 + c8) = w; }
        }
        __syncthreads();
        LAS float* sh2 = (LAS float*)lds;
        for (int i = tid; i < 8 * D; i += NWAVES * 64) sh2[i] = MOD[(i >> 10) * NMOD + 3072 + (i & 1023)];
        __syncthreads();
        const int ncol = NGU / G;
        for (int j = wave; j < ncol; j += NWAVES) { const int n = bx * ncol + j;
            const v4u w0 = *(const v4u*)(WGU_T + (size_t)n * D + lane * 16), w1 = *(const v4u*)(WGU_T + (size_t)n * D + lane * 16 + 8);
            const float wv[16] = {bflo(w0.x), bfhi(w0.x), bflo(w0.y), bfhi(w0.y), bflo(w0.z), bfhi(w0.z), bflo(w0.w), bfhi(w0.w), bflo(w1.x), bfhi(w1.x), bflo(w1.y), bfhi(w1.y), bflo(w1.z), bfhi(w1.z), bflo(w1.w), bfhi(w1.w)};
#pragma unroll
            for (int b = 0; b < 8; ++b) { float s = 0.f;
#pragma unroll
                for (int q4 = 0; q4 < 4; ++q4) { const f32x4 sv = *(const LAS f32x4*)(sh2 + b * D + lane * 16 + q4 * 4); s += wv[q4 * 4] * sv[0] + wv[q4 * 4 + 1] * sv[1] + wv[q4 * 4 + 2] * sv[2] + wv[q4 * 4 + 3] * sv[3]; }
                s = wsum64(s); if (lane == 0) BIAS2[b * NGU + n] = s; }
        }
        __syncthreads();
    }
    xcd_barrier(bar);

    {
        pg8::Gemm g{MIXIN, WOUT_T, T, D, D}; pg8::StaticOrder So; So.init(T, D, G, bx);
        EpiOut E{P_x, P_out, A2, SSQ1, MOD, P_g2};
        pg8::gemm_phase<EpiOut, pg8::StaticOrder, true, true>(lds, g, So, E, wave);
    }
    xcd_barrier(bar);

    {
        pg8::Gemm g{A2, WGU_T, T, NGU, D}; pg8::StaticOrder So; So.init(T, NGU, G, bx);
        EpiGU E{HID, SSQ1, BIAS2};
        pg8::gemm_phase<EpiGU, pg8::StaticOrder, true, true>(lds, g, So, E, wave);
    }
    xcd_barrier(bar);

    {
        pg8::Gemm g{HID, WD_T, T, D, DFF}; pg8::StaticOrder So; So.init(T, D, G, bx);
        EpiDown E{P_out, MOD};
        pg8::gemm_phase<EpiDown, pg8::StaticOrder, true, true>(lds, g, So, E, wave);
    }
    xcd_barrier(bar);

    PHASE_TID();
    for (int row = gw; row < T; row += NGW) {
        GAS f32x4* xr = (GAS f32x4*)(P_out + (size_t)row * D) + lane;
        f32x4 v[4]; float s = 0.f;
#pragma unroll
        for (int j = 0; j < 4; ++j) { v[j] = xr[64 * j]; s += (v[j].x * v[j].x + v[j].y * v[j].y) + (v[j].z * v[j].z + v[j].w * v[j].w); }
        const float rstd = rsq(wsum64(s) * (1.f / D) + EPS);
#pragma unroll
        for (int j = 0; j < 4; ++j) { const f32x4 g4 = *(const f32x4*)(P_gf + 256 * j + 4 * lane); xr[64 * j] = v[j] * rstd * g4; }
    }
}
}

extern "C" void kernel_launch(void* const* d_in, const int* in_sizes, int n_in, void* d_out, int out_size, void* d_ws, size_t ws_size, hipStream_t stream) {
    using namespace mk;
    static int grid = 0;
    if (grid == 0) {
        if (n_in != 14 || in_sizes[0] != T * D || out_size != T * D || ws_size < WS_END) { fprintf(stderr, "kernel_launch: unexpected shapes (n_in %d, in0 %d, out %d, ws %zu); nothing launched\n", n_in, n_in > 0 ? in_sizes[0] : -1, out_size, ws_size); grid = -1; return; }
        int dev = 0, cus = 0, per_cu = 0;
        if (hipGetDevice(&dev) != hipSuccess || hipDeviceGetAttribute(&cus, hipDeviceAttributeMultiprocessorCount, dev) != hipSuccess) { grid = -1; return; }
        if (hipFuncSetAttribute((const void*)mk_fwd, hipFuncAttributeMaxDynamicSharedMemorySize, LDS_BYTES) != hipSuccess) { fprintf(stderr, "kernel_launch: hipFuncSetAttribute failed\n"); grid = -1; return; }
        if (hipOccupancyMaxActiveBlocksPerMultiprocessor(&per_cu, (const void*)mk_fwd, NWAVES * 64, LDS_BYTES) != hipSuccess || per_cu < 1) { fprintf(stderr, "kernel_launch: occupancy query says %d blocks per CU\n", per_cu); per_cu = 1; }
        (void)hipGetLastError();
        grid = cus;
        if (grid != 256) { fprintf(stderr, "kernel_launch: this kernel is laid out for a 256-CU device, found %d CUs; nothing launched\n", grid); grid = -1; return; }
    }
    if (grid < 0) return;
    if (hipMemsetAsync((char*)d_ws + WS_CTL, 0, CTL_ZERO_BYTES, stream) != hipSuccess) { fprintf(stderr, "kernel_launch: hipMemsetAsync failed\n"); return; }
    Args a{};
    for (int i = 0; i < 14; ++i) a.in[i] = (const float*)d_in[i];
    a.out = (float*)d_out; a.ws = (unsigned char*)d_ws;
    hipLaunchKernelGGL(mk_fwd, dim3(grid), dim3(NWAVES * 64), LDS_BYTES, stream, a);
    const hipError_t le = hipPeekAtLastError();
    if (le != hipSuccess) fprintf(stderr, "kernel_launch: launch failed: %s\n", hipGetErrorName(le));
}
```

```cpp
#include <hip/hip_runtime.h>
#include <cstdio>
#include <cstdint>
namespace pg8 {
#define PG8_LAS __attribute__((address_space(3)))
typedef unsigned short bf16_t;
typedef short bf16x8 __attribute__((ext_vector_type(8)));
typedef float f32x4 __attribute__((ext_vector_type(4)));
typedef unsigned u32x4 __attribute__((ext_vector_type(4)));
constexpr int BM = 256, BK = 64, HALF = 128, HTB = HALF * BK * 2  , STAGE_BYTES = 8 * HTB, NXCD = 8, WGM = 8;

__host__ __device__ __forceinline__ int lds_byte(int r, int c) { const int st = (r >> 4) * 2 + (c >> 5), rr = r & 15, cc = c & 31, ob = rr * 64 + cc * 2; return st * 1024 + (ob ^ (((ob >> 9) & 1) << 5)); }
__host__ __device__ __forceinline__ void stage_rc(int b, int& R, int& C) { const int st = b / 1024, sb = b % 1024, swz = sb ^ (((sb >> 9) & 1) << 5); R = (st >> 1) * 16 + swz / 64; C = (st & 1) * 32 + (swz % 64) / 2; }
__host__ __device__ __forceinline__ int perm32(int rho) { const int n = rho >> 4, i = rho & 15; return 8 * (i >> 2) + 4 * n + (i & 3); }

struct Unit { int pm, pn; };
struct Gemm { const bf16_t* A; const bf16_t* Bt; int M, N, K; };

struct StaticOrder {
    int nM, nN, nwg, G, c;
    __host__ __device__ void init(int M, int N, int G_, int c_) { nM = M / BM; nN = N / BM; nwg = nM * nN; G = G_; c = c_; }
    __host__ __device__ bool next(int i, Unit& u) const {
        const long L = (long)i * G + c; if (L >= nwg) return false;
        int wgid = (int)L; { const int q = nwg / NXCD, r = nwg % NXCD, xcd = wgid % NXCD, off = wgid / NXCD; wgid = (xcd < r ? xcd * (q + 1) : r * (q + 1) + (xcd - r) * q) + off; }
        const int nig = WGM * nN, gid = wgid / nig, fm = gid * WGM, gsz = (nM - fm) < WGM ? (nM - fm) : WGM;
        u.pm = fm + ((wgid % nig) % gsz); u.pn = (wgid % nig) / gsz; return true;
    }
    __device__ __forceinline__ void a_ready(const Unit&) const {}
    __device__ __forceinline__ void done(const Unit&) const {}
};

__device__ __forceinline__ unsigned cvt_pk_bf16(float lo, float hi) { unsigned r; asm volatile("v_cvt_pk_bf16_f32 %0, %1, %2" : "=v"(r) : "v"(lo), "v"(hi)); return r; }
typedef float f32x2 __attribute__((ext_vector_type(2)));
template <class Epi, class Sched, bool ALIGN_EPI = false, bool SP2 = false>
__device__ __forceinline__ void gemm_phase(PG8_LAS unsigned char* lds, const Gemm g, const Sched& S, const Epi& E, const int wid_in  ) {
    int lane_o; asm volatile("v_mbcnt_lo_u32_b32 %0, -1, 0\n\tv_mbcnt_hi_u32_b32 %0, -1, %0" : "=&v"(lane_o));
    const int wid = wid_in, lane = lane_o, tid = wid * 64 + lane, wr = wid >> 2, wc = wid & 3, fr = lane & 15, fq = lane >> 4;
    const int K = g.K, nt = K / BK;
    unsigned voffA[2], voffB[2];
#pragma unroll
    for (int i = 0; i < 2; ++i) { int R, C; stage_rc(tid * 16 + i * 8192, R, C); const int Rb = Epi::PERM ? ((R & ~31) + perm32(R & 31)) : R;
        voffA[i] = (unsigned)(R * K + C) * 2u; voffB[i] = (unsigned)(Rb * K + C) * 2u; }
    const size_t kstep = (size_t)(BK * 2);
    const size_t hstep = (size_t)HALF * K * 2;
    const size_t tstep = 2 * hstep;
    const unsigned ldsw = (unsigned)wid * 1024u;
    const int aoff = lds_byte(wr * 64 + fr, fq * 8), boff = lds_byte(wc * 32 + fr, fq * 8);
#define PG8_SA(b, h) (((b) * 2 + (h)) * HTB)
#define PG8_SB(b, h) ((4 + (b) * 2 + (h)) * HTB)
#define PG8_STAGE(bufoff, gbase, voff) do { _Pragma("unroll") for (int _i = 0; _i < 2; ++_i) \
        __builtin_amdgcn_global_load_lds((const unsigned*)((const char*)(gbase) + (voff)[_i]), (PG8_LAS unsigned*)(lds + (bufoff) + ldsw + _i * 8192), 16, 0, 0); } while (0)
#define PG8_LDA(dst, b, h) do { _Pragma("unroll") for (int m = 0; m < 4; ++m) _Pragma("unroll") for (int k = 0; k < 2; ++k) dst[m][k] = *(const PG8_LAS bf16x8*)(lds + PG8_SA(b, h) + aoff + m * 2048 + k * 1024); } while (0)
#define PG8_LDB(dst, b, h) do { _Pragma("unroll") for (int n = 0; n < 2; ++n) _Pragma("unroll") for (int k = 0; k < 2; ++k) dst[n][k] = *(const PG8_LAS bf16x8*)(lds + PG8_SB(b, h) + boff + n * 2048 + k * 1024); } while (0)
#define PG8_MMA(ai, bj, At, Bt) do { __builtin_amdgcn_s_setprio(1); _Pragma("unroll") for (int m = 0; m < 4; ++m) _Pragma("unroll") for (int n = 0; n < 2; ++n) _Pragma("unroll") for (int k = 0; k < 2; ++k) \
        acc[ai][bj][m][n] = __builtin_amdgcn_mfma_f32_16x16x32_bf16(Bt[n][k], At[m][k], acc[ai][bj][m][n], 0, 0, 0); __builtin_amdgcn_s_setprio(0); } while (0)
#define PG8_WAIT_V(n) asm volatile("s_waitcnt vmcnt(" #n ")" ::: "memory")
#define PG8_WAIT_L(n) asm volatile("s_waitcnt lgkmcnt(" #n ")" ::: "memory")
#define PG8_BAR __builtin_amdgcn_s_barrier()
#define PG8_SCHED __builtin_amdgcn_sched_barrier(0)
    Unit cur, nxt; int ui = 0;
    if (!S.next(0, cur)) return;
    f32x4 acc[2][2][4][2];
#pragma unroll
    for (int a = 0; a < 2; ++a)
#pragma unroll
        for (int b = 0; b < 2; ++b)
#pragma unroll
            for (int m = 0; m < 4; ++m)
#pragma unroll
                for (int n = 0; n < 2; ++n) acc[a][b][m][n] = (f32x4){0.f, 0.f, 0.f, 0.f};
    bf16x8 At[4][2], B0[2][2], B1[2][2];
    const char* cA = (const char*)g.A + (size_t)cur.pm * tstep; const char* cB = (const char*)g.Bt + (size_t)cur.pn * tstep;
    S.a_ready(cur);
    if constexpr (SP2) {
        PG8_STAGE(PG8_SB(0, 0), cB, voffB); PG8_STAGE(PG8_SB(0, 1), cB + hstep, voffB); PG8_STAGE(PG8_SA(0, 0), cA, voffA); PG8_STAGE(PG8_SA(0, 1), cA + hstep, voffA);
        if (wr == 1) PG8_BAR;
        PG8_WAIT_V(2); PG8_BAR;
        PG8_STAGE(PG8_SB(1, 0), cB + kstep, voffB); PG8_STAGE(PG8_SA(1, 0), cA + kstep, voffA); PG8_STAGE(PG8_SB(1, 1), cB + hstep + kstep, voffB);
        PG8_WAIT_V(6); PG8_BAR;
    } else {
        PG8_STAGE(PG8_SB(0, 0), cB, voffB); PG8_STAGE(PG8_SA(0, 0), cA, voffA); PG8_STAGE(PG8_SB(0, 1), cB + hstep, voffB); PG8_STAGE(PG8_SA(0, 1), cA + hstep, voffA);
        if (wr == 1) PG8_BAR;
        PG8_WAIT_V(4); PG8_BAR;
        PG8_STAGE(PG8_SB(1, 0), cB + kstep, voffB); PG8_STAGE(PG8_SA(1, 0), cA + kstep, voffA); PG8_STAGE(PG8_SB(1, 1), cB + hstep + kstep, voffB);
        PG8_WAIT_V(6); PG8_BAR;
    }
    for (;;) {
        const bool has_next = S.next(ui + 1, nxt);
        const char* nA = has_next ? (const char*)g.A + (size_t)nxt.pm * tstep : cA; const char* nB = has_next ? (const char*)g.Bt + (size_t)nxt.pn * tstep : cB;
        for (int t = 0; t < nt; t += 2) {
            const bool last = (t == nt - 2);
            const char* a1 = cA + (size_t)(t + 1) * kstep;
            const char* a2 = last ? nA : cA + (size_t)(t + 2) * kstep; const char* b2 = last ? nB : cB + (size_t)(t + 2) * kstep;
            const char* a3 = a2 + kstep; const char* b3 = b2 + kstep;
            if (last && has_next) S.a_ready(nxt);
            if constexpr (SP2) {
            PG8_LDB(B0, 0, 0); PG8_LDB(B1, 0, 1); PG8_SCHED; PG8_LDA(At, 0, 0); PG8_STAGE(PG8_SA(1, 1), a1 + hstep, voffA);
            PG8_WAIT_V(8); PG8_WAIT_L(0); PG8_BAR; PG8_MMA(0, 0, At, B0); PG8_MMA(0, 1, At, B1); PG8_BAR; PG8_SCHED;
            PG8_LDA(At, 0, 1); PG8_STAGE(PG8_SB(0, 0), b2, voffB); PG8_STAGE(PG8_SB(0, 1), b2 + hstep, voffB); PG8_STAGE(PG8_SA(0, 0), a2, voffA);
            PG8_WAIT_V(8); PG8_WAIT_L(0); PG8_BAR; PG8_MMA(1, 0, At, B0); PG8_MMA(1, 1, At, B1); PG8_BAR; PG8_SCHED;
            PG8_LDB(B0, 1, 0); PG8_LDB(B1, 1, 1); PG8_SCHED; PG8_LDA(At, 1, 0); PG8_STAGE(PG8_SA(0, 1), a2 + hstep, voffA);
            PG8_WAIT_V(8); PG8_WAIT_L(0); PG8_BAR; PG8_MMA(0, 0, At, B0); PG8_MMA(0, 1, At, B1); PG8_BAR; PG8_SCHED;
            PG8_LDA(At, 1, 1); PG8_STAGE(PG8_SB(1, 0), b3, voffB); PG8_STAGE(PG8_SB(1, 1), b3 + hstep, voffB); PG8_STAGE(PG8_SA(1, 0), a3, voffA);
            PG8_WAIT_V(8); PG8_WAIT_L(0); PG8_BAR; PG8_MMA(1, 0, At, B0); PG8_MMA(1, 1, At, B1); PG8_BAR; PG8_SCHED;
            } else {
            PG8_LDB(B0, 0, 0); PG8_SCHED; PG8_LDA(At, 0, 0); PG8_STAGE(PG8_SA(1, 1), a1 + hstep, voffA);
            PG8_WAIT_L(8); PG8_BAR; PG8_WAIT_L(0); PG8_MMA(0, 0, At, B0); PG8_BAR; PG8_SCHED;
            PG8_LDB(B1, 0, 1); PG8_STAGE(PG8_SB(0, 0), b2, voffB);
            PG8_BAR; PG8_WAIT_L(0); PG8_MMA(0, 1, At, B1); PG8_BAR;
            PG8_LDA(At, 0, 1); PG8_STAGE(PG8_SA(0, 0), a2, voffA);
            PG8_BAR; PG8_WAIT_L(0); PG8_MMA(1, 0, At, B0); PG8_BAR; PG8_SCHED;
            PG8_STAGE(PG8_SB(0, 1), b2 + hstep, voffB);
            PG8_WAIT_V(6); PG8_BAR; PG8_MMA(1, 1, At, B1); PG8_BAR;
            PG8_LDB(B0, 1, 0); PG8_SCHED; PG8_LDA(At, 1, 0); PG8_STAGE(PG8_SA(0, 1), a2 + hstep, voffA);
            PG8_WAIT_L(8); PG8_BAR; PG8_WAIT_L(0); PG8_MMA(0, 0, At, B0); PG8_BAR; PG8_SCHED;
            PG8_LDB(B1, 1, 1); PG8_STAGE(PG8_SB(1, 0), b3, voffB);
            PG8_BAR; PG8_WAIT_L(0); PG8_MMA(0, 1, At, B1); PG8_BAR;
            PG8_LDA(At, 1, 1); PG8_STAGE(PG8_SA(1, 0), a3, voffA);
            PG8_BAR; PG8_WAIT_L(0); PG8_MMA(1, 0, At, B0); PG8_BAR; PG8_SCHED;
            PG8_STAGE(PG8_SB(1, 1), b3 + hstep, voffB);
            PG8_WAIT_V(6); PG8_BAR; PG8_MMA(1, 1, At, B1); PG8_BAR;
            }
        }
        if constexpr (ALIGN_EPI) { if (wr == 0) PG8_BAR; }
        if constexpr (!Epi::AFTER_DRAIN) { E(acc, cur, wr, wc, fr, fq); S.done(cur); }
        if (!has_next) break;
#pragma unroll
        for (int a = 0; a < 2; ++a)
#pragma unroll
            for (int b = 0; b < 2; ++b)
#pragma unroll
                for (int m = 0; m < 4; ++m)
#pragma unroll
                    for (int n = 0; n < 2; ++n) acc[a][b][m][n] = (f32x4){0.f, 0.f, 0.f, 0.f};
        cur = nxt; cA = nA; cB = nB; ++ui;
        if constexpr (ALIGN_EPI) { if (wr == 1) PG8_BAR; }
    }
    PG8_WAIT_V(0);
    if constexpr (!ALIGN_EPI) { if (wr == 0) PG8_BAR; }
    PG8_BAR;
    if constexpr (Epi::AFTER_DRAIN) { E.fused(acc, cur, wr, wc, fr, fq, lds, wid, lane); S.done(cur); }
#undef PG8_SA
#undef PG8_SB
#undef PG8_STAGE
#undef PG8_LDA
#undef PG8_LDB
#undef PG8_MMA
#undef PG8_WAIT_V
#undef PG8_WAIT_L
#undef PG8_BAR
#undef PG8_SCHED
}
}
#define GAS __attribute__((address_space(1)))
#define LAS __attribute__((address_space(3)))
typedef unsigned short bf16;
typedef unsigned v4u __attribute__((ext_vector_type(4)));
typedef float f32x4 __attribute__((ext_vector_type(4)));
typedef short bf16x8 __attribute__((ext_vector_type(8)));
typedef GAS unsigned gu32;
typedef GAS unsigned long long gu64;
#define RLX_AGENT __ATOMIC_RELAXED, __HIP_MEMORY_SCOPE_AGENT
#define LDS_WAIT() asm volatile("s_waitcnt lgkmcnt(0)" ::: "memory")
#define VM_WAIT() asm volatile("s_waitcnt vmcnt(0)" ::: "memory")
__device__ __forceinline__ unsigned long long rt() { return __builtin_amdgcn_s_memrealtime(); }
__device__ __forceinline__ unsigned f2bf(float f) { unsigned u = __builtin_bit_cast(unsigned, f); return (u + 0x7fffu + ((u >> 16) & 1u)) >> 16; }
__device__ __forceinline__ unsigned pk2(float lo, float hi) { return f2bf(lo) | (f2bf(hi) << 16); }
#define XB_TMO      128
#define XB_XCNT(j)  (256  + 64 * (j))
#define XB_XSUB(j)  (1280 + 64 * (j))
#define XB_XGEN(j)  (2304 + 64 * (j))
#define XB_TOP      3328
#define XB_TOPGEN   3392
#define XCD_BAR_WORDS 3456
#define XB_SPIN_CAP (1u << 24)

__device__ __forceinline__ unsigned xb_ld(unsigned* p)              { return __hip_atomic_load(p, __ATOMIC_RELAXED, __HIP_MEMORY_SCOPE_AGENT); }
__device__ __forceinline__ unsigned xb_add(unsigned* p, unsigned v) { return __hip_atomic_fetch_add(p, v, __ATOMIC_RELAXED, __HIP_MEMORY_SCOPE_AGENT); }
__device__ __forceinline__ unsigned xb_xcc_id() { return (unsigned)__builtin_amdgcn_s_getreg((3 << 11) | 20) & 0xFu; }
#define XB_SPIN(cond, bar) do { unsigned _sp = 0; while (cond) { __builtin_amdgcn_s_sleep(1); \
    if ((++_sp & 255u) == 0u) { if (xb_ld(&(bar)[XB_TMO])) break; if (_sp > XB_SPIN_CAP) { atomicAdd(&(bar)[XB_TMO], 1u); break; } } } } while (0)

struct XcdBarrier {
    unsigned* bar; unsigned x;
    volatile LAS unsigned* st;
};

__device__ __forceinline__ XcdBarrier xcd_barrier_post(unsigned* bar, volatile LAS unsigned* st) {
    XcdBarrier b; b.bar = bar; b.x = xb_xcc_id(); b.st = st;
    if (threadIdx.x == 0) (void)xb_add(&bar[XB_XCNT(b.x)], 1u);
    return b;
}
__device__ __forceinline__ void xcd_barrier_complete(unsigned* bar, unsigned x, unsigned& nloc, unsigned& nx) {
    const unsigned G = gridDim.x * gridDim.y * gridDim.z;
    unsigned sum, cnt, mine, sp = 0u;
    for (;;) {
        sum = 0u; cnt = 0u; mine = 0u;
#pragma unroll
        for (unsigned j = 0; j < 16; ++j) { const unsigned c = xb_ld(&bar[XB_XCNT(j)]); sum += c; cnt += (c > 0u) ? 1u : 0u; mine = (j == x) ? c : mine; }
        if (sum == G) break;
        __builtin_amdgcn_s_sleep(1);
        if ((++sp & 255u) == 0u) { if (xb_ld(&bar[XB_TMO])) break; if (sp > XB_SPIN_CAP) { atomicAdd(&bar[XB_TMO], 1u); break; } }
    }
    nloc = mine > 0u ? mine : 1u; nx = cnt > 0u ? cnt : 1u;
}

__device__ __forceinline__ void xcd_barrier(const XcdBarrier& b) {
    asm volatile("s_waitcnt vmcnt(0)" ::: "memory");
    __syncthreads();
    if (threadIdx.x == 0) {
        unsigned* bar = b.bar;
        __builtin_amdgcn_s_waitcnt(0);
        unsigned nloc = b.st[0], nx = b.st[1];
        if (nloc == 0u) { xcd_barrier_complete(bar, b.x, nloc, nx); b.st[0] = nloc; b.st[1] = nx; }
        const unsigned old = xb_add(&bar[XB_XSUB(b.x)], 1u);
        const unsigned gen = old / nloc;
        if (old + 1u == (gen + 1u) * nloc) {
            __builtin_amdgcn_fence(__ATOMIC_RELEASE, "agent");
            asm volatile("s_waitcnt vmcnt(0)" ::: "memory");
            const unsigned og = xb_add(&bar[XB_TOP], 1u);
            const unsigned tg = og / nx;
            if (og + 1u == (tg + 1u) * nx) xb_add(&bar[XB_TOPGEN], 1u);
            else XB_SPIN(xb_ld(&bar[XB_TOPGEN]) == tg, bar);
            __builtin_amdgcn_fence(__ATOMIC_ACQUIRE, "agent");
            xb_add(&bar[XB_XGEN(b.x)], 1u);
            asm volatile("s_waitcnt vmcnt(0)" ::: "memory");
        } else {
            XB_SPIN(xb_ld(&bar[XB_XGEN(b.x)]) == gen, bar);
            __builtin_amdgcn_fence(__ATOMIC_ACQUIRE, "agent");
            asm volatile("s_waitcnt vmcnt(0)" ::: "memory");
        }
    }
    __syncthreads();
}
namespace mk {
using pg8::f32x4; using pg8::Unit; using pg8::bf16_t; using pg8::u32x4; using pg8::cvt_pk_bf16;
typedef unsigned u32x2 __attribute__((ext_vector_type(2)));
constexpr int B = 8, S = 4096, D = 1024, T = B * S, INW = 3584, DFF = 2816, NMOD = 6144, NGU = 2 * DFF;
constexpr float EPS = 1e-6f, LOG2E = 1.4426950408889634f, QSCALE = 0.125f * 1.4426950408889634f;
#define EPI_LANES() int lane_; asm volatile("v_mbcnt_lo_u32_b32 %0, -1, 0\n\tv_mbcnt_hi_u32_b32 %0, -1, %0" : "=&v"(lane_)); const int wr = wr_, wc = wc_, fr = lane_ & 15, fq = lane_ >> 4; (void)fr_; (void)fq_;
template <int CTRL> __device__ __forceinline__ float dpp_mov0(float v) { return __int_as_float(__builtin_amdgcn_update_dpp(0, __float_as_int(v), CTRL, 0xF, 0xF, false)); }
__device__ __forceinline__ float row_scan16(float s) { s += dpp_mov0<0x111>(s); s += dpp_mov0<0x112>(s); s += dpp_mov0<0x114>(s); s += dpp_mov0<0x118>(s); return s; }
__device__ __forceinline__ float row_sum16(float s) { s += dpp_mov0<0x128>(s); s += dpp_mov0<0x124>(s); s += dpp_mov0<0x122>(s); s += dpp_mov0<0x121>(s); return s; }
__device__ __forceinline__ float ex2(float x) { return __builtin_amdgcn_exp2f(x); }
__device__ __forceinline__ float lg2(float x) { return __builtin_amdgcn_logf(x); }
__device__ __forceinline__ float rcp(float x) { return __builtin_amdgcn_rcpf(x); }
__device__ __forceinline__ float rsq(float x) { return __builtin_amdgcn_rsqf(x); }
__device__ __forceinline__ float silu(float x) { return x * rcp(1.f + ex2(-x * LOG2E)); }
typedef short bf16x8 __attribute__((ext_vector_type(8)));
typedef float f32x2c __attribute__((ext_vector_type(2))); typedef __bf16 bf16x2c __attribute__((ext_vector_type(2)));
__device__ __forceinline__ unsigned pk2r(float lo, float hi) { const f32x2c v = {lo, hi}; return __builtin_bit_cast(unsigned, __builtin_convertvector(v, bf16x2c)); }
__device__ __forceinline__ float bf2f(unsigned short h) { return __uint_as_float(((unsigned)h) << 16); }
__device__ __forceinline__ float bflo(unsigned w) { return __uint_as_float(w << 16); }
__device__ __forceinline__ float bfhi(unsigned w) { return __uint_as_float(w & 0xffff0000u); }

struct EpiIn {
    static constexpr bool PERM = true, AFTER_DRAIN = false;
    bf16_t *QT, *KT, *VH, *SG, *AQ, *AK, *AV; float* DEC; const float* lb;
    __device__ __forceinline__ void operator()(f32x4 (&acc)[2][2][4][2], const Unit& u, int wr_, int wc_, int fr_, int fq_) const {
        EPI_LANES();
        const int pn = u.pn; const unsigned row0 = (unsigned)(u.pm * 256 + wr * 64 + fr);
#ifndef NO_HGRN_EPI
        if (pn < 4) {
            const int cb = pn * 128 + wc * 32 + 8 * fq;
            const f32x4 l0 = *(const f32x4*)(lb + cb), l1 = *(const f32x4*)(lb + cb + 4);
#pragma unroll
            for (int ai = 0; ai < 2; ++ai) {
                const unsigned chunk = (unsigned)(u.pm * 4 + ai * 2 + wr);
#pragma unroll
                for (int n = 0; n < 2; ++n) {
                    float dl[4];
#pragma unroll
                    for (int j = 0; j < 4; ++j) {
                        const float lbv = n == 0 ? l0[j] : l1[j], omlb = 1.f - lbv;
                        float lgv[4], b2[4]; float carry = 0.f;
#pragma unroll
                        for (int m = 0; m < 4; ++m) { const float e = ex2(-acc[ai][1][m][n][j] * LOG2E), sg = rcp(1.f + e); lgv[m] = lg2(lbv + omlb * sg); acc[ai][1][m][n][j] = omlb * (e * sg); }
#pragma unroll
                        for (int m = 0; m < 4; ++m) { const float s = row_scan16(lgv[m]), tot = row_sum16(lgv[m]); b2[m] = carry + s; carry += tot; }
                        dl[j] = ex2(carry);
#pragma unroll
                        for (int m = 0; m < 4; ++m) { acc[ai][0][m][n][j] = silu(acc[ai][0][m][n][j]) * ex2(b2[m]); acc[ai][1][m][n][j] *= ex2(-b2[m]); }
                        __builtin_amdgcn_sched_barrier(0);
                    }
                    *(f32x4*)(DEC + (chunk * 512u + (unsigned)(cb + 4 * n))) = (f32x4){dl[0], dl[1], dl[2], dl[3]};
#pragma unroll
                    for (int m = 0; m < 4; ++m) { const unsigned off = (row0 + ai * 128 + m * 16) * 512u + (unsigned)(cb + 4 * n);
                        const f32x4 q = acc[ai][0][m][n], k = acc[ai][1][m][n];
                        u32x2 w; w.x = pk2r(q[0], q[1]); w.y = pk2r(q[2], q[3]); *(u32x2*)(QT + off) = w;
                        u32x2 kw; kw.x = pk2r(k[0], k[1]); kw.y = pk2r(k[2], k[3]); *(u32x2*)(KT + off) = kw; }
                    __builtin_amdgcn_sched_barrier(0);
                }
            }
        } else
#endif
        {
            const int g = (pn - 4) >> 1; bf16_t* base = g == 0 ? VH : g == 1 ? SG : g == 2 ? AQ : g == 3 ? AK : AV;
            const unsigned col0 = (unsigned)(((pn - 4) & 1) * 256 + wc * 32 + 8 * fq);
#pragma unroll
            for (int ai = 0; ai < 2; ++ai)
#pragma unroll
                for (int m = 0; m < 4; ++m) { bf16_t* rowp = base + ((row0 + ai * 128 + m * 16) * 512u + col0);
#pragma unroll
                    for (int bj = 0; bj < 2; ++bj) { f32x4 v0 = acc[ai][bj][m][0], v1 = acc[ai][bj][m][1];
                        if (g == 1) {
#pragma unroll
                            for (int j = 0; j < 4; ++j) { v0[j] = silu(v0[j]); v1[j] = silu(v1[j]); } }
                        if (g == 2) { v0 = v0 * QSCALE; v1 = v1 * QSCALE; }
                        u32x4 w; w.x = pk2r(v0[0], v0[1]); w.y = pk2r(v0[2], v0[3]); w.z = pk2r(v1[0], v1[1]); w.w = pk2r(v1[2], v1[3]);
                        *(u32x4*)(rowp + bj * 128) = w; } }
        }
    }
};

struct EpiOut {
    static constexpr bool PERM = false, AFTER_DRAIN = false;
    const float* x; float* x1; bf16_t* A2; float* ssq; const float* mod; const float* g2;
    __device__ __forceinline__ void operator()(const f32x4 (&acc)[2][2][4][2], const Unit& u, int wr_, int wc_, int fr_, int fq_) const {
        EPI_LANES();
        const int b = u.pm >> 4, col0 = u.pn * 256 + wc * 32 + 4 * fq, rowb = u.pm * 256 + wr * 64 + fr; const float* modb = mod + b * NMOD;
        float ssr[2][4];
#pragma unroll
        for (int ai = 0; ai < 2; ++ai)
#pragma unroll
            for (int m = 0; m < 4; ++m) ssr[ai][m] = 0.f;
#pragma unroll
        for (int bj = 0; bj < 2; ++bj)
#pragma unroll
            for (int n = 0; n < 2; ++n) { const int c = col0 + bj * 128 + n * 16;
                const f32x4 gate = *(const f32x4*)(modb + 2048 + c), sc2 = *(const f32x4*)(modb + 4096 + c), gg = *(const f32x4*)(g2 + c); const f32x4 mul = gg * (sc2 + 1.0f);
#pragma unroll
                for (int ai = 0; ai < 2; ++ai)
#pragma unroll
                    for (int m = 0; m < 4; ++m) { const size_t off = (size_t)(rowb + ai * 128 + m * 16) * D + c;
                        const f32x4 v = *(const f32x4*)(x + off) + gate * acc[ai][bj][m][n]; *(f32x4*)(x1 + off) = v;
                        ssr[ai][m] += (v[0] * v[0] + v[1] * v[1]) + (v[2] * v[2] + v[3] * v[3]);
                        const f32x4 a = v * mul; u32x2 w; w.x = pk2r(a[0], a[1]); w.y = pk2r(a[2], a[3]); *(u32x2*)(A2 + off) = w; } }
#pragma unroll
        for (int ai = 0; ai < 2; ++ai)
#pragma unroll
            for (int m = 0; m < 4; ++m) { float s = ssr[ai][m]; s += __shfl_xor(s, 16); s += __shfl_xor(s, 32);
                if (fq == 0) ssq[(size_t)(rowb + ai * 128 + m * 16) * 16 + u.pn * 4 + wc] = s; }
    }
};

struct EpiGU {
    static constexpr bool PERM = true, AFTER_DRAIN = false;
    bf16_t* HID; const float* ssq; const float* bias2;
    __device__ __forceinline__ void operator()(const f32x4 (&acc)[2][2][4][2], const Unit& u, int wr_, int wc_, int fr_, int fq_) const {
        EPI_LANES();
        const int b = u.pm >> 4, rowb = u.pm * 256 + wr * 64 + fr; const float* bb = bias2 + b * NGU + u.pn * 256 + wc * 32 + 8 * fq;
        const f32x4 ba0 = *(const f32x4*)(bb), ba1 = *(const f32x4*)(bb + 4), bu0 = *(const f32x4*)(bb + 128), bu1 = *(const f32x4*)(bb + 132);
#pragma unroll
        for (int ai = 0; ai < 2; ++ai)
#pragma unroll
            for (int m = 0; m < 4; ++m) { const int row = rowb + ai * 128 + m * 16; const f32x4* sp = (const f32x4*)(ssq + (size_t)row * 16);
                const f32x4 s0 = sp[0], s1 = sp[1], s2 = sp[2], s3 = sp[3]; const f32x4 st = (s0 + s1) + (s2 + s3);
                const float rstd = rsq(((st[0] + st[1]) + (st[2] + st[3])) * (1.0f / D) + EPS);
                const f32x4 a0 = acc[ai][0][m][0] * rstd + ba0, a1 = acc[ai][0][m][1] * rstd + ba1, u0 = acc[ai][1][m][0] * rstd + bu0, u1 = acc[ai][1][m][1] * rstd + bu1;
                float h[8];
#pragma unroll
                for (int j = 0; j < 4; ++j) { h[j] = silu(a0[j]) * u0[j]; h[4 + j] = silu(a1[j]) * u1[j]; }
                u32x4 w; w.x = pk2r(h[0], h[1]); w.y = pk2r(h[2], h[3]); w.z = pk2r(h[4], h[5]); w.w = pk2r(h[6], h[7]);
                *(u32x4*)(HID + (size_t)row * DFF + u.pn * 128 + wc * 32 + 8 * fq) = w; }
    }
};

struct EpiDown {
    static constexpr bool PERM = false, AFTER_DRAIN = false;
    float* xio; const float* mod;
    __device__ __forceinline__ void operator()(const f32x4 (&acc)[2][2][4][2], const Unit& u, int wr_, int wc_, int fr_, int fq_) const {
        EPI_LANES();
        const int b = u.pm >> 4, col0 = u.pn * 256 + wc * 32 + 4 * fq, rowb = u.pm * 256 + wr * 64 + fr; const float* modb = mod + b * NMOD;
#pragma unroll
        for (int bj = 0; bj < 2; ++bj)
#pragma unroll
            for (int n = 0; n < 2; ++n) { const int c = col0 + bj * 128 + n * 16; const f32x4 gate = *(const f32x4*)(modb + 5120 + c);
#pragma unroll
                for (int ai = 0; ai < 2; ++ai)
#pragma unroll
                    for (int m = 0; m < 4; ++m) { const size_t off = (size_t)(rowb + ai * 128 + m * 16) * D + c; *(f32x4*)(xio + off) = *(const f32x4*)(xio + off) + gate * acc[ai][bj][m][n]; } }
    }
};
}
namespace mk {
constexpr int NWAVES = 8;
constexpr size_t MiB = 1u << 20;
constexpr size_t WS_CTL = 0, CTL_ZERO_BYTES = 64 * 1024;
constexpr size_t WS_MODP = 1 * MiB;
constexpr size_t WS_MOD = 3 * MiB, WS_LB = WS_MOD + 256 * 1024, WS_BIAS2 = WS_MOD + 512 * 1024;
constexpr size_t WS_WIN = 4 * MiB, WS_WOUT = 11 * MiB, WS_WGU = 13 * MiB, WS_WD = 24 * MiB;
constexpr size_t WS_DEC = 30 * MiB, WS_LSE = 31 * MiB, WS_SSQ1 = 34 * MiB;
constexpr size_t WS_BUFA = 40 * MiB;
constexpr size_t WS_BUFB = 104 * MiB;
constexpr size_t WS_R = 168 * MiB;
constexpr size_t WS_QT = WS_R, WS_KT = WS_R + 32 * MiB, WS_VH = WS_R + 64 * MiB, WS_SG = WS_R + 96 * MiB, WS_AQ = WS_R + 128 * MiB, WS_AK = WS_R + 160 * MiB, WS_AV = WS_R + 192 * MiB;
constexpr size_t WS_ST = WS_BUFA;
constexpr size_t WS_ATT0 = WS_R + 224 * MiB, WS_ATT1 = WS_R + 256 * MiB, WS_ATT2 = WS_R + 288 * MiB;
constexpr size_t WS_HID = WS_R;
constexpr size_t WS_END = WS_R + 320 * MiB;
constexpr int CW_BAR = 4096;
constexpr int RING_BYTES = 131072, LDS_BYTES = 163840, LDSCTL_OFF = LDS_BYTES - 512, MISC_OFF = LDSCTL_OFF + 320;

__device__ __forceinline__ const float* karg_ptr(int i) {
    asm volatile("" : "+s"(i));
    typedef const float* cfp;
    const __attribute__((address_space(4))) cfp* ka = (const __attribute__((address_space(4))) cfp*)__builtin_amdgcn_kernarg_segment_ptr();
    return ka[i];
}

__device__ __forceinline__ void transpose_item(const float* W, int K, int N, bf16* WT, int mode, LAS float* scr, int item, int lane) {
    const int nblk = N / 32, kb = item / nblk, nb = item % nblk, k0 = 64 * kb, n0 = 32 * nb;
    int r0 = n0;
    if (mode == 1) { if (n0 < 512) r0 = (n0 >> 7) * 256 + (n0 & 127); else if (n0 < 1024) r0 = ((n0 - 512) >> 7) * 256 + 128 + (n0 & 127); }
    if (mode == 2) { if (n0 < DFF) r0 = (n0 >> 7) * 256 + (n0 & 127); else r0 = ((n0 - DFF) >> 7) * 256 + 128 + ((n0 - DFF) & 127); }
#pragma unroll 8
    for (int i = 0; i < 32; ++i) { const int kk = 2 * i + (lane >> 5); scr[kk * 33 + (lane & 31)] = W[(size_t)(k0 + kk) * N + n0 + (lane & 31)]; }
    LDS_WAIT(); asm volatile("" ::: "memory");
    const int c = lane & 7;
#pragma unroll
    for (int j = 0; j < 4; ++j) { const int n = (lane >> 3) + 8 * j; const LAS float* s = scr + (8 * c) * 33 + n;
        v4u o; o.x = pk2(s[0 * 33], s[1 * 33]); o.y = pk2(s[2 * 33], s[3 * 33]); o.z = pk2(s[4 * 33], s[5 * 33]); o.w = pk2(s[6 * 33], s[7 * 33]);
        *(GAS v4u*)(WT + (size_t)(r0 + n) * K + k0 + 8 * c) = o; }
    LDS_WAIT(); asm volatile("" ::: "memory");
}
__device__ __forceinline__ void mod_partial(const float* Pc, const float* Pw_ada, float* modp, LAS float* scr, int it, int lane) {
    const int cg = it % 96, ks = it / 96, n = cg * 64 + lane;
#pragma unroll
    for (int i = 0; i < 16; ++i) { const int idx = i * 64 + lane, kk = idx & 127, b = idx >> 7; scr[kk * 8 + b] = silu(Pc[b * D + ks * 128 + kk]); }
    LDS_WAIT(); asm volatile("" ::: "memory");
    float acc[8];
#pragma unroll
    for (int b = 0; b < 8; ++b) acc[b] = 0.f;
    const float* wp = Pw_ada + (size_t)(ks * 128) * NMOD + n;
#pragma unroll 16
    for (int kk = 0; kk < 128; ++kk) { const float w = wp[(size_t)kk * NMOD]; const f32x4 c0 = *(const LAS f32x4*)(scr + kk * 8), c1 = *(const LAS f32x4*)(scr + kk * 8 + 4);
        acc[0] += c0[0] * w; acc[1] += c0[1] * w; acc[2] += c0[2] * w; acc[3] += c0[3] * w; acc[4] += c1[0] * w; acc[5] += c1[1] * w; acc[6] += c1[2] * w; acc[7] += c1[3] * w; }
#pragma unroll
    for (int b = 0; b < 8; ++b) modp[(size_t)(ks * 8 + b) * NMOD + n] = acc[b];
    LDS_WAIT(); asm volatile("" ::: "memory");
}
__device__ __forceinline__ float wsum64(float v) {
#pragma unroll
    for (int o = 1; o < 64; o <<= 1) v += __shfl_xor(v, o);
    return v;
}
__device__ __forceinline__ float wmax64(float v) {
#pragma unroll
    for (int o = 1; o < 64; o <<= 1) v = fmaxf(v, __shfl_xor(v, o));
    return v;
}

typedef short s16x4v __attribute__((ext_vector_type(4)));
#define LBAR() asm volatile("s_waitcnt lgkmcnt(0)\n\ts_barrier" ::: "memory")
#define TOPBAR() asm volatile("s_waitcnt vmcnt(0) lgkmcnt(0)\n\ts_barrier" ::: "memory")
#define TOUCH(x) asm volatile("" : "+v"(x))
__device__ __forceinline__ void glds16(const void* gsrc, unsigned lds_dst) { unsigned keep;
    asm volatile("s_mov_b32 %0, m0\n\ts_mov_b32 m0, %2\n\ts_nop 0\n\tglobal_load_lds_dwordx4 %1, off\n\ts_mov_b32 m0, %0" : "=&s"(keep) : "v"(gsrc), "s"(lds_dst) : "memory"); }
__device__ __forceinline__ void glds4(const void* gsrc, unsigned lds_dst) { unsigned keep;
    asm volatile("s_mov_b32 %0, m0\n\ts_mov_b32 m0, %2\n\ts_nop 0\n\tglobal_load_lds_dword %1, off\n\ts_mov_b32 m0, %0" : "=&s"(keep) : "v"(gsrc), "s"(lds_dst) : "memory"); }
__device__ __forceinline__ unsigned lds_addr(const LAS unsigned char* p) { return (unsigned)(size_t)p; }
template <int SW> __device__ __forceinline__ int swz(int R) { return SW == 0 ? (R & 15) : SW == 1 ? (((R & 3) << 1) | (((R >> 3) & 1) << 3)) : ((R & 7) << 1); }
template <int SW> __device__ __forceinline__ void tile_dma(LAS unsigned char* lds, int to, const bf16* src, size_t tok0, int col0, int wave, int lane) {
#pragma unroll
    for (int pi = 0; pi < 2; ++pi) { const int piece = wave + 8 * pi, R = 4 * piece + (lane >> 4); const int gch = (lane & 15) ^ swz<SW>(R);
        glds16(src + (tok0 + R) * 512 + col0 + gch * 8, (unsigned)__builtin_amdgcn_readfirstlane(lds_addr(lds) + to + piece * 1024)); }
}
template <int SW> __device__ __forceinline__ bf16x8 tr_frag(const LAS unsigned char* tile, int r0a, int r0b, int c0, int i16) {
    const int q = i16 >> 2, ch = (c0 >> 3) + ((i16 & 3) >> 1), bo = (i16 & 1) * 8; const int Ra = r0a + q, Rb = r0b + q;
    const s16x4v va = __builtin_amdgcn_ds_read_tr16_b64_v4i16((LAS s16x4v*)(tile + Ra * 256 + ((ch ^ swz<SW>(Ra)) << 4) + bo));
    const s16x4v vb = __builtin_amdgcn_ds_read_tr16_b64_v4i16((LAS s16x4v*)(tile + Rb * 256 + ((ch ^ swz<SW>(Rb)) << 4) + bo));
    return (bf16x8){va[0], va[1], va[2], va[3], vb[0], vb[1], vb[2], vb[3]};
}
__device__ __forceinline__ bf16x8 row_frag(const LAS unsigned char* tile, int R, int ch) { return *(const LAS bf16x8*)(tile + R * 256 + ((ch ^ (R & 15)) << 4)); }

__device__ __forceinline__ void scan_issue(LAS unsigned char* lds, const bf16* KT, const bf16* VH, const float* DEC, int b, int h, int c, int wave, int lane) {
    const int bo = (c % 3) * 32768; const size_t tok = (size_t)b * S + 64 * c;
    tile_dma<1>(lds, bo, KT, tok, h * 128, wave, lane); tile_dma<1>(lds, bo + 16384, VH, tok, h * 128, wave, lane);
    glds4(DEC + ((size_t)(b * 64 + c) * 512 + h * 128 + 16 * wave + (lane & 15)), (unsigned)__builtin_amdgcn_readfirstlane(lds_addr(lds) + 131072 + (c % 3) * 2048 + wave * 256));
}
__device__ __forceinline__ void hgrn_scan(LAS unsigned char* lds, const bf16* KT, const bf16* VH, const float* DEC, bf16* ST, int bh, int wave, int lane) {
    const int b = bh >> 2, h = bh & 3, i16 = lane & 15, g4 = lane >> 4;
    LAS unsigned char* stg = lds + 98304;
    f32x4 acc[8];
#pragma unroll
    for (int vt = 0; vt < 8; ++vt) acc[vt] = (f32x4){0.f, 0.f, 0.f, 0.f};
    scan_issue(lds, KT, VH, DEC, b, h, 0, wave, lane); scan_issue(lds, KT, VH, DEC, b, h, 1, wave, lane);
    for (int c = 0; c < 63; ++c) {
        if (c < 2 || c >= 61) asm volatile("s_waitcnt vmcnt(0) lgkmcnt(0)\n\ts_barrier" ::: "memory");
        else asm volatile("s_waitcnt vmcnt(13) lgkmcnt(0)\n\ts_barrier" ::: "memory");
        if (c + 2 < 63) scan_issue(lds, KT, VH, DEC, b, h, c + 2, wave, lane);
        const LAS unsigned char* Kt = lds + (c % 3) * 32768; const LAS unsigned char* Vt = Kt + 16384;
        const f32x4 dv = *(const LAS f32x4*)(lds + 131072 + (c % 3) * 2048 + wave * 256 + 16 * g4);
#pragma unroll
        for (int ks = 0; ks < 2; ++ks) { const int r0 = 32 * ks + 8 * g4;
            const bf16x8 af = tr_frag<1>(Kt, r0, r0 + 4, 16 * wave, i16);
#pragma unroll
            for (int vt = 0; vt < 8; ++vt) { const bf16x8 bfv = tr_frag<1>(Vt, r0, r0 + 4, 16 * vt, i16);
                acc[vt] = __builtin_amdgcn_mfma_f32_16x16x32_bf16(af, bfv, acc[vt], 0, 0, 0); } }
#pragma unroll
        for (int vt = 0; vt < 8; ++vt) { acc[vt] = acc[vt] * dv;
            u32x2 w; w.x = pk2r(acc[vt][0], acc[vt][1]); w.y = pk2r(acc[vt][2], acc[vt][3]);
            *(LAS u32x2*)(stg + (16 * vt + i16) * 256 + (((4 * wave + g4) ^ (i16 << 1)) << 3)) = w; }
        LBAR();
        { unsigned char* gp = (unsigned char*)(ST + (size_t)(bh * 64 + c) * 16384);
#pragma unroll
          for (int q4 = 0; q4 < 4; ++q4) { const int r = 16 * wave + 4 * q4 + (lane >> 4), ch = lane & 15;
              const v4u x = *(const LAS v4u*)(stg + r * 256 + ((ch ^ (r & 15)) << 4)); *(v4u*)(gp + r * 256 + ch * 16) = x; } }
    }
    asm volatile("s_waitcnt vmcnt(0) lgkmcnt(0)\n\ts_barrier" ::: "memory");
}

__device__ __forceinline__ void hgrn_out_units(LAS unsigned char* lds, const bf16* QT, const bf16* KT, const bf16* VH, const bf16* SG, const bf16* ST, const float* hg_on, bf16* MIXIN, int wave, int lane, int ulo, int uhi) {
    const int i16 = lane & 15, g4 = lane >> 4;
    LAS unsigned char* Pl = lds + 98304; LAS float* ssq = (LAS float*)(lds + 106496);
    bf16x8 san[4];
    { const int bh = ulo >> 6, c = ulo & 63, b = bh >> 2, h = bh & 3; const size_t tok0 = (size_t)b * S + 64 * c;
      tile_dma<0>(lds, 0, QT, tok0, h * 128, wave, lane); tile_dma<0>(lds, 16384, KT, tok0, h * 128, wave, lane); tile_dma<2>(lds, 32768, VH, tok0, h * 128, wave, lane);
      if (c > 0) { const bf16* sp = ST + (((size_t)(bh * 64 + c - 1) * 128 + 16 * wave + i16) * 128 + 8 * g4);
#pragma unroll
          for (int ks = 0; ks < 4; ++ks) san[ks] = *(const bf16x8*)(sp + 32 * ks); }
      else {
#pragma unroll
          for (int ks = 0; ks < 4; ++ks) san[ks] = (bf16x8){0, 0, 0, 0, 0, 0, 0, 0}; } }
    for (int u = ulo; u < uhi; ++u) {
        const int cur = (u - ulo) & 1; const int bh = u >> 6, c = u & 63, b = bh >> 2, h = bh & 3; const size_t tok0 = (size_t)b * S + 64 * c;
        TOPBAR();
        TOUCH(san[0]); TOUCH(san[1]); TOUCH(san[2]); TOUCH(san[3]);
        const bf16x8 sa[4] = {san[0], san[1], san[2], san[3]};
        if (u + 1 < uhi) { const int bh2 = (u + 1) >> 6, c2 = (u + 1) & 63; const size_t t2 = (size_t)(bh2 >> 2) * S + 64 * c2; const int h2 = bh2 & 3, o2 = (cur ^ 1) * 49152;
            tile_dma<0>(lds, o2, QT, t2, h2 * 128, wave, lane); tile_dma<0>(lds, o2 + 16384, KT, t2, h2 * 128, wave, lane); tile_dma<2>(lds, o2 + 32768, VH, t2, h2 * 128, wave, lane);
            if (c2 > 0) { const bf16* sp = ST + (((size_t)(bh2 * 64 + c2 - 1) * 128 + 16 * wave + i16) * 128 + 8 * g4);
#pragma unroll
                for (int ks = 0; ks < 4; ++ks) san[ks] = *(const bf16x8*)(sp + 32 * ks); }
            else {
#pragma unroll
                for (int ks = 0; ks < 4; ++ks) san[ks] = (bf16x8){0, 0, 0, 0, 0, 0, 0, 0}; } }
        const LAS unsigned char* Qt = lds + cur * 49152; const LAS unsigned char* Kt = Qt + 16384; const LAS unsigned char* Vt = Qt + 32768;
#pragma unroll
        for (int q = 0; q < 2; ++q) { const int id = 2 * wave + q, si = id >> 2, ti = id & 3; f32x4 a = {0.f, 0.f, 0.f, 0.f};
            if (si <= ti) {
#pragma unroll
                for (int ks = 0; ks < 4; ++ks) a = __builtin_amdgcn_mfma_f32_16x16x32_bf16(row_frag(Kt, 16 * si + i16, g4 + 4 * ks), row_frag(Qt, 16 * ti + i16, g4 + 4 * ks), a, 0, 0, 0);
                if (si == ti) {
#pragma unroll
                    for (int reg = 0; reg < 4; ++reg) if (4 * g4 + reg > i16) a[reg] = 0.f; } }
            u32x2 w; w.x = pk2r(a[0], a[1]); w.y = pk2r(a[2], a[3]); *(LAS u32x2*)(Pl + id * 512 + lane * 8) = w; }
        LBAR();
        f32x4 o[4];
#pragma unroll
        for (int tt = 0; tt < 4; ++tt) { o[tt] = (f32x4){0.f, 0.f, 0.f, 0.f};
#pragma unroll
            for (int ks = 0; ks < 4; ++ks) o[tt] = __builtin_amdgcn_mfma_f32_16x16x32_bf16(sa[ks], row_frag(Qt, 16 * tt + i16, g4 + 4 * ks), o[tt], 0, 0, 0);
#pragma unroll
            for (int kp = 0; kp < 2; ++kp) { if (2 * kp <= tt) {
                    const u32x2 pa = *(const LAS u32x2*)(Pl + ((2 * kp) * 4 + tt) * 512 + lane * 8), pb = *(const LAS u32x2*)(Pl + ((2 * kp + 1) * 4 + tt) * 512 + lane * 8);
                    const v4u pw = {pa.x, pa.y, pb.x, pb.y};
                    const bf16x8 vf = tr_frag<2>(Vt, 32 * kp + 4 * g4, 32 * kp + 16 + 4 * g4, 16 * wave, i16);
                    o[tt] = __builtin_amdgcn_mfma_f32_16x16x32_bf16(vf, __builtin_bit_cast(bf16x8, pw), o[tt], 0, 0, 0); } } }
        LAS unsigned char* ostg = lds + 108544;
#pragma unroll
        for (int tt = 0; tt < 4; ++tt) { float ss = (o[tt][0] * o[tt][0] + o[tt][1] * o[tt][1]) + (o[tt][2] * o[tt][2] + o[tt][3] * o[tt][3]); ss += __shfl_xor(ss, 16); ss += __shfl_xor(ss, 32);
            if (g4 == 0) ssq[wave * 64 + 16 * tt + i16] = ss;
            u32x2 w; w.x = pk2r(o[tt][0], o[tt][1]); w.y = pk2r(o[tt][2], o[tt][3]);
            *(LAS u32x2*)(ostg + (16 * tt + i16) * 256 + (((4 * wave + g4) ^ (i16 << 1)) << 3)) = w; }
        LBAR();
#pragma unroll
        for (int j = 0; j < 2; ++j) { const int r = 8 * wave + 4 * j + (lane >> 4), ch = lane & 15;
            float tot = 0.f;
#pragma unroll
            for (int w8 = 0; w8 < 8; ++w8) tot += ssq[w8 * 64 + r];
            const float rstd = rsq(tot * (1.f / 128.f) + EPS);
            const v4u ov = *(const LAS v4u*)(ostg + r * 256 + ((ch ^ (r & 15)) << 4));
            const size_t tok = tok0 + r; const int col = h * 128 + 8 * ch;
            const v4u sg = *(const v4u*)(SG + tok * 512 + col);
            const f32x4 g0 = *(const f32x4*)(hg_on + 8 * ch), g1 = *(const f32x4*)(hg_on + 8 * ch + 4);
            v4u w;
            w.x = pk2r(bflo(ov.x) * rstd * g0[0] * bflo(sg.x), bfhi(ov.x) * rstd * g0[1] * bfhi(sg.x)); w.y = pk2r(bflo(ov.y) * rstd * g0[2] * bflo(sg.y), bfhi(ov.y) * rstd * g0[3] * bfhi(sg.y));
            w.z = pk2r(bflo(ov.z) * rstd * g1[0] * bflo(sg.z), bfhi(ov.z) * rstd * g1[1] * bfhi(sg.z)); w.w = pk2r(bflo(ov.w) * rstd * g1[2] * bflo(sg.w), bfhi(ov.w) * rstd * g1[3] * bfhi(sg.w));
            *(v4u*)(MIXIN + tok * D + col) = w; }
    }
    __syncthreads();
}

struct AttU { int b, h, dsh, r, n, br; };
__device__ __forceinline__ AttU att_decode(int g) {
    AttU U; const int bh = g / 96, u = g % 96; U.b = bh >> 3; U.h = bh & 7;
    if (u < 32) { U.dsh = 0; U.r = 0; U.n = u; U.br = 0; }
    else if (u < 64) { U.dsh = 2; U.r = (u - 32) >> 3; U.n = (u - 32) & 7; U.br = 1; }
    else { U.dsh = 4; U.r = (u - 64) >> 1; U.n = (u - 64) & 1; U.br = 2; }
    return U;
}
__device__ __forceinline__ void att_dma(LAS unsigned char* lds, int bufo, const bf16* AK, const bf16* AV, const AttU& U, int wave, int lane) {
    const int gch = (lane & 7) ^ (lane >> 3);
#pragma unroll
    for (int pi = 0; pi < 4; ++pi) { const int piece = wave + 8 * pi, row = piece * 8 + (lane >> 3); int m = 128 * (U.n - 1) + row; if (m < 0) m += 128;
        const size_t eoff = ((size_t)U.b * S + (size_t)((m << U.dsh) + U.r)) * 512 + U.h * 64 + gch * 8;
        glds16(AK + eoff, (unsigned)__builtin_amdgcn_readfirstlane(lds_addr(lds) + bufo + piece * 1024));
        glds16(AV + eoff, (unsigned)__builtin_amdgcn_readfirstlane(lds_addr(lds) + bufo + 32768 + piece * 1024)); }
}
__device__ __forceinline__ void attn_units(LAS unsigned char* lds, const bf16* AQ, const bf16* AK, const bf16* AV, unsigned char* ws, float* LSE, int wave, int lane, int glo, int ghi) {
    const int i16 = lane & 15, g4 = lane >> 4;
    if (glo >= ghi) return;
    AttU U = att_decode(glo);
    att_dma(lds, 0, AK, AV, U, wave, lane);
    bf16x8 qn0, qn1;
    { const bf16* qp = AQ + (((size_t)U.b * S + (size_t)(((128 * U.n + 16 * wave + i16) << U.dsh) + U.r)) * 512 + U.h * 64 + 8 * g4); qn0 = *(const bf16x8*)qp; qn1 = *(const bf16x8*)(qp + 32); }
    for (int gu = glo; gu < ghi; ++gu) {
        const int cur = (gu - glo) & 1; const AttU C = U;
        TOPBAR();
        TOUCH(qn0); TOUCH(qn1); const bf16x8 qf0 = qn0, qf1 = qn1;
        if (gu + 1 < ghi) { U = att_decode(gu + 1); att_dma(lds, (cur ^ 1) * 65536, AK, AV, U, wave, lane);
            const bf16* qp = AQ + (((size_t)U.b * S + (size_t)(((128 * U.n + 16 * wave + i16) << U.dsh) + U.r)) * 512 + U.h * 64 + 8 * g4); qn0 = *(const bf16x8*)qp; qn1 = *(const bf16x8*)(qp + 32); }
        const LAS unsigned char* Kb = lds + cur * 65536; const LAS unsigned char* Vb = Kb + 32768;
        f32x4 st[9];
#pragma unroll
        for (int t = 0; t < 9; ++t) { const int R = 16 * (wave + t) + i16; const LAS unsigned char* kp = Kb + R * 128;
            const bf16x8 a0 = *(const LAS bf16x8*)(kp + ((g4 ^ (R & 7)) << 4)), a1 = *(const LAS bf16x8*)(kp + (((g4 + 4) ^ (R & 7)) << 4));
            f32x4 z = {0.f, 0.f, 0.f, 0.f};
            z = __builtin_amdgcn_mfma_f32_16x16x32_bf16(a0, qf0, z, 0, 0, 0); st[t] = __builtin_amdgcn_mfma_f32_16x16x32_bf16(a1, qf1, z, 0, 0, 0); }
        const int qi = 16 * wave + i16; const float NEG = -INFINITY;
#pragma unroll
        for (int reg = 0; reg < 4; ++reg) { const int kj0 = 16 * wave + 4 * g4 + reg; if (kj0 < qi) st[0][reg] = NEG; if (kj0 + 128 > qi + 128) st[8][reg] = NEG; }
        if (C.n == 0) {
#pragma unroll
            for (int t = 0; t < 8; ++t)
#pragma unroll
                for (int reg = 0; reg < 4; ++reg) { if (16 * (wave + t) + 4 * g4 + reg < 128) st[t][reg] = NEG; } }
        float mx = st[0][0];
#pragma unroll
        for (int t = 0; t < 9; ++t)
#pragma unroll
            for (int reg = 0; reg < 4; ++reg) mx = fmaxf(mx, st[t][reg]);
        mx = fmaxf(mx, __shfl_xor(mx, 16)); mx = fmaxf(mx, __shfl_xor(mx, 32));
        float l = 0.f;
#pragma unroll
        for (int t = 0; t < 9; ++t)
#pragma unroll
            for (int reg = 0; reg < 4; ++reg) { const float pv = ex2(st[t][reg] - mx); st[t][reg] = pv; l += pv; }
        l += __shfl_xor(l, 16); l += __shfl_xor(l, 32);
        f32x4 o[4];
#pragma unroll
        for (int et = 0; et < 4; ++et) o[et] = (f32x4){0.f, 0.f, 0.f, 0.f};
#pragma unroll
        for (int ks = 0; ks < 5; ++ks) {
            const int ta = 2 * ks, tb = (ks < 4) ? 2 * ks + 1 : 2 * ks;
            v4u pw; pw.x = pk2r(st[ta][0], st[ta][1]); pw.y = pk2r(st[ta][2], st[ta][3]);
            if (ks < 4) { pw.z = pk2r(st[tb][0], st[tb][1]); pw.w = pk2r(st[tb][2], st[tb][3]); } else { pw.z = 0u; pw.w = 0u; }
            const bf16x8 pf = __builtin_bit_cast(bf16x8, pw);
            const int Ra = 16 * (wave + ta) + 4 * g4 + (i16 >> 2), Rb = 16 * (wave + tb) + 4 * g4 + (i16 >> 2);
#pragma unroll
            for (int et = 0; et < 4; ++et) { const int ch = 2 * et + ((i16 & 3) >> 1), bo = (i16 & 1) * 8;
                const s16x4v va = __builtin_amdgcn_ds_read_tr16_b64_v4i16((LAS s16x4v*)(Vb + Ra * 128 + ((ch ^ (Ra & 7)) << 4) + bo));
                const s16x4v vb = __builtin_amdgcn_ds_read_tr16_b64_v4i16((LAS s16x4v*)(Vb + Rb * 128 + ((ch ^ (Rb & 7)) << 4) + bo));
                const bf16x8 vf = {va[0], va[1], va[2], va[3], vb[0], vb[1], vb[2], vb[3]};
                o[et] = __builtin_amdgcn_mfma_f32_16x16x32_bf16(vf, pf, o[et], 0, 0, 0); }
        }
        const float il = rcp(l);
        LAS unsigned char* stg = lds + 131072 + wave * 2048;
#pragma unroll
        for (int et = 0; et < 4; ++et) { u32x2 w; w.x = pk2r(o[et][0] * il, o[et][1] * il); w.y = pk2r(o[et][2] * il, o[et][3] * il);
            *(LAS u32x2*)(stg + i16 * 128 + (((4 * et + g4) ^ ((i16 & 7) << 1)) << 3)) = w; }
        asm volatile("s_waitcnt lgkmcnt(0)" ::: "memory");
        bf16* AOb = (bf16*)(ws + (C.br == 0 ? WS_ATT0 : C.br == 1 ? WS_ATT1 : WS_ATT2)) + C.h * 64;
#pragma unroll
        for (int j = 0; j < 2; ++j) { const int r = (lane >> 3) + 8 * j, ch = lane & 7;
            const v4u x = *(const LAS v4u*)(stg + r * 128 + ((ch ^ (r & 7)) << 4));
            const size_t orow_r = (size_t)C.b * S + (size_t)(((128 * C.n + 16 * wave + r) << C.dsh) + C.r);
            *(v4u*)(AOb + orow_r * 512 + ch * 8) = x; }
        const size_t orow = (size_t)C.b * S + (size_t)(((128 * C.n + qi) << C.dsh) + C.r);
        if (g4 == 0) LSE[(size_t)C.br * T * 8 + orow * 8 + C.h] = mx + lg2(l);
    }
    __syncthreads();
}

struct Args { const float* in[14]; float* out; unsigned char* ws; };
__global__ void __launch_bounds__(NWAVES * 64, 2) mk_fwd(Args args) {
    extern __shared__ __attribute__((aligned(16))) unsigned char lds_raw[];
    LAS unsigned char* lds = (LAS unsigned char*)lds_raw;
    volatile LAS unsigned* MISC = (volatile LAS unsigned*)(lds + MISC_OFF);
    const int wave = __builtin_amdgcn_readfirstlane(threadIdx.x >> 6);
    const int G = gridDim.x, bx = blockIdx.x; const int vcu = (G % 8 == 0) ? (bx % 8) * (G / 8) + bx / 8 : bx;
    const int gw = vcu * NWAVES + wave, NGW = G * NWAVES;
    (void)args;
#define INP(i) karg_ptr(i)
#define P_x INP(0)
#define P_c INP(1)
#define P_w_ada INP(2)
#define P_b_ada INP(3)
#define P_g1 INP(4)
#define P_w_in INP(5)
#define P_lbl INP(6)
#define P_hg_on INP(7)
#define P_att_on INP(8)
#define P_w_out INP(9)
#define P_g2 INP(10)
#define P_w_gu INP(11)
#define P_w_down INP(12)
#define P_gf INP(13)
#define P_out ((float*)INP(14))
    unsigned char* const ws = (unsigned char*)INP(15);
    gu32* ctl = (gu32*)(ws + WS_CTL);
#define MODP ((float*)(ws + WS_MODP))
#define MOD ((float*)(ws + WS_MOD))
#define LB ((float*)(ws + WS_LB))
#define BIAS2 ((float*)(ws + WS_BIAS2))
#define WIN_T ((bf16*)(ws + WS_WIN))
#define WOUT_T ((bf16*)(ws + WS_WOUT))
#define WGU_T ((bf16*)(ws + WS_WGU))
#define WD_T ((bf16*)(ws + WS_WD))
#define DEC ((float*)(ws + WS_DEC))
#define LSE ((float*)(ws + WS_LSE))
#define SSQ1 ((float*)(ws + WS_SSQ1))
#define XN ((bf16*)(ws + WS_BUFA))
#define A2 ((bf16*)(ws + WS_BUFA))
#define MIXIN ((bf16*)(ws + WS_BUFB))
#define QT ((bf16*)(ws + WS_QT))
#define KT ((bf16*)(ws + WS_KT))
#define VH ((bf16*)(ws + WS_VH))
#define SG ((bf16*)(ws + WS_SG))
#define AQ ((bf16*)(ws + WS_AQ))
#define AK ((bf16*)(ws + WS_AK))
#define AV ((bf16*)(ws + WS_AV))
#define STB ((bf16*)(ws + WS_ST))
#define HID ((bf16*)(ws + WS_HID))
#ifndef ATT_SCAN_UNITS
#define ATT_SCAN_UNITS 8
#endif
#define PHASE_TID() int lane; asm volatile("v_mbcnt_lo_u32_b32 %0, -1, 0\n\tv_mbcnt_hi_u32_b32 %0, -1, %0" : "=&v"(lane)); const int tid = wave * 64 + lane; (void)tid;

    for (int u = threadIdx.x; u < (LDS_BYTES - LDSCTL_OFF) / 4; u += NWAVES * 64) ((LAS unsigned*)(lds + LDSCTL_OFF))[u] = 0u;
    __syncthreads();
    XcdBarrier bar = xcd_barrier_post((unsigned*)(ctl + CW_BAR), MISC + 8);

    {   PHASE_TID();
        LAS float* scr = (LAS float*)(lds + wave * 16384);
        constexpr int I_MOD = 768, I_IN = 16 * (INW / 32), I_OUT = 16 * (D / 32), I_GU = 16 * (NGU / 32), I_DN = (DFF / 64) * (D / 32);
        constexpr int NTASK = I_MOD + I_IN + I_OUT + I_GU + I_DN + 1;
        for (int it = gw; it < NTASK; it += NGW) {
            int r = it;
            if (r < I_MOD) { mod_partial(P_c, P_w_ada, MODP, scr, r, lane); continue; } r -= I_MOD;
            if (r < I_IN) { transpose_item(P_w_in, D, INW, WIN_T, 1, scr, r, lane); continue; } r -= I_IN;
            if (r < I_OUT) { transpose_item(P_w_out, D, D, WOUT_T, 0, scr, r, lane); continue; } r -= I_OUT;
            if (r < I_GU) { transpose_item(P_w_gu, D, NGU, WGU_T, 2, scr, r, lane); continue; } r -= I_GU;
            if (r < I_DN) { transpose_item(P_w_down, DFF, D, WD_T, 0, scr, r, lane); continue; }
#pragma unroll
            for (int i = 0; i < 8; ++i) { const int j = lane + 64 * i; LB[j] = rcp(1.f + ex2((P_lbl[512 + j] - P_lbl[j]) * LOG2E)); }
        }
    }
    xcd_barrier(bar);

    {   PHASE_TID();
        LAS float* ms = (LAS float*)lds; LAS float* sh = ms + D;
        if (tid < 192) { const int idx = bx * 192 + tid; const int b = idx / NMOD, n = idx % NMOD; float v = P_b_ada[n];
#pragma unroll
            for (int ks = 0; ks < 8; ++ks) v += MODP[(size_t)(ks * 8 + b) * NMOD + n];
            MOD[idx] = v; }
        const int rows_per = T / G, row0 = bx * rows_per, b = row0 / S;
#pragma unroll
        for (int i = 0; i < 2; ++i) { const int k = tid + 512 * i; float s1 = P_b_ada[k], c1 = P_b_ada[1024 + k];
#pragma unroll
            for (int ks = 0; ks < 8; ++ks) { s1 += MODP[(size_t)(ks * 8 + b) * NMOD + k]; c1 += MODP[(size_t)(ks * 8 + b) * NMOD + 1024 + k]; }
            ms[k] = P_g1[k] * (1.f + c1); sh[k] = s1; }
        __syncthreads();
        for (int r = wave; r < rows_per; r += NWAVES) {
            const int row = row0 + r; const GAS f32x4* xr = (const GAS f32x4*)(P_x + (size_t)row * D) + lane;
            f32x4 v[4]; float s = 0.f;
#pragma unroll
            for (int j = 0; j < 4; ++j) { v[j] = xr[64 * j]; s += (v[j].x * v[j].x + v[j].y * v[j].y) + (v[j].z * v[j].z + v[j].w * v[j].w); }
            const float rstd = rsq(wsum64(s) * (1.f / D) + EPS);
            GAS unsigned long long* o8 = (GAS unsigned long long*)(XN + (size_t)row * D) + lane;
#pragma unroll
            for (int j = 0; j < 4; ++j) { const f32x4 m4 = *(const LAS f32x4*)(ms + 256 * j + 4 * lane), s4 = *(const LAS f32x4*)(sh + 256 * j + 4 * lane); const f32x4 o = v[j] * rstd * m4 + s4;
                o8[64 * j] = (unsigned long long)pk2(o.x, o.y) | ((unsigned long long)pk2(o.z, o.w) << 32); }
        }
    }
    xcd_barrier(bar);

    {
        pg8::Gemm g{XN, WIN_T, T, INW, D}; pg8::StaticOrder So; So.init(T, INW, G, bx);
        EpiIn E{QT, KT, VH, SG, AQ, AK, AV, DEC, LB};
        pg8::gemm_phase<EpiIn, pg8::StaticOrder, true, true>(lds, g, So, E, wave);
    }
    xcd_barrier(bar);

    if (vcu < 32) {   PHASE_TID();
        hgrn_scan(lds, KT, VH, DEC, STB, vcu, wave, lane);
    }
    {   PHASE_TID();
        constexpr int AS = ATT_SCAN_UNITS, NREST = 6144 - 32 * AS, BASE = NREST / 224, REM = NREST % 224;
        int alo, ahi;
        if (vcu < 32) { alo = vcu * AS; ahi = alo + AS; } else { const int q = vcu - 32; alo = 32 * AS + q * BASE + (q < REM ? q : REM); ahi = alo + BASE + (q < REM ? 1 : 0); }
        attn_units(lds, AQ, AK, AV, ws, LSE, wave, lane, alo, ahi);
    }
    xcd_barrier(bar);

    {   PHASE_TID();
        hgrn_out_units(lds, QT, KT, VH, SG, STB, P_hg_on, MIXIN, wave, lane, vcu * 8, vcu * 8 + 8);
        for (int t = gw; t < T; t += NGW) {
            const int c8 = lane * 8;
            {   const int h = lane >> 3;
                const float l0 = LSE[(size_t)t * 8 + h], l1 = LSE[(size_t)T * 8 + (size_t)t * 8 + h], l2 = LSE[(size_t)2 * T * 8 + (size_t)t * 8 + h];
                const float mx = fmaxf(l0, fmaxf(l1, l2)); float w0 = ex2(l0 - mx), w1 = ex2(l1 - mx), w2 = ex2(l2 - mx); const float inv = rcp(w0 + w1 + w2); w0 *= inv; w1 *= inv; w2 *= inv;
                const v4u a0 = *(const v4u*)((const bf16*)(ws + WS_ATT0) + (size_t)t * 512 + c8), a1 = *(const v4u*)((const bf16*)(ws + WS_ATT1) + (size_t)t * 512 + c8), a2 = *(const v4u*)((const bf16*)(ws + WS_ATT2) + (size_t)t * 512 + c8);
                float a[8];
                a[0] = w0 * bflo(a0.x) + w1 * bflo(a1.x) + w2 * bflo(a2.x); a[1] = w0 * bfhi(a0.x) + w1 * bfhi(a1.x) + w2 * bfhi(a2.x);
                a[2] = w0 * bflo(a0.y) + w1 * bflo(a1.y) + w2 * bflo(a2.y); a[3] = w0 * bfhi(a0.y) + w1 * bfhi(a1.y) + w2 * bfhi(a2.y);
                a[4] = w0 * bflo(a0.z) + w1 * bflo(a1.z) + w2 * bflo(a2.z); a[5] = w0 * bfhi(a0.z) + w1 * bfhi(a1.z) + w2 * bfhi(a2.z);
                a[6] = w0 * bflo(a0.w) + w1 * bflo(a1.w) + w2 * bflo(a2.w); a[7] = w0 * bfhi(a0.w) + w1 * bfhi(a1.w) + w2 * bfhi(a2.w);
                float ss = 0.f;
#pragma unroll
                for (int i = 0; i < 8; ++i) ss += a[i] * a[i];
                const float rstd = rsq(wsum64(ss) * (1.f / 512.f) + EPS);
                const f32x4 n0 = *(const f32x4*)(P_att_on + c8), n1 = *(const f32x4*)(P_att_on + c8 + 4);
#pragma unroll
                for (int i = 0; i < 4; ++i) { a[i] = a[i] * rstd * n0[i]; a[4 + i] = a[4 + i] * rstd * n1[i]; }
                v4u w; w.x = pk2(a[0], a[1]); w.y = pk2(a[2], a[3]); w.z = pk2(a[4], a[5]); w.w = pk2(a[6], a[7]);
                *(v4u*)(MIXIN + (size_t)t * D + 512 + c8) = w; }
        }
        __syncthreads();
        LAS float* sh2 = (LAS float*)lds;
        for (int i = tid; i < 8 * D; i += NWAVES * 64) sh2[i] = MOD[(i >> 10) * NMOD + 3072 + (i & 1023)];
        __syncthreads();
        const int ncol = NGU / G;
        for (int j = wave; j < ncol; j += NWAVES) { const int n = bx * ncol + j;
            const v4u w0 = *(const v4u*)(WGU_T + (size_t)n * D + lane * 16), w1 = *(const v4u*)(WGU_T + (size_t)n * D + lane * 16 + 8);
            const float wv[16] = {bflo(w0.x), bfhi(w0.x), bflo(w0.y), bfhi(w0.y), bflo(w0.z), bfhi(w0.z), bflo(w0.w), bfhi(w0.w), bflo(w1.x), bfhi(w1.x), bflo(w1.y), bfhi(w1.y), bflo(w1.z), bfhi(w1.z), bflo(w1.w), bfhi(w1.w)};
#pragma unroll
            for (int b = 0; b < 8; ++b) { float s = 0.f;
#pragma unroll
                for (int q4 = 0; q4 < 4; ++q4) { const f32x4 sv = *(const LAS f32x4*)(sh2 + b * D + lane * 16 + q4 * 4); s += wv[q4 * 4] * sv[0] + wv[q4 * 4 + 1] * sv[1] + wv[q4 * 4 + 2] * sv[2] + wv[q4 * 4 + 3] * sv[3]; }
                s = wsum64(s); if (lane == 0) BIAS2[b * NGU + n] = s; }
        }
        __syncthreads();
    }
    xcd_barrier(bar);

    {
        pg8::Gemm g{MIXIN, WOUT_T, T, D, D}; pg8::StaticOrder So; So.init(T, D, G, bx);
        EpiOut E{P_x, P_out, A2, SSQ1, MOD, P_g2};
        pg8::gemm_phase<EpiOut, pg8::StaticOrder, true, true>(lds, g, So, E, wave);
    }
    xcd_barrier(bar);

    {
        pg8::Gemm g{A2, WGU_T, T, NGU, D}; pg8::StaticOrder So; So.init(T, NGU, G, bx);
        EpiGU E{HID, SSQ1, BIAS2};
        pg8::gemm_phase<EpiGU, pg8::StaticOrder, true, true>(lds, g, So, E, wave);
    }
    xcd_barrier(bar);

    {
        pg8::Gemm g{HID, WD_T, T, D, DFF}; pg8::StaticOrder So; So.init(T, D, G, bx);
        EpiDown E{P_out, MOD};
        pg8::gemm_phase<EpiDown, pg8::StaticOrder, true, true>(lds, g, So, E, wave);
    }
    xcd_barrier(bar);

    PHASE_TID();
    for (int row = gw; row < T; row += NGW) {
        GAS f32x4* xr = (GAS f32x4*)(P_out + (size_t)row * D) + lane;
        f32x4 v[4]; float s = 0.f;
#pragma unroll
        for (int j = 0; j < 4; ++j) { v[j] = xr[64 * j]; s += (v[j].x * v[j].x + v[j].y * v[j].y) + (v[j].z * v[j].z + v[j].w * v[j].w); }
        const float rstd = rsq(wsum64(s) * (1.f / D) + EPS);
#pragma unroll
        for (int j = 0; j < 4; ++j) { const f32x4 g4 = *(const f32x4*)(P_gf + 256 * j + 4 * lane); xr[64 * j] = v[j] * rstd * g4; }
    }
}
}

extern "C" void kernel_launch(void* const* d_in, const int* in_sizes, int n_in, void* d_out, int out_size, void* d_ws, size_t ws_size, hipStream_t stream) {
    using namespace mk;
    static int grid = 0;
    if (grid == 0) {
        if (n_in != 14 || in_sizes[0] != T * D || out_size != T * D || ws_size < WS_END) { fprintf(stderr, "kernel_launch: unexpected shapes (n_in %d, in0 %d, out %d, ws %zu); nothing launched\n", n_in, n_in > 0 ? in_sizes[0] : -1, out_size, ws_size); grid = -1; return; }
        int dev = 0, cus = 0, per_cu = 0;
        if (hipGetDevice(&dev) != hipSuccess || hipDeviceGetAttribute(&cus, hipDeviceAttributeMultiprocessorCount, dev) != hipSuccess) { grid = -1; return; }
        if (hipFuncSetAttribute((const void*)mk_fwd, hipFuncAttributeMaxDynamicSharedMemorySize, LDS_BYTES) != hipSuccess) { fprintf(stderr, "kernel_launch: hipFuncSetAttribute failed\n"); grid = -1; return; }
        if (hipOccupancyMaxActiveBlocksPerMultiprocessor(&per_cu, (const void*)mk_fwd, NWAVES * 64, LDS_BYTES) != hipSuccess || per_cu < 1) { fprintf(stderr, "kernel_launch: occupancy query says %d blocks per CU\n", per_cu); per_cu = 1; }
        (void)hipGetLastError();
        grid = cus;
        if (grid != 256) { fprintf(stderr, "kernel_launch: this kernel is laid out for a 256-CU device, found %d CUs; nothing launched\n", grid); grid = -1; return; }
    }
    if (grid < 0) return;
    if (hipMemsetAsync((char*)d_ws + WS_CTL, 0, CTL_ZERO_BYTES, stream) != hipSuccess) { fprintf(stderr, "kernel_launch: hipMemsetAsync failed\n"); return; }
    Args a{};
    for (int i = 0; i < 14; ++i) a.in[i] = (const float*)d_in[i];
    a.out = (float*)d_out; a.ws = (unsigned char*)d_ws;
    hipLaunchKernelGGL(mk_fwd, dim3(grid), dim3(NWAVES * 64), LDS_BYTES, stream, a);
    const hipError_t le = hipPeekAtLastError();
    if (le != hipSuccess) fprintf(stderr, "kernel_launch: launch failed: %s\n", hipGetErrorName(le));
}
```

```cpp
#include <hip/hip_runtime.h>
#include <cstdio>
#include <cstdint>
namespace pg8 {
#define PG8_LAS __attribute__((address_space(3)))
typedef unsigned short bf16_t;
typedef short bf16x8 __attribute__((ext_vector_type(8)));
typedef float f32x4 __attribute__((ext_vector_type(4)));
typedef unsigned u32x4 __attribute__((ext_vector_type(4)));
constexpr int BM = 256, BK = 64, HALF = 128, HTB = HALF * BK * 2  , STAGE_BYTES = 8 * HTB, NXCD = 8, WGM = 8;

__host__ __device__ __forceinline__ int lds_byte(int r, int c) { const int st = (r >> 4) * 2 + (c >> 5), rr = r & 15, cc = c & 31, ob = rr * 64 + cc * 2; return st * 1024 + (ob ^ (((ob >> 9) & 1) << 5)); }
__host__ __device__ __forceinline__ void stage_rc(int b, int& R, int& C) { const int st = b / 1024, sb = b % 1024, swz = sb ^ (((sb >> 9) & 1) << 5); R = (st >> 1) * 16 + swz / 64; C = (st & 1) * 32 + (swz % 64) / 2; }
__host__ __device__ __forceinline__ int perm32(int rho) { const int n = rho >> 4, i = rho & 15; return 8 * (i >> 2) + 4 * n + (i & 3); }

struct Unit { int pm, pn; };
struct Gemm { const bf16_t* A; const bf16_t* Bt; int M, N, K; };

struct StaticOrder {
    int nM, nN, nwg, G, c;
    __host__ __device__ void init(int M, int N, int G_, int c_) { nM = M / BM; nN = N / BM; nwg = nM * nN; G = G_; c = c_; }
    __host__ __device__ bool next(int i, Unit& u) const {
        const long L = (long)i * G + c; if (L >= nwg) return false;
        int wgid = (int)L; { const int q = nwg / NXCD, r = nwg % NXCD, xcd = wgid % NXCD, off = wgid / NXCD; wgid = (xcd < r ? xcd * (q + 1) : r * (q + 1) + (xcd - r) * q) + off; }
        const int nig = WGM * nN, gid = wgid / nig, fm = gid * WGM, gsz = (nM - fm) < WGM ? (nM - fm) : WGM;
        u.pm = fm + ((wgid % nig) % gsz); u.pn = (wgid % nig) / gsz; return true;
    }
    __device__ __forceinline__ void a_ready(const Unit&) const {}
    __device__ __forceinline__ void done(const Unit&) const {}
};

__device__ __forceinline__ unsigned cvt_pk_bf16(float lo, float hi) { unsigned r; asm volatile("v_cvt_pk_bf16_f32 %0, %1, %2" : "=v"(r) : "v"(lo), "v"(hi)); return r; }
typedef float f32x2 __attribute__((ext_vector_type(2)));
template <class Epi, class Sched, bool ALIGN_EPI = false, bool SP2 = false>
__device__ __forceinline__ void gemm_phase(PG8_LAS unsigned char* lds, const Gemm g, const Sched& S, const Epi& E, const int wid_in  ) {
    int lane_o; asm volatile("v_mbcnt_lo_u32_b32 %0, -1, 0\n\tv_mbcnt_hi_u32_b32 %0, -1, %0" : "=&v"(lane_o));
    const int wid = wid_in, lane = lane_o, tid = wid * 64 + lane, wr = wid >> 2, wc = wid & 3, fr = lane & 15, fq = lane >> 4;
    const int K = g.K, nt = K / BK;
    unsigned voffA[2], voffB[2];
#pragma unroll
    for (int i = 0; i < 2; ++i) { int R, C; stage_rc(tid * 16 + i * 8192, R, C); const int Rb = Epi::PERM ? ((R & ~31) + perm32(R & 31)) : R;
        voffA[i] = (unsigned)(R * K + C) * 2u; voffB[i] = (unsigned)(Rb * K + C) * 2u; }
    const size_t kstep = (size_t)(BK * 2);
    const size_t hstep = (size_t)HALF * K * 2;
    const size_t tstep = 2 * hstep;
    const unsigned ldsw = (unsigned)wid * 1024u;
    const int aoff = lds_byte(wr * 64 + fr, fq * 8), boff = lds_byte(wc * 32 + fr, fq * 8);
#define PG8_SA(b, h) (((b) * 2 + (h)) * HTB)
#define PG8_SB(b, h) ((4 + (b) * 2 + (h)) * HTB)
#define PG8_STAGE(bufoff, gbase, voff) do { _Pragma("unroll") for (int _i = 0; _i < 2; ++_i) \
        __builtin_amdgcn_global_load_lds((const unsigned*)((const char*)(gbase) + (voff)[_i]), (PG8_LAS unsigned*)(lds + (bufoff) + ldsw + _i * 8192), 16, 0, 0); } while (0)
#define PG8_LDA(dst, b, h) do { _Pragma("unroll") for (int m = 0; m < 4; ++m) _Pragma("unroll") for (int k = 0; k < 2; ++k) dst[m][k] = *(const PG8_LAS bf16x8*)(lds + PG8_SA(b, h) + aoff + m * 2048 + k * 1024); } while (0)
#define PG8_LDB(dst, b, h) do { _Pragma("unroll") for (int n = 0; n < 2; ++n) _Pragma("unroll") for (int k = 0; k < 2; ++k) dst[n][k] = *(const PG8_LAS bf16x8*)(lds + PG8_SB(b, h) + boff + n * 2048 + k * 1024); } while (0)
#define PG8_MMA(ai, bj, At, Bt) do { __builtin_amdgcn_s_setprio(1); _Pragma("unroll") for (int m = 0; m < 4; ++m) _Pragma("unroll") for (int n = 0; n < 2; ++n) _Pragma("unroll") for (int k = 0; k < 2; ++k) \
        acc[ai][bj][m][n] = __builtin_amdgcn_mfma_f32_16x16x32_bf16(Bt[n][k], At[m][k], acc[ai][bj][m][n], 0, 0, 0); __builtin_amdgcn_s_setprio(0); } while (0)
#define PG8_WAIT_V(n) asm volatile("s_waitcnt vmcnt(" #n ")" ::: "memory")
#define PG8_WAIT_L(n) asm volatile("s_waitcnt lgkmcnt(" #n ")" ::: "memory")
#define PG8_BAR __builtin_amdgcn_s_barrier()
#define PG8_SCHED __builtin_amdgcn_sched_barrier(0)
    Unit cur, nxt; int ui = 0;
    if (!S.next(0, cur)) return;
    f32x4 acc[2][2][4][2];
#pragma unroll
    for (int a = 0; a < 2; ++a)
#pragma unroll
        for (int b = 0; b < 2; ++b)
#pragma unroll
            for (int m = 0; m < 4; ++m)
#pragma unroll
                for (int n = 0; n < 2; ++n) acc[a][b][m][n] = (f32x4){0.f, 0.f, 0.f, 0.f};
    bf16x8 At[4][2], B0[2][2], B1[2][2];
    const char* cA = (const char*)g.A + (size_t)cur.pm * tstep; const char* cB = (const char*)g.Bt + (size_t)cur.pn * tstep;
    S.a_ready(cur);
    if constexpr (SP2) {
        PG8_STAGE(PG8_SB(0, 0), cB, voffB); PG8_STAGE(PG8_SB(0, 1), cB + hstep, voffB); PG8_STAGE(PG8_SA(0, 0), cA, voffA); PG8_STAGE(PG8_SA(0, 1), cA + hstep, voffA);
        if (wr == 1) PG8_BAR;
        PG8_WAIT_V(2); PG8_BAR;
        PG8_STAGE(PG8_SB(1, 0), cB + kstep, voffB); PG8_STAGE(PG8_SA(1, 0), cA + kstep, voffA); PG8_STAGE(PG8_SB(1, 1), cB + hstep + kstep, voffB);
        PG8_WAIT_V(6); PG8_BAR;
    } else {
        PG8_STAGE(PG8_SB(0, 0), cB, voffB); PG8_STAGE(PG8_SA(0, 0), cA, voffA); PG8_STAGE(PG8_SB(0, 1), cB + hstep, voffB); PG8_STAGE(PG8_SA(0, 1), cA + hstep, voffA);
        if (wr == 1) PG8_BAR;
        PG8_WAIT_V(4); PG8_BAR;
        PG8_STAGE(PG8_SB(1, 0), cB + kstep, voffB); PG8_STAGE(PG8_SA(1, 0), cA + kstep, voffA); PG8_STAGE(PG8_SB(1, 1), cB + hstep + kstep, voffB);
        PG8_WAIT_V(6); PG8_BAR;
    }
    for (;;) {
        const bool has_next = S.next(ui + 1, nxt);
        const char* nA = has_next ? (const char*)g.A + (size_t)nxt.pm * tstep : cA; const char* nB = has_next ? (const char*)g.Bt + (size_t)nxt.pn * tstep : cB;
        for (int t = 0; t < nt; t += 2) {
            const bool last = (t == nt - 2);
            const char* a1 = cA + (size_t)(t + 1) * kstep;
            const char* a2 = last ? nA : cA + (size_t)(t + 2) * kstep; const char* b2 = last ? nB : cB + (size_t)(t + 2) * kstep;
            const char* a3 = a2 + kstep; const char* b3 = b2 + kstep;
            if (last && has_next) S.a_ready(nxt);
            if constexpr (SP2) {
            PG8_LDB(B0, 0, 0); PG8_LDB(B1, 0, 1); PG8_SCHED; PG8_LDA(At, 0, 0); PG8_STAGE(PG8_SA(1, 1), a1 + hstep, voffA);
            PG8_WAIT_V(8); PG8_WAIT_L(0); PG8_BAR; PG8_MMA(0, 0, At, B0); PG8_MMA(0, 1, At, B1); PG8_BAR; PG8_SCHED;
            PG8_LDA(At, 0, 1); PG8_STAGE(PG8_SB(0, 0), b2, voffB); PG8_STAGE(PG8_SB(0, 1), b2 + hstep, voffB); PG8_STAGE(PG8_SA(0, 0), a2, voffA);
            PG8_WAIT_V(8); PG8_WAIT_L(0); PG8_BAR; PG8_MMA(1, 0, At, B0); PG8_MMA(1, 1, At, B1); PG8_BAR; PG8_SCHED;
            PG8_LDB(B0, 1, 0); PG8_LDB(B1, 1, 1); PG8_SCHED; PG8_LDA(At, 1, 0); PG8_STAGE(PG8_SA(0, 1), a2 + hstep, voffA);
            PG8_WAIT_V(8); PG8_WAIT_L(0); PG8_BAR; PG8_MMA(0, 0, At, B0); PG8_MMA(0, 1, At, B1); PG8_BAR; PG8_SCHED;
            PG8_LDA(At, 1, 1); PG8_STAGE(PG8_SB(1, 0), b3, voffB); PG8_STAGE(PG8_SB(1, 1), b3 + hstep, voffB); PG8_STAGE(PG8_SA(1, 0), a3, voffA);
            PG8_WAIT_V(8); PG8_WAIT_L(0); PG8_BAR; PG8_MMA(1, 0, At, B0); PG8_MMA(1, 1, At, B1); PG8_BAR; PG8_SCHED;
            } else {
            PG8_LDB(B0, 0, 0); PG8_SCHED; PG8_LDA(At, 0, 0); PG8_STAGE(PG8_SA(1, 1), a1 + hstep, voffA);
            PG8_WAIT_L(8); PG8_BAR; PG8_WAIT_L(0); PG8_MMA(0, 0, At, B0); PG8_BAR; PG8_SCHED;
            PG8_LDB(B1, 0, 1); PG8_STAGE(PG8_SB(0, 0), b2, voffB);
            PG8_BAR; PG8_WAIT_L(0); PG8_MMA(0, 1, At, B1); PG8_BAR;
            PG8_LDA(At, 0, 1); PG8_STAGE(PG8_SA(0, 0), a2, voffA);
            PG8_BAR; PG8_WAIT_L(0); PG8_MMA(1, 0, At, B0); PG8_BAR; PG8_SCHED;
            PG8_STAGE(PG8_SB(0, 1), b2 + hstep, voffB);
            PG8_WAIT_V(6); PG8_BAR; PG8_MMA(1, 1, At, B1); PG8_BAR;
            PG8_LDB(B0, 1, 0); PG8_SCHED; PG8_LDA(At, 1, 0); PG8_STAGE(PG8_SA(0, 1), a2 + hstep, voffA);
            PG8_WAIT_L(8); PG8_BAR; PG8_WAIT_L(0); PG8_MMA(0, 0, At, B0); PG8_BAR; PG8_SCHED;
            PG8_LDB(B1, 1, 1); PG8_STAGE(PG8_SB(1, 0), b3, voffB);
            PG8_BAR; PG8_WAIT_L(0); PG8_MMA(0, 1, At, B1); PG8_BAR;
            PG8_LDA(At, 1, 1); PG8_STAGE(PG8_SA(1, 0), a3, voffA);
            PG8_BAR; PG8_WAIT_L(0); PG8_MMA(1, 0, At, B0); PG8_BAR; PG8_SCHED;
            PG8_STAGE(PG8_SB(1, 1), b3 + hstep, voffB);
            PG8_WAIT_V(6); PG8_BAR; PG8_MMA(1, 1, At, B1); PG8_BAR;
            }
        }
        if constexpr (ALIGN_EPI) { if (wr == 0) PG8_BAR; }
        if constexpr (!Epi::AFTER_DRAIN) { E(acc, cur, wr, wc, fr, fq); S.done(cur); }
        if (!has_next) break;
#pragma unroll
        for (int a = 0; a < 2; ++a)
#pragma unroll
            for (int b = 0; b < 2; ++b)
#pragma unroll
                for (int m = 0; m < 4; ++m)
#pragma unroll
                    for (int n = 0; n < 2; ++n) acc[a][b][m][n] = (f32x4){0.f, 0.f, 0.f, 0.f};
        cur = nxt; cA = nA; cB = nB; ++ui;
        if constexpr (ALIGN_EPI) { if (wr == 1) PG8_BAR; }
    }
    PG8_WAIT_V(0);
    if constexpr (!ALIGN_EPI) { if (wr == 0) PG8_BAR; }
    PG8_BAR;
    if constexpr (Epi::AFTER_DRAIN) { E.fused(acc, cur, wr, wc, fr, fq, lds, wid, lane); S.done(cur); }
#undef PG8_SA
#undef PG8_SB
#undef PG8_STAGE
#undef PG8_LDA
#undef PG8_LDB
#undef PG8_MMA
#undef PG8_WAIT_V
#undef PG8_WAIT_L
#undef PG8_BAR
#undef PG8_SCHED
}
}
#define GAS __attribute__((address_space(1)))
#define LAS __attribute__((address_space(3)))
typedef unsigned short bf16;
typedef unsigned v4u __attribute__((ext_vector_type(4)));
typedef float f32x4 __attribute__((ext_vector_type(4)));
typedef short bf16x8 __attribute__((ext_vector_type(8)));
typedef GAS unsigned gu32;
typedef GAS unsigned long long gu64;
#define RLX_AGENT __ATOMIC_RELAXED, __HIP_MEMORY_SCOPE_AGENT
#define LDS_WAIT() asm volatile("s_waitcnt lgkmcnt(0)" ::: "memory")
#define VM_WAIT() asm volatile("s_waitcnt vmcnt(0)" ::: "memory")
__device__ __forceinline__ unsigned long long rt() { return __builtin_amdgcn_s_memrealtime(); }
__device__ __forceinline__ unsigned f2bf(float f) { unsigned u = __builtin_bit_cast(unsigned, f); return (u + 0x7fffu + ((u >> 16) & 1u)) >> 16; }
__device__ __forceinline__ unsigned pk2(float lo, float hi) { return f2bf(lo) | (f2bf(hi) << 16); }
#define XB_TMO      128
#define XB_XCNT(j)  (256  + 64 * (j))
#define XB_XSUB(j)  (1280 + 64 * (j))
#define XB_XGEN(j)  (2304 + 64 * (j))
#define XB_TOP      3328
#define XB_TOPGEN   3392
#define XCD_BAR_WORDS 3456
#define XB_SPIN_CAP (1u << 24)

__device__ __forceinline__ unsigned xb_ld(unsigned* p)              { return __hip_atomic_load(p, __ATOMIC_RELAXED, __HIP_MEMORY_SCOPE_AGENT); }
__device__ __forceinline__ unsigned xb_add(unsigned* p, unsigned v) { return __hip_atomic_fetch_add(p, v, __ATOMIC_RELAXED, __HIP_MEMORY_SCOPE_AGENT); }
__device__ __forceinline__ unsigned xb_xcc_id() { return (unsigned)__builtin_amdgcn_s_getreg((3 << 11) | 20) & 0xFu; }
#define XB_SPIN(cond, bar) do { unsigned _sp = 0; while (cond) { __builtin_amdgcn_s_sleep(1); \
    if ((++_sp & 255u) == 0u) { if (xb_ld(&(bar)[XB_TMO])) break; if (_sp > XB_SPIN_CAP) { atomicAdd(&(bar)[XB_TMO], 1u); break; } } } } while (0)

struct XcdBarrier {
    unsigned* bar; unsigned x;
    volatile LAS unsigned* st;
};

__device__ __forceinline__ XcdBarrier xcd_barrier_post(unsigned* bar, volatile LAS unsigned* st) {
    XcdBarrier b; b.bar = bar; b.x = xb_xcc_id(); b.st = st;
    if (threadIdx.x == 0) (void)xb_add(&bar[XB_XCNT(b.x)], 1u);
    return b;
}
__device__ __forceinline__ void xcd_barrier_complete(unsigned* bar, unsigned x, unsigned& nloc, unsigned& nx) {
    const unsigned G = gridDim.x * gridDim.y * gridDim.z;
    unsigned sum, cnt, mine, sp = 0u;
    for (;;) {
        sum = 0u; cnt = 0u; mine = 0u;
#pragma unroll
        for (unsigned j = 0; j < 16; ++j) { const unsigned c = xb_ld(&bar[XB_XCNT(j)]); sum += c; cnt += (c > 0u) ? 1u : 0u; mine = (j == x) ? c : mine; }
        if (sum == G) break;
        __builtin_amdgcn_s_sleep(1);
        if ((++sp & 255u) == 0u) { if (xb_ld(&bar[XB_TMO])) break; if (sp > XB_SPIN_CAP) { atomicAdd(&bar[XB_TMO], 1u); break; } }
    }
    nloc = mine > 0u ? mine : 1u; nx = cnt > 0u ? cnt : 1u;
}

__device__ __forceinline__ void xcd_barrier(const XcdBarrier& b) {
    asm volatile("s_waitcnt vmcnt(0)" ::: "memory");
    __syncthreads();
    if (threadIdx.x == 0) {
        unsigned* bar = b.bar;
        __builtin_amdgcn_s_waitcnt(0);
        unsigned nloc = b.st[0], nx = b.st[1];
        if (nloc == 0u) { xcd_barrier_complete(bar, b.x, nloc, nx); b.st[0] = nloc; b.st[1] = nx; }
        const unsigned old = xb_add(&bar[XB_XSUB(b.x)], 1u);
        const unsigned gen = old / nloc;
        if (old + 1u == (gen + 1u) * nloc) {
            __builtin_amdgcn_fence(__ATOMIC_RELEASE, "agent");
            asm volatile("s_waitcnt vmcnt(0)" ::: "memory");
            const unsigned og = xb_add(&bar[XB_TOP], 1u);
            const unsigned tg = og / nx;
            if (og + 1u == (tg + 1u) * nx) xb_add(&bar[XB_TOPGEN], 1u);
            else XB_SPIN(xb_ld(&bar[XB_TOPGEN]) == tg, bar);
            __builtin_amdgcn_fence(__ATOMIC_ACQUIRE, "agent");
            xb_add(&bar[XB_XGEN(b.x)], 1u);
            asm volatile("s_waitcnt vmcnt(0)" ::: "memory");
        } else {
            XB_SPIN(xb_ld(&bar[XB_XGEN(b.x)]) == gen, bar);
            __builtin_amdgcn_fence(__ATOMIC_ACQUIRE, "agent");
            asm volatile("s_waitcnt vmcnt(0)" ::: "memory");
        }
    }
    __syncthreads();
}
namespace mk {
using pg8::f32x4; using pg8::Unit; using pg8::bf16_t; using pg8::u32x4; using pg8::cvt_pk_bf16;
typedef unsigned u32x2 __attribute__((ext_vector_type(2)));
constexpr int B = 8, S = 4096, D = 1024, T = B * S, INW = 3584, DFF = 2816, NMOD = 6144, NGU = 2 * DFF;
constexpr float EPS = 1e-6f, LOG2E = 1.4426950408889634f, QSCALE = 0.125f * 1.4426950408889634f;
#define EPI_LANES() int lane_; asm volatile("v_mbcnt_lo_u32_b32 %0, -1, 0\n\tv_mbcnt_hi_u32_b32 %0, -1, %0" : "=&v"(lane_)); const int wr = wr_, wc = wc_, fr = lane_ & 15, fq = lane_ >> 4; (void)fr_; (void)fq_;
template <int CTRL> __device__ __forceinline__ float dpp_mov0(float v) { return __int_as_float(__builtin_amdgcn_update_dpp(0, __float_as_int(v), CTRL, 0xF, 0xF, false)); }
__device__ __forceinline__ float row_scan16(float s) { s += dpp_mov0<0x111>(s); s += dpp_mov0<0x112>(s); s += dpp_mov0<0x114>(s); s += dpp_mov0<0x118>(s); return s; }
__device__ __forceinline__ float row_sum16(float s) { s += dpp_mov0<0x128>(s); s += dpp_mov0<0x124>(s); s += dpp_mov0<0x122>(s); s += dpp_mov0<0x121>(s); return s; }
__device__ __forceinline__ float ex2(float x) { return __builtin_amdgcn_exp2f(x); }
__device__ __forceinline__ float lg2(float x) { return __builtin_amdgcn_logf(x); }
__device__ __forceinline__ float rcp(float x) { return __builtin_amdgcn_rcpf(x); }
__device__ __forceinline__ float rsq(float x) { return __builtin_amdgcn_rsqf(x); }
__device__ __forceinline__ float silu(float x) { return x * rcp(1.f + ex2(-x * LOG2E)); }
typedef short bf16x8 __attribute__((ext_vector_type(8)));
typedef float f32x2c __attribute__((ext_vector_type(2))); typedef __bf16 bf16x2c __attribute__((ext_vector_type(2)));
__device__ __forceinline__ unsigned pk2r(float lo, float hi) { const f32x2c v = {lo, hi}; return __builtin_bit_cast(unsigned, __builtin_convertvector(v, bf16x2c)); }
__device__ __forceinline__ float bf2f(unsigned short h) { return __uint_as_float(((unsigned)h) << 16); }
__device__ __forceinline__ float bflo(unsigned w) { return __uint_as_float(w << 16); }
__device__ __forceinline__ float bfhi(unsigned w) { return __uint_as_float(w & 0xffff0000u); }

struct EpiIn {
    static constexpr bool PERM = true, AFTER_DRAIN = false;
    bf16_t *QT, *KT, *VH, *SG, *AQ, *AK, *AV; float* DEC; const float* lb;
    __device__ __forceinline__ void operator()(f32x4 (&acc)[2][2][4][2], const Unit& u, int wr_, int wc_, int fr_, int fq_) const {
        EPI_LANES();
        const int pn = u.pn; const unsigned row0 = (unsigned)(u.pm * 256 + wr * 64 + fr);
#ifndef NO_HGRN_EPI
        if (pn < 4) {
            const int cb = pn * 128 + wc * 32 + 8 * fq;
            const f32x4 l0 = *(const f32x4*)(lb + cb), l1 = *(const f32x4*)(lb + cb + 4);
#pragma unroll
            for (int ai = 0; ai < 2; ++ai) {
                const unsigned chunk = (unsigned)(u.pm * 4 + ai * 2 + wr);
#pragma unroll
                for (int n = 0; n < 2; ++n) {
                    float dl[4];
#pragma unroll
                    for (int j = 0; j < 4; ++j) {
                        const float lbv = n == 0 ? l0[j] : l1[j], omlb = 1.f - lbv;
                        float lgv[4], b2[4]; float carry = 0.f;
#pragma unroll
                        for (int m = 0; m < 4; ++m) { const float e = ex2(-acc[ai][1][m][n][j] * LOG2E), sg = rcp(1.f + e); lgv[m] = lg2(lbv + omlb * sg); acc[ai][1][m][n][j] = omlb * (e * sg); }
#pragma unroll
                        for (int m = 0; m < 4; ++m) { const float s = row_scan16(lgv[m]), tot = row_sum16(lgv[m]); b2[m] = carry + s; carry += tot; }
                        dl[j] = ex2(carry);
#pragma unroll
                        for (int m = 0; m < 4; ++m) { acc[ai][0][m][n][j] = silu(acc[ai][0][m][n][j]) * ex2(b2[m]); acc[ai][1][m][n][j] *= ex2(-b2[m]); }
                        __builtin_amdgcn_sched_barrier(0);
                    }
                    *(f32x4*)(DEC + (chunk * 512u + (unsigned)(cb + 4 * n))) = (f32x4){dl[0], dl[1], dl[2], dl[3]};
#pragma unroll
                    for (int m = 0; m < 4; ++m) { const unsigned off = (row0 + ai * 128 + m * 16) * 512u + (unsigned)(cb + 4 * n);
                        const f32x4 q = acc[ai][0][m][n], k = acc[ai][1][m][n];
                        u32x2 w; w.x = pk2r(q[0], q[1]); w.y = pk2r(q[2], q[3]); *(u32x2*)(QT + off) = w;
                        u32x2 kw; kw.x = pk2r(k[0], k[1]); kw.y = pk2r(k[2], k[3]); *(u32x2*)(KT + off) = kw; }
                    __builtin_amdgcn_sched_barrier(0);
                }
            }
        } else
#endif
        {
            const int g = (pn - 4) >> 1; bf16_t* base = g == 0 ? VH : g == 1 ? SG : g == 2 ? AQ : g == 3 ? AK : AV;
            const unsigned col0 = (unsigned)(((pn - 4) & 1) * 256 + wc * 32 + 8 * fq);
#pragma unroll
            for (int ai = 0; ai < 2; ++ai)
#pragma unroll
                for (int m = 0; m < 4; ++m) { bf16_t* rowp = base + ((row0 + ai * 128 + m * 16) * 512u + col0);
#pragma unroll
                    for (int bj = 0; bj < 2; ++bj) { f32x4 v0 = acc[ai][bj][m][0], v1 = acc[ai][bj][m][1];
                        if (g == 1) {
#pragma unroll
                            for (int j = 0; j < 4; ++j) { v0[j] = silu(v0[j]); v1[j] = silu(v1[j]); } }
                        if (g == 2) { v0 = v0 * QSCALE; v1 = v1 * QSCALE; }
                        u32x4 w; w.x = pk2r(v0[0], v0[1]); w.y = pk2r(v0[2], v0[3]); w.z = pk2r(v1[0], v1[1]); w.w = pk2r(v1[2], v1[3]);
                        *(u32x4*)(rowp + bj * 128) = w; } }
        }
    }
};

struct EpiOut {
    static constexpr bool PERM = false, AFTER_DRAIN = false;
    const float* x; float* x1; bf16_t* A2; float* ssq; const float* mod; const float* g2;
    __device__ __forceinline__ void operator()(const f32x4 (&acc)[2][2][4][2], const Unit& u, int wr_, int wc_, int fr_, int fq_) const {
        EPI_LANES();
        const int b = u.pm >> 4, col0 = u.pn * 256 + wc * 32 + 4 * fq, rowb = u.pm * 256 + wr * 64 + fr; const float* modb = mod + b * NMOD;
        float ssr[2][4];
#pragma unroll
        for (int ai = 0; ai < 2; ++ai)
#pragma unroll
            for (int m = 0; m < 4; ++m) ssr[ai][m] = 0.f;
#pragma unroll
        for (int bj = 0; bj < 2; ++bj)
#pragma unroll
            for (int n = 0; n < 2; ++n) { const int c = col0 + bj * 128 + n * 16;
                const f32x4 gate = *(const f32x4*)(modb + 2048 + c), sc2 = *(const f32x4*)(modb + 4096 + c), gg = *(const f32x4*)(g2 + c); const f32x4 mul = gg * (sc2 + 1.0f);
#pragma unroll
                for (int ai = 0; ai < 2; ++ai)
#pragma unroll
                    for (int m = 0; m < 4; ++m) { const size_t off = (size_t)(rowb + ai * 128 + m * 16) * D + c;
                        const f32x4 v = *(const f32x4*)(x + off) + gate * acc[ai][bj][m][n]; *(f32x4*)(x1 + off) = v;
                        ssr[ai][m] += (v[0] * v[0] + v[1] * v[1]) + (v[2] * v[2] + v[3] * v[3]);
                        const f32x4 a = v * mul; u32x2 w; w.x = pk2r(a[0], a[1]); w.y = pk2r(a[2], a[3]); *(u32x2*)(A2 + off) = w; } }
#pragma unroll
        for (int ai = 0; ai < 2; ++ai)
#pragma unroll
            for (int m = 0; m < 4; ++m) { float s = ssr[ai][m]; s += __shfl_xor(s, 16); s += __shfl_xor(s, 32);
                if (fq == 0) ssq[(size_t)(rowb + ai * 128 + m * 16) * 16 + u.pn * 4 + wc] = s; }
    }
};

struct EpiGU {
    static constexpr bool PERM = true, AFTER_DRAIN = false;
    bf16_t* HID; const float* ssq; const float* bias2;
    __device__ __forceinline__ void operator()(const f32x4 (&acc)[2][2][4][2], const Unit& u, int wr_, int wc_, int fr_, int fq_) const {
        EPI_LANES();
        const int b = u.pm >> 4, rowb = u.pm * 256 + wr * 64 + fr; const float* bb = bias2 + b * NGU + u.pn * 256 + wc * 32 + 8 * fq;
        const f32x4 ba0 = *(const f32x4*)(bb), ba1 = *(const f32x4*)(bb + 4), bu0 = *(const f32x4*)(bb + 128), bu1 = *(const f32x4*)(bb + 132);
#pragma unroll
        for (int ai = 0; ai < 2; ++ai)
#pragma unroll
            for (int m = 0; m < 4; ++m) { const int row = rowb + ai * 128 + m * 16; const f32x4* sp = (const f32x4*)(ssq + (size_t)row * 16);
                const f32x4 s0 = sp[0], s1 = sp[1], s2 = sp[2], s3 = sp[3]; const f32x4 st = (s0 + s1) + (s2 + s3);
                const float rstd = rsq(((st[0] + st[1]) + (st[2] + st[3])) * (1.0f / D) + EPS);
                const f32x4 a0 = acc[ai][0][m][0] * rstd + ba0, a1 = acc[ai][0][m][1] * rstd + ba1, u0 = acc[ai][1][m][0] * rstd + bu0, u1 = acc[ai][1][m][1] * rstd + bu1;
                float h[8];
#pragma unroll
                for (int j = 0; j < 4; ++j) { h[j] = silu(a0[j]) * u0[j]; h[4 + j] = silu(a1[j]) * u1[j]; }
                u32x4 w; w.x = pk2r(h[0], h[1]); w.y = pk2r(h[2], h[3]); w.z = pk2r(h[4], h[5]); w.w = pk2r(h[6], h[7]);
                *(u32x4*)(HID + (size_t)row * DFF + u.pn * 128 + wc * 32 + 8 * fq) = w; }
    }
};

struct EpiDown {
    static constexpr bool PERM = false, AFTER_DRAIN = false;
    float* xio; const float* mod;
    __device__ __forceinline__ void operator()(const f32x4 (&acc)[2][2][4][2], const Unit& u, int wr_, int wc_, int fr_, int fq_) const {
        EPI_LANES();
        const int b = u.pm >> 4, col0 = u.pn * 256 + wc * 32 + 4 * fq, rowb = u.pm * 256 + wr * 64 + fr; const float* modb = mod + b * NMOD;
#pragma unroll
        for (int bj = 0; bj < 2; ++bj)
#pragma unroll
            for (int n = 0; n < 2; ++n) { const int c = col0 + bj * 128 + n * 16; const f32x4 gate = *(const f32x4*)(modb + 5120 + c);
#pragma unroll
                for (int ai = 0; ai < 2; ++ai)
#pragma unroll
                    for (int m = 0; m < 4; ++m) { const size_t off = (size_t)(rowb + ai * 128 + m * 16) * D + c; *(f32x4*)(xio + off) = *(const f32x4*)(xio + off) + gate * acc[ai][bj][m][n]; } }
    }
};
}
namespace mk {
constexpr int NWAVES = 8;
constexpr size_t MiB = 1u << 20;
constexpr size_t WS_CTL = 0, CTL_ZERO_BYTES = 64 * 1024;
constexpr size_t WS_MODP = 168 * MiB;
constexpr size_t WS_MOD = 3 * MiB, WS_LB = WS_MOD + 256 * 1024, WS_BIAS2 = WS_MOD + 512 * 1024;
constexpr size_t WS_WIN = 4 * MiB, WS_WOUT = 11 * MiB, WS_WGU = 13 * MiB, WS_WD = 24 * MiB;
constexpr size_t WS_DEC = 30 * MiB, WS_LSE = 31 * MiB, WS_SSQ1 = 34 * MiB;
constexpr size_t WS_BUFA = 40 * MiB;
constexpr size_t WS_BUFB = 104 * MiB;
constexpr size_t WS_R = 168 * MiB;
constexpr size_t WS_QT = WS_R, WS_KT = WS_R + 32 * MiB, WS_VH = WS_R + 64 * MiB, WS_SG = WS_R + 96 * MiB, WS_AQ = WS_R + 128 * MiB, WS_AK = WS_R + 160 * MiB, WS_AV = WS_R + 192 * MiB;
constexpr size_t WS_ST = WS_BUFA;
constexpr size_t WS_ATT0 = WS_R + 224 * MiB, WS_ATT1 = WS_R + 256 * MiB, WS_ATT2 = WS_R + 288 * MiB;
constexpr size_t WS_HID = WS_R;
constexpr size_t WS_END = WS_R + 320 * MiB;
constexpr int CW_BAR = 4096;
constexpr int RING_BYTES = 131072, LDS_BYTES = 163840, LDSCTL_OFF = LDS_BYTES - 512, MISC_OFF = LDSCTL_OFF + 320;

__device__ __forceinline__ const float* karg_ptr(int i) {
    asm volatile("" : "+s"(i));
    typedef const float* cfp;
    const __attribute__((address_space(4))) cfp* ka = (const __attribute__((address_space(4))) cfp*)__builtin_amdgcn_kernarg_segment_ptr();
    return ka[i];
}

__device__ __forceinline__ void transpose_item(const float* W, int K, int N, bf16* WT, int mode, LAS float* scr, int item, int lane) {
    const int nblk = N / 32, kb = item / nblk, nb = item % nblk, k0 = 64 * kb, n0 = 32 * nb;
    int r0 = n0;
    if (mode == 1) { if (n0 < 512) r0 = (n0 >> 7) * 256 + (n0 & 127); else if (n0 < 1024) r0 = ((n0 - 512) >> 7) * 256 + 128 + (n0 & 127); }
    if (mode == 2) { if (n0 < DFF) r0 = (n0 >> 7) * 256 + (n0 & 127); else r0 = ((n0 - DFF) >> 7) * 256 + 128 + ((n0 - DFF) & 127); }
    float wv[32];
#pragma unroll
    for (int i = 0; i < 32; ++i) wv[i] = W[(size_t)(k0 + 2 * i + (lane >> 5)) * N + n0 + (lane & 31)];
#pragma unroll
    for (int i = 0; i < 32; ++i) scr[(2 * i + (lane >> 5)) * 33 + (lane & 31)] = wv[i];
    LDS_WAIT(); asm volatile("" ::: "memory");
    const int c = lane & 7;
#pragma unroll
    for (int j = 0; j < 4; ++j) { const int n = (lane >> 3) + 8 * j; const LAS float* s = scr + (8 * c) * 33 + n;
        v4u o; o.x = pk2(s[0 * 33], s[1 * 33]); o.y = pk2(s[2 * 33], s[3 * 33]); o.z = pk2(s[4 * 33], s[5 * 33]); o.w = pk2(s[6 * 33], s[7 * 33]);
        *(GAS v4u*)(WT + (size_t)(r0 + n) * K + k0 + 8 * c) = o; }
    LDS_WAIT(); asm volatile("" ::: "memory");
}
__device__ __forceinline__ void mod_partial(const float* Pc, const float* Pw_ada, float* modp, LAS float* scr, int it, int lane) {
    const int cg = it % 96, ks = it / 96, n = cg * 64 + lane;
    const float* wp = Pw_ada + (size_t)(ks * 64) * NMOD + n;
    float w[64];
#pragma unroll
    for (int kk = 0; kk < 64; ++kk) w[kk] = wp[(size_t)kk * NMOD];
#pragma unroll
    for (int i = 0; i < 8; ++i) { const int idx = i * 64 + lane, kk = idx & 63, b = idx >> 6; scr[kk * 8 + b] = silu(Pc[b * D + ks * 64 + kk]); }
    LDS_WAIT(); asm volatile("" ::: "memory");
    float acc[8];
#pragma unroll
    for (int b = 0; b < 8; ++b) acc[b] = 0.f;
#pragma unroll
    for (int kk = 0; kk < 64; ++kk) { const f32x4 c0 = *(const LAS f32x4*)(scr + kk * 8), c1 = *(const LAS f32x4*)(scr + kk * 8 + 4);
        acc[0] += c0[0] * w[kk]; acc[1] += c0[1] * w[kk]; acc[2] += c0[2] * w[kk]; acc[3] += c0[3] * w[kk]; acc[4] += c1[0] * w[kk]; acc[5] += c1[1] * w[kk]; acc[6] += c1[2] * w[kk]; acc[7] += c1[3] * w[kk]; }
#pragma unroll
    for (int b = 0; b < 8; ++b) modp[(size_t)(ks * 8 + b) * NMOD + n] = acc[b];
    LDS_WAIT(); asm volatile("" ::: "memory");
}
__device__ __forceinline__ float wsum64(float v) {
#pragma unroll
    for (int o = 1; o < 64; o <<= 1) v += __shfl_xor(v, o);
    return v;
}
__device__ __forceinline__ float wmax64(float v) {
#pragma unroll
    for (int o = 1; o < 64; o <<= 1) v = fmaxf(v, __shfl_xor(v, o));
    return v;
}

typedef short s16x4v __attribute__((ext_vector_type(4)));
#define LBAR() asm volatile("s_waitcnt lgkmcnt(0)\n\ts_barrier" ::: "memory")
#define TOPBAR() asm volatile("s_waitcnt vmcnt(0) lgkmcnt(0)\n\ts_barrier" ::: "memory")
#define TOUCH(x) asm volatile("" : "+v"(x))
__device__ __forceinline__ void glds16(const void* gsrc, unsigned lds_dst) { unsigned keep;
    asm volatile("s_mov_b32 %0, m0\n\ts_mov_b32 m0, %2\n\ts_nop 0\n\tglobal_load_lds_dwordx4 %1, off\n\ts_mov_b32 m0, %0" : "=&s"(keep) : "v"(gsrc), "s"(lds_dst) : "memory"); }
__device__ __forceinline__ void glds4(const void* gsrc, unsigned lds_dst) { unsigned keep;
    asm volatile("s_mov_b32 %0, m0\n\ts_mov_b32 m0, %2\n\ts_nop 0\n\tglobal_load_lds_dword %1, off\n\ts_mov_b32 m0, %0" : "=&s"(keep) : "v"(gsrc), "s"(lds_dst) : "memory"); }
__device__ __forceinline__ unsigned lds_addr(const LAS unsigned char* p) { return (unsigned)(size_t)p; }
template <int SW> __device__ __forceinline__ int swz(int R) { return SW == 0 ? (R & 15) : SW == 1 ? (((R & 3) << 1) | (((R >> 3) & 1) << 3)) : ((R & 7) << 1); }
template <int SW> __device__ __forceinline__ void tile_dma(LAS unsigned char* lds, int to, const bf16* src, size_t tok0, int col0, int wave, int lane) {
#pragma unroll
    for (int pi = 0; pi < 2; ++pi) { const int piece = wave + 8 * pi, R = 4 * piece + (lane >> 4); const int gch = (lane & 15) ^ swz<SW>(R);
        glds16(src + (tok0 + R) * 512 + col0 + gch * 8, (unsigned)__builtin_amdgcn_readfirstlane(lds_addr(lds) + to + piece * 1024)); }
}
template <int SW> __device__ __forceinline__ bf16x8 tr_frag(const LAS unsigned char* tile, int r0a, int r0b, int c0, int i16) {
    const int q = i16 >> 2, ch = (c0 >> 3) + ((i16 & 3) >> 1), bo = (i16 & 1) * 8; const int Ra = r0a + q, Rb = r0b + q;
    const s16x4v va = __builtin_amdgcn_ds_read_tr16_b64_v4i16((LAS s16x4v*)(tile + Ra * 256 + ((ch ^ swz<SW>(Ra)) << 4) + bo));
    const s16x4v vb = __builtin_amdgcn_ds_read_tr16_b64_v4i16((LAS s16x4v*)(tile + Rb * 256 + ((ch ^ swz<SW>(Rb)) << 4) + bo));
    return (bf16x8){va[0], va[1], va[2], va[3], vb[0], vb[1], vb[2], vb[3]};
}
__device__ __forceinline__ bf16x8 row_frag(const LAS unsigned char* tile, int R, int ch) { return *(const LAS bf16x8*)(tile + R * 256 + ((ch ^ (R & 15)) << 4)); }

__device__ __forceinline__ void scan_issue(LAS unsigned char* lds, const bf16* KT, const bf16* VH, const float* DEC, int b, int h, int c, int wave, int lane) {
    const int bo = (c % 3) * 32768; const size_t tok = (size_t)b * S + 64 * c;
    tile_dma<1>(lds, bo, KT, tok, h * 128, wave, lane); tile_dma<1>(lds, bo + 16384, VH, tok, h * 128, wave, lane);
    glds4(DEC + ((size_t)(b * 64 + c) * 512 + h * 128 + 16 * wave + (lane & 15)), (unsigned)__builtin_amdgcn_readfirstlane(lds_addr(lds) + 131072 + (c % 3) * 2048 + wave * 256));
}
__device__ __forceinline__ void hgrn_scan(LAS unsigned char* lds, const bf16* KT, const bf16* VH, const float* DEC, bf16* ST, int bh, int wave, int lane) {
    const int b = bh >> 2, h = bh & 3, i16 = lane & 15, g4 = lane >> 4;
    LAS unsigned char* stg = lds + 98304;
    f32x4 acc[8];
#pragma unroll
    for (int vt = 0; vt < 8; ++vt) acc[vt] = (f32x4){0.f, 0.f, 0.f, 0.f};
    scan_issue(lds, KT, VH, DEC, b, h, 0, wave, lane); scan_issue(lds, KT, VH, DEC, b, h, 1, wave, lane);
    for (int c = 0; c < 63; ++c) {
        if (c < 2 || c >= 61) asm volatile("s_waitcnt vmcnt(0) lgkmcnt(0)\n\ts_barrier" ::: "memory");
        else asm volatile("s_waitcnt vmcnt(13) lgkmcnt(0)\n\ts_barrier" ::: "memory");
        if (c + 2 < 63) scan_issue(lds, KT, VH, DEC, b, h, c + 2, wave, lane);
        const LAS unsigned char* Kt = lds + (c % 3) * 32768; const LAS unsigned char* Vt = Kt + 16384;
        const f32x4 dv = *(const LAS f32x4*)(lds + 131072 + (c % 3) * 2048 + wave * 256 + 16 * g4);
#pragma unroll
        for (int ks = 0; ks < 2; ++ks) { const int r0 = 32 * ks + 8 * g4;
            const bf16x8 af = tr_frag<1>(Kt, r0, r0 + 4, 16 * wave, i16);
#pragma unroll
            for (int vt = 0; vt < 8; ++vt) { const bf16x8 bfv = tr_frag<1>(Vt, r0, r0 + 4, 16 * vt, i16);
                acc[vt] = __builtin_amdgcn_mfma_f32_16x16x32_bf16(af, bfv, acc[vt], 0, 0, 0); } }
#pragma unroll
        for (int vt = 0; vt < 8; ++vt) { acc[vt] = acc[vt] * dv;
            u32x2 w; w.x = pk2r(acc[vt][0], acc[vt][1]); w.y = pk2r(acc[vt][2], acc[vt][3]);
            *(LAS u32x2*)(stg + (16 * vt + i16) * 256 + (((4 * wave + g4) ^ (i16 << 1)) << 3)) = w; }
        LBAR();
        { unsigned char* gp = (unsigned char*)(ST + (size_t)(bh * 64 + c) * 16384);
#pragma unroll
          for (int q4 = 0; q4 < 4; ++q4) { const int r = 16 * wave + 4 * q4 + (lane >> 4), ch = lane & 15;
              const v4u x = *(const LAS v4u*)(stg + r * 256 + ((ch ^ (r & 15)) << 4)); *(v4u*)(gp + r * 256 + ch * 16) = x; } }
    }
    asm volatile("s_waitcnt vmcnt(0) lgkmcnt(0)\n\ts_barrier" ::: "memory");
}

__device__ __forceinline__ void hgrn_out_units(LAS unsigned char* lds, const bf16* QT, const bf16* KT, const bf16* VH, const bf16* SG, const bf16* ST, const float* hg_on, bf16* MIXIN, int wave, int lane, int ulo, int uhi) {
    const int i16 = lane & 15, g4 = lane >> 4;
    LAS unsigned char* Pl = lds + 98304; LAS float* ssq = (LAS float*)(lds + 106496);
    bf16x8 san[4];
    { const int bh = ulo >> 6, c = ulo & 63, b = bh >> 2, h = bh & 3; const size_t tok0 = (size_t)b * S + 64 * c;
      tile_dma<0>(lds, 0, QT, tok0, h * 128, wave, lane); tile_dma<0>(lds, 16384, KT, tok0, h * 128, wave, lane); tile_dma<2>(lds, 32768, VH, tok0, h * 128, wave, lane);
      if (c > 0) { const bf16* sp = ST + (((size_t)(bh * 64 + c - 1) * 128 + 16 * wave + i16) * 128 + 8 * g4);
#pragma unroll
          for (int ks = 0; ks < 4; ++ks) san[ks] = *(const bf16x8*)(sp + 32 * ks); }
      else {
#pragma unroll
          for (int ks = 0; ks < 4; ++ks) san[ks] = (bf16x8){0, 0, 0, 0, 0, 0, 0, 0}; } }
    for (int u = ulo; u < uhi; ++u) {
        const int cur = (u - ulo) & 1; const int bh = u >> 6, c = u & 63, b = bh >> 2, h = bh & 3; const size_t tok0 = (size_t)b * S + 64 * c;
        TOPBAR();
        TOUCH(san[0]); TOUCH(san[1]); TOUCH(san[2]); TOUCH(san[3]);
        const bf16x8 sa[4] = {san[0], san[1], san[2], san[3]};
        if (u + 1 < uhi) { const int bh2 = (u + 1) >> 6, c2 = (u + 1) & 63; const size_t t2 = (size_t)(bh2 >> 2) * S + 64 * c2; const int h2 = bh2 & 3, o2 = (cur ^ 1) * 49152;
            tile_dma<0>(lds, o2, QT, t2, h2 * 128, wave, lane); tile_dma<0>(lds, o2 + 16384, KT, t2, h2 * 128, wave, lane); tile_dma<2>(lds, o2 + 32768, VH, t2, h2 * 128, wave, lane);
            if (c2 > 0) { const bf16* sp = ST + (((size_t)(bh2 * 64 + c2 - 1) * 128 + 16 * wave + i16) * 128 + 8 * g4);
#pragma unroll
                for (int ks = 0; ks < 4; ++ks) san[ks] = *(const bf16x8*)(sp + 32 * ks); }
            else {
#pragma unroll
                for (int ks = 0; ks < 4; ++ks) san[ks] = (bf16x8){0, 0, 0, 0, 0, 0, 0, 0}; } }
        const LAS unsigned char* Qt = lds + cur * 49152; const LAS unsigned char* Kt = Qt + 16384; const LAS unsigned char* Vt = Qt + 32768;
#pragma unroll
        for (int q = 0; q < 2; ++q) { const int id = 2 * wave + q, si = id >> 2, ti = id & 3; f32x4 a = {0.f, 0.f, 0.f, 0.f};
            if (si <= ti) {
#pragma unroll
                for (int ks = 0; ks < 4; ++ks) a = __builtin_amdgcn_mfma_f32_16x16x32_bf16(row_frag(Kt, 16 * si + i16, g4 + 4 * ks), row_frag(Qt, 16 * ti + i16, g4 + 4 * ks), a, 0, 0, 0);
                if (si == ti) {
#pragma unroll
                    for (int reg = 0; reg < 4; ++reg) if (4 * g4 + reg > i16) a[reg] = 0.f; } }
            u32x2 w; w.x = pk2r(a[0], a[1]); w.y = pk2r(a[2], a[3]); *(LAS u32x2*)(Pl + id * 512 + lane * 8) = w; }
        LBAR();
        f32x4 o[4];
#pragma unroll
        for (int tt = 0; tt < 4; ++tt) { o[tt] = (f32x4){0.f, 0.f, 0.f, 0.f};
#pragma unroll
            for (int ks = 0; ks < 4; ++ks) o[tt] = __builtin_amdgcn_mfma_f32_16x16x32_bf16(sa[ks], row_frag(Qt, 16 * tt + i16, g4 + 4 * ks), o[tt], 0, 0, 0);
#pragma unroll
            for (int kp = 0; kp < 2; ++kp) { if (2 * kp <= tt) {
                    const u32x2 pa = *(const LAS u32x2*)(Pl + ((2 * kp) * 4 + tt) * 512 + lane * 8), pb = *(const LAS u32x2*)(Pl + ((2 * kp + 1) * 4 + tt) * 512 + lane * 8);
                    const v4u pw = {pa.x, pa.y, pb.x, pb.y};
                    const bf16x8 vf = tr_frag<2>(Vt, 32 * kp + 4 * g4, 32 * kp + 16 + 4 * g4, 16 * wave, i16);
                    o[tt] = __builtin_amdgcn_mfma_f32_16x16x32_bf16(vf, __builtin_bit_cast(bf16x8, pw), o[tt], 0, 0, 0); } } }
        LAS unsigned char* ostg = lds + 108544;
#pragma unroll
        for (int tt = 0; tt < 4; ++tt) { float ss = (o[tt][0] * o[tt][0] + o[tt][1] * o[tt][1]) + (o[tt][2] * o[tt][2] + o[tt][3] * o[tt][3]); ss += __shfl_xor(ss, 16); ss += __shfl_xor(ss, 32);
            if (g4 == 0) ssq[wave * 64 + 16 * tt + i16] = ss;
            u32x2 w; w.x = pk2r(o[tt][0], o[tt][1]); w.y = pk2r(o[tt][2], o[tt][3]);
            *(LAS u32x2*)(ostg + (16 * tt + i16) * 256 + (((4 * wave + g4) ^ (i16 << 1)) << 3)) = w; }
        LBAR();
#pragma unroll
        for (int j = 0; j < 2; ++j) { const int r = 8 * wave + 4 * j + (lane >> 4), ch = lane & 15;
            float tot = 0.f;
#pragma unroll
            for (int w8 = 0; w8 < 8; ++w8) tot += ssq[w8 * 64 + r];
            const float rstd = rsq(tot * (1.f / 128.f) + EPS);
            const v4u ov = *(const LAS v4u*)(ostg + r * 256 + ((ch ^ (r & 15)) << 4));
            const size_t tok = tok0 + r; const int col = h * 128 + 8 * ch;
            const v4u sg = *(const v4u*)(SG + tok * 512 + col);
            const f32x4 g0 = *(const f32x4*)(hg_on + 8 * ch), g1 = *(const f32x4*)(hg_on + 8 * ch + 4);
            v4u w;
            w.x = pk2r(bflo(ov.x) * rstd * g0[0] * bflo(sg.x), bfhi(ov.x) * rstd * g0[1] * bfhi(sg.x)); w.y = pk2r(bflo(ov.y) * rstd * g0[2] * bflo(sg.y), bfhi(ov.y) * rstd * g0[3] * bfhi(sg.y));
            w.z = pk2r(bflo(ov.z) * rstd * g1[0] * bflo(sg.z), bfhi(ov.z) * rstd * g1[1] * bfhi(sg.z)); w.w = pk2r(bflo(ov.w) * rstd * g1[2] * bflo(sg.w), bfhi(ov.w) * rstd * g1[3] * bfhi(sg.w));
            *(v4u*)(MIXIN + tok * D + col) = w; }
    }
    __syncthreads();
}

struct AttU { int b, h, dsh, r, n, br; };
__device__ __forceinline__ AttU att_decode(int g) {
    AttU U; const int bh = g / 96, u = g % 96; U.b = bh >> 3; U.h = bh & 7;
    if (u < 32) { U.dsh = 0; U.r = 0; U.n = u; U.br = 0; }
    else if (u < 64) { U.dsh = 2; U.r = (u - 32) >> 3; U.n = (u - 32) & 7; U.br = 1; }
    else { U.dsh = 4; U.r = (u - 64) >> 1; U.n = (u - 64) & 1; U.br = 2; }
    return U;
}
__device__ __forceinline__ void att_dma(LAS unsigned char* lds, int bufo, const bf16* AK, const bf16* AV, const AttU& U, int wave, int lane) {
    const int gch = (lane & 7) ^ (lane >> 3);
#pragma unroll
    for (int pi = 0; pi < 4; ++pi) { const int piece = wave + 8 * pi, row = piece * 8 + (lane >> 3); int m = 128 * (U.n - 1) + row; if (m < 0) m += 128;
        const size_t eoff = ((size_t)U.b * S + (size_t)((m << U.dsh) + U.r)) * 512 + U.h * 64 + gch * 8;
        glds16(AK + eoff, (unsigned)__builtin_amdgcn_readfirstlane(lds_addr(lds) + bufo + piece * 1024));
        glds16(AV + eoff, (unsigned)__builtin_amdgcn_readfirstlane(lds_addr(lds) + bufo + 32768 + piece * 1024)); }
}
__device__ __forceinline__ void attn_units(LAS unsigned char* lds, const bf16* AQ, const bf16* AK, const bf16* AV, unsigned char* ws, float* LSE, int wave, int lane, int glo, int ghi) {
    const int i16 = lane & 15, g4 = lane >> 4;
    if (glo >= ghi) return;
    AttU U = att_decode(glo);
    att_dma(lds, 0, AK, AV, U, wave, lane);
    bf16x8 qn0, qn1;
    { const bf16* qp = AQ + (((size_t)U.b * S + (size_t)(((128 * U.n + 16 * wave + i16) << U.dsh) + U.r)) * 512 + U.h * 64 + 8 * g4); qn0 = *(const bf16x8*)qp; qn1 = *(const bf16x8*)(qp + 32); }
    for (int gu = glo; gu < ghi; ++gu) {
        const int cur = (gu - glo) & 1; const AttU C = U;
        TOPBAR();
        TOUCH(qn0); TOUCH(qn1); const bf16x8 qf0 = qn0, qf1 = qn1;
        if (gu + 1 < ghi) { U = att_decode(gu + 1); att_dma(lds, (cur ^ 1) * 65536, AK, AV, U, wave, lane);
            const bf16* qp = AQ + (((size_t)U.b * S + (size_t)(((128 * U.n + 16 * wave + i16) << U.dsh) + U.r)) * 512 + U.h * 64 + 8 * g4); qn0 = *(const bf16x8*)qp; qn1 = *(const bf16x8*)(qp + 32); }
        const LAS unsigned char* Kb = lds + cur * 65536; const LAS unsigned char* Vb = Kb + 32768;
        f32x4 st[9];
#pragma unroll
        for (int t = 0; t < 9; ++t) { const int R = 16 * (wave + t) + i16; const LAS unsigned char* kp = Kb + R * 128;
            const bf16x8 a0 = *(const LAS bf16x8*)(kp + ((g4 ^ (R & 7)) << 4)), a1 = *(const LAS bf16x8*)(kp + (((g4 + 4) ^ (R & 7)) << 4));
            f32x4 z = {0.f, 0.f, 0.f, 0.f};
            z = __builtin_amdgcn_mfma_f32_16x16x32_bf16(a0, qf0, z, 0, 0, 0); st[t] = __builtin_amdgcn_mfma_f32_16x16x32_bf16(a1, qf1, z, 0, 0, 0); }
        const int qi = 16 * wave + i16; const float NEG = -INFINITY;
#pragma unroll
        for (int reg = 0; reg < 4; ++reg) { const int kj0 = 16 * wave + 4 * g4 + reg; if (kj0 < qi) st[0][reg] = NEG; if (kj0 + 128 > qi + 128) st[8][reg] = NEG; }
        if (C.n == 0) {
#pragma unroll
            for (int t = 0; t < 8; ++t)
#pragma unroll
                for (int reg = 0; reg < 4; ++reg) { if (16 * (wave + t) + 4 * g4 + reg < 128) st[t][reg] = NEG; } }
        float mx = st[0][0];
#pragma unroll
        for (int t = 0; t < 9; ++t)
#pragma unroll
            for (int reg = 0; reg < 4; ++reg) mx = fmaxf(mx, st[t][reg]);
        mx = fmaxf(mx, __shfl_xor(mx, 16)); mx = fmaxf(mx, __shfl_xor(mx, 32));
        float l = 0.f;
#pragma unroll
        for (int t = 0; t < 9; ++t)
#pragma unroll
            for (int reg = 0; reg < 4; ++reg) { const float pv = ex2(st[t][reg] - mx); st[t][reg] = pv; l += pv; }
        l += __shfl_xor(l, 16); l += __shfl_xor(l, 32);
        f32x4 o[4];
#pragma unroll
        for (int et = 0; et < 4; ++et) o[et] = (f32x4){0.f, 0.f, 0.f, 0.f};
#pragma unroll
        for (int ks = 0; ks < 5; ++ks) {
            const int ta = 2 * ks, tb = (ks < 4) ? 2 * ks + 1 : 2 * ks;
            v4u pw; pw.x = pk2r(st[ta][0], st[ta][1]); pw.y = pk2r(st[ta][2], st[ta][3]);
            if (ks < 4) { pw.z = pk2r(st[tb][0], st[tb][1]); pw.w = pk2r(st[tb][2], st[tb][3]); } else { pw.z = 0u; pw.w = 0u; }
            const bf16x8 pf = __builtin_bit_cast(bf16x8, pw);
            const int Ra = 16 * (wave + ta) + 4 * g4 + (i16 >> 2), Rb = 16 * (wave + tb) + 4 * g4 + (i16 >> 2);
#pragma unroll
            for (int et = 0; et < 4; ++et) { const int ch = 2 * et + ((i16 & 3) >> 1), bo = (i16 & 1) * 8;
                const s16x4v va = __builtin_amdgcn_ds_read_tr16_b64_v4i16((LAS s16x4v*)(Vb + Ra * 128 + ((ch ^ (Ra & 7)) << 4) + bo));
                const s16x4v vb = __builtin_amdgcn_ds_read_tr16_b64_v4i16((LAS s16x4v*)(Vb + Rb * 128 + ((ch ^ (Rb & 7)) << 4) + bo));
                const bf16x8 vf = {va[0], va[1], va[2], va[3], vb[0], vb[1], vb[2], vb[3]};
                o[et] = __builtin_amdgcn_mfma_f32_16x16x32_bf16(vf, pf, o[et], 0, 0, 0); }
        }
        const float il = rcp(l);
        LAS unsigned char* stg = lds + 131072 + wave * 2048;
#pragma unroll
        for (int et = 0; et < 4; ++et) { u32x2 w; w.x = pk2r(o[et][0] * il, o[et][1] * il); w.y = pk2r(o[et][2] * il, o[et][3] * il);
            *(LAS u32x2*)(stg + i16 * 128 + (((4 * et + g4) ^ ((i16 & 7) << 1)) << 3)) = w; }
        asm volatile("s_waitcnt lgkmcnt(0)" ::: "memory");
        bf16* AOb = (bf16*)(ws + (C.br == 0 ? WS_ATT0 : C.br == 1 ? WS_ATT1 : WS_ATT2)) + C.h * 64;
#pragma unroll
        for (int j = 0; j < 2; ++j) { const int r = (lane >> 3) + 8 * j, ch = lane & 7;
            const v4u x = *(const LAS v4u*)(stg + r * 128 + ((ch ^ (r & 7)) << 4));
            const size_t orow_r = (size_t)C.b * S + (size_t)(((128 * C.n + 16 * wave + r) << C.dsh) + C.r);
            *(v4u*)(AOb + orow_r * 512 + ch * 8) = x; }
        const size_t orow = (size_t)C.b * S + (size_t)(((128 * C.n + qi) << C.dsh) + C.r);
        if (g4 == 0) LSE[(size_t)C.br * T * 8 + orow * 8 + C.h] = mx + lg2(l);
    }
    __syncthreads();
}

struct Args { const float* in[14]; float* out; unsigned char* ws; };
__global__ void __launch_bounds__(NWAVES * 64, 2) mk_fwd(Args args) {
    extern __shared__ __attribute__((aligned(16))) unsigned char lds_raw[];
    LAS unsigned char* lds = (LAS unsigned char*)lds_raw;
    volatile LAS unsigned* MISC = (volatile LAS unsigned*)(lds + MISC_OFF);
    const int wave = __builtin_amdgcn_readfirstlane(threadIdx.x >> 6);
    const int G = gridDim.x, bx = blockIdx.x; const int vcu = (G % 8 == 0) ? (bx % 8) * (G / 8) + bx / 8 : bx;
    const int gw = vcu * NWAVES + wave, NGW = G * NWAVES;
    (void)args;
#define INP(i) karg_ptr(i)
#define P_x INP(0)
#define P_c INP(1)
#define P_w_ada INP(2)
#define P_b_ada INP(3)
#define P_g1 INP(4)
#define P_w_in INP(5)
#define P_lbl INP(6)
#define P_hg_on INP(7)
#define P_att_on INP(8)
#define P_w_out INP(9)
#define P_g2 INP(10)
#define P_w_gu INP(11)
#define P_w_down INP(12)
#define P_gf INP(13)
#define P_out ((float*)INP(14))
    unsigned char* const ws = (unsigned char*)INP(15);
    gu32* ctl = (gu32*)(ws + WS_CTL);
#define MODP ((float*)(ws + WS_MODP))
#define MOD ((float*)(ws + WS_MOD))
#define LB ((float*)(ws + WS_LB))
#define BIAS2 ((float*)(ws + WS_BIAS2))
#define WIN_T ((bf16*)(ws + WS_WIN))
#define WOUT_T ((bf16*)(ws + WS_WOUT))
#define WGU_T ((bf16*)(ws + WS_WGU))
#define WD_T ((bf16*)(ws + WS_WD))
#define DEC ((float*)(ws + WS_DEC))
#define LSE ((float*)(ws + WS_LSE))
#define SSQ1 ((float*)(ws + WS_SSQ1))
#define XN ((bf16*)(ws + WS_BUFA))
#define A2 ((bf16*)(ws + WS_BUFA))
#define MIXIN ((bf16*)(ws + WS_BUFB))
#define QT ((bf16*)(ws + WS_QT))
#define KT ((bf16*)(ws + WS_KT))
#define VH ((bf16*)(ws + WS_VH))
#define SG ((bf16*)(ws + WS_SG))
#define AQ ((bf16*)(ws + WS_AQ))
#define AK ((bf16*)(ws + WS_AK))
#define AV ((bf16*)(ws + WS_AV))
#define STB ((bf16*)(ws + WS_ST))
#define HID ((bf16*)(ws + WS_HID))
#ifndef ATT_SCAN_UNITS
#define ATT_SCAN_UNITS 8
#endif
#define PHASE_TID() int lane; asm volatile("v_mbcnt_lo_u32_b32 %0, -1, 0\n\tv_mbcnt_hi_u32_b32 %0, -1, %0" : "=&v"(lane)); const int tid = wave * 64 + lane; (void)tid;

    for (int u = threadIdx.x; u < (LDS_BYTES - LDSCTL_OFF) / 4; u += NWAVES * 64) ((LAS unsigned*)(lds + LDSCTL_OFF))[u] = 0u;
    __syncthreads();
    XcdBarrier bar = xcd_barrier_post((unsigned*)(ctl + CW_BAR), MISC + 8);

    {   PHASE_TID();
        LAS float* scr = (LAS float*)(lds + wave * 16384);
        for (int it = gw; it < 1537; it += NGW) {
            if (it < 1536) { mod_partial(P_c, P_w_ada, MODP, scr, it, lane); continue; }
#pragma unroll
            for (int i = 0; i < 8; ++i) { const int j = lane + 64 * i; LB[j] = rcp(1.f + ex2((P_lbl[512 + j] - P_lbl[j]) * LOG2E)); }
        }
    }
    xcd_barrier(bar);

    {   PHASE_TID();
        LAS float* ms = (LAS float*)lds; LAS float* sh = ms + D;
        if (tid < 192) { const int idx = bx * 192 + tid; const int b = idx / NMOD, n = idx % NMOD; float v = P_b_ada[n];
#pragma unroll
            for (int ks = 0; ks < 16; ++ks) v += MODP[(size_t)(ks * 8 + b) * NMOD + n];
            MOD[idx] = v; }
        const int rows_per = T / G, row0 = bx * rows_per, b = row0 / S;
#pragma unroll
        for (int i = 0; i < 2; ++i) { const int k = tid + 512 * i; float s1 = P_b_ada[k], c1 = P_b_ada[1024 + k];
#pragma unroll
            for (int ks = 0; ks < 16; ++ks) { s1 += MODP[(size_t)(ks * 8 + b) * NMOD + k]; c1 += MODP[(size_t)(ks * 8 + b) * NMOD + 1024 + k]; }
            ms[k] = P_g1[k] * (1.f + c1); sh[k] = s1; }
        __syncthreads();
        for (int r = wave; r < rows_per; r += 2 * NWAVES) {
            const int rowA = row0 + r, rowB = rowA + NWAVES; const GAS f32x4* xa = (const GAS f32x4*)(P_x + (size_t)rowA * D) + lane; const GAS f32x4* xb = (const GAS f32x4*)(P_x + (size_t)rowB * D) + lane;
            f32x4 va[4], vb[4]; float sa_ = 0.f, sb_ = 0.f;
#pragma unroll
            for (int j = 0; j < 4; ++j) { va[j] = xa[64 * j]; vb[j] = xb[64 * j]; }
#pragma unroll
            for (int j = 0; j < 4; ++j) { sa_ += (va[j].x * va[j].x + va[j].y * va[j].y) + (va[j].z * va[j].z + va[j].w * va[j].w); sb_ += (vb[j].x * vb[j].x + vb[j].y * vb[j].y) + (vb[j].z * vb[j].z + vb[j].w * vb[j].w); }
            const float ra = rsq(wsum64(sa_) * (1.f / D) + EPS), rb = rsq(wsum64(sb_) * (1.f / D) + EPS);
            GAS unsigned long long* oa = (GAS unsigned long long*)(XN + (size_t)rowA * D) + lane; GAS unsigned long long* ob = (GAS unsigned long long*)(XN + (size_t)rowB * D) + lane;
#pragma unroll
            for (int j = 0; j < 4; ++j) { const f32x4 m4 = *(const LAS f32x4*)(ms + 256 * j + 4 * lane), s4 = *(const LAS f32x4*)(sh + 256 * j + 4 * lane); const f32x4 o1 = va[j] * ra * m4 + s4, o2 = vb[j] * rb * m4 + s4;
                oa[64 * j] = (unsigned long long)pk2(o1.x, o1.y) | ((unsigned long long)pk2(o1.z, o1.w) << 32); ob[64 * j] = (unsigned long long)pk2(o2.x, o2.y) | ((unsigned long long)pk2(o2.z, o2.w) << 32); }
        }
        __syncthreads();
        { LAS float* scr = (LAS float*)(lds + wave * 16384); constexpr int I_IN = 16 * (INW / 32);
          for (int it = gw; it < I_IN; it += NGW) transpose_item(P_w_in, D, INW, WIN_T, 1, scr, it, lane); }
    }
    xcd_barrier(bar);

    {
        pg8::Gemm g{XN, WIN_T, T, INW, D}; pg8::StaticOrder So; So.init(T, INW, G, bx);
        EpiIn E{QT, KT, VH, SG, AQ, AK, AV, DEC, LB};
        pg8::gemm_phase<EpiIn, pg8::StaticOrder, true, true>(lds, g, So, E, wave);
    }
    xcd_barrier(bar);

    if ((vcu & 7) == 0) {   PHASE_TID();
        hgrn_scan(lds, KT, VH, DEC, STB, vcu >> 3, wave, lane);
    }
    {   PHASE_TID();
        constexpr int AS = ATT_SCAN_UNITS, NREST = 6144 - 32 * AS, BASE = NREST / 224, REM = NREST % 224;
        int alo, ahi;
        const bool scanwg = (vcu & 7) == 0; const int q = vcu - (vcu >> 3) - 1;
        if (scanwg) { alo = (vcu >> 3) * AS; ahi = alo + AS; } else { alo = 32 * AS + q * BASE + (q < REM ? q : REM); ahi = alo + BASE + (q < REM ? 1 : 0); }
        attn_units(lds, AQ, AK, AV, ws, LSE, wave, lane, alo, ahi);
        if (!scanwg) {
            LAS float* scr = (LAS float*)(lds + wave * 16384);
            constexpr int I_OUT = 16 * (D / 32), I_GU = 16 * (NGU / 32), I_DN = (DFF / 64) * (D / 32);
            for (int it = q * NWAVES + wave; it < I_OUT + I_GU + I_DN; it += 224 * NWAVES) { int r = it;
                if (r < I_OUT) { transpose_item(P_w_out, D, D, WOUT_T, 0, scr, r, lane); continue; } r -= I_OUT;
                if (r < I_GU) { transpose_item(P_w_gu, D, NGU, WGU_T, 2, scr, r, lane); continue; } r -= I_GU;
                transpose_item(P_w_down, DFF, D, WD_T, 0, scr, r, lane); } }
    }
    xcd_barrier(bar);

    {   PHASE_TID();
        hgrn_out_units(lds, QT, KT, VH, SG, STB, P_hg_on, MIXIN, wave, lane, vcu * 8, vcu * 8 + 8);
        for (int t = gw; t < T; t += NGW) {
            const int c8 = lane * 8;
            {   const int h = lane >> 3;
                const float l0 = LSE[(size_t)t * 8 + h], l1 = LSE[(size_t)T * 8 + (size_t)t * 8 + h], l2 = LSE[(size_t)2 * T * 8 + (size_t)t * 8 + h];
                const float mx = fmaxf(l0, fmaxf(l1, l2)); float w0 = ex2(l0 - mx), w1 = ex2(l1 - mx), w2 = ex2(l2 - mx); const float inv = rcp(w0 + w1 + w2); w0 *= inv; w1 *= inv; w2 *= inv;
                const v4u a0 = *(const v4u*)((const bf16*)(ws + WS_ATT0) + (size_t)t * 512 + c8), a1 = *(const v4u*)((const bf16*)(ws + WS_ATT1) + (size_t)t * 512 + c8), a2 = *(const v4u*)((const bf16*)(ws + WS_ATT2) + (size_t)t * 512 + c8);
                float a[8];
                a[0] = w0 * bflo(a0.x) + w1 * bflo(a1.x) + w2 * bflo(a2.x); a[1] = w0 * bfhi(a0.x) + w1 * bfhi(a1.x) + w2 * bfhi(a2.x);
                a[2] = w0 * bflo(a0.y) + w1 * bflo(a1.y) + w2 * bflo(a2.y); a[3] = w0 * bfhi(a0.y) + w1 * bfhi(a1.y) + w2 * bfhi(a2.y);
                a[4] = w0 * bflo(a0.z) + w1 * bflo(a1.z) + w2 * bflo(a2.z); a[5] = w0 * bfhi(a0.z) + w1 * bfhi(a1.z) + w2 * bfhi(a2.z);
                a[6] = w0 * bflo(a0.w) + w1 * bflo(a1.w) + w2 * bflo(a2.w); a[7] = w0 * bfhi(a0.w) + w1 * bfhi(a1.w) + w2 * bfhi(a2.w);
                float ss = 0.f;
#pragma unroll
                for (int i = 0; i < 8; ++i) ss += a[i] * a[i];
                const float rstd = rsq(wsum64(ss) * (1.f / 512.f) + EPS);
                const f32x4 n0 = *(const f32x4*)(P_att_on + c8), n1 = *(const f32x4*)(P_att_on + c8 + 4);
#pragma unroll
                for (int i = 0; i < 4; ++i) { a[i] = a[i] * rstd * n0[i]; a[4 + i] = a[4 + i] * rstd * n1[i]; }
                v4u w; w.x = pk2(a[0], a[1]); w.y = pk2(a[2], a[3]); w.z = pk2(a[4], a[5]); w.w = pk2(a[6], a[7]);
                *(v4u*)(MIXIN + (size_t)t * D + 512 + c8) = w; }
        }
        __syncthreads();
        LAS float* sh2 = (LAS float*)lds;
        { float t16[16];
#pragma unroll
          for (int i = 0; i < 16; ++i) { const int e = tid + 512 * i; t16[i] = MOD[(e >> 10) * NMOD + 3072 + (e & 1023)]; }
#pragma unroll
          for (int i = 0; i < 16; ++i) sh2[tid + 512 * i] = t16[i]; }
        __syncthreads();
        const int ncol = NGU / G;
        for (int j = wave; j < ncol; j += NWAVES) { const int n = bx * ncol + j;
            const v4u w0 = *(const v4u*)(WGU_T + (size_t)n * D + lane * 16), w1 = *(const v4u*)(WGU_T + (size_t)n * D + lane * 16 + 8);
            const float wv[16] = {bflo(w0.x), bfhi(w0.x), bflo(w0.y), bfhi(w0.y), bflo(w0.z), bfhi(w0.z), bflo(w0.w), bfhi(w0.w), bflo(w1.x), bfhi(w1.x), bflo(w1.y), bfhi(w1.y), bflo(w1.z), bfhi(w1.z), bflo(w1.w), bfhi(w1.w)};
#pragma unroll
            for (int b = 0; b < 8; ++b) { float s = 0.f;
#pragma unroll
                for (int q4 = 0; q4 < 4; ++q4) { const f32x4 sv = *(const LAS f32x4*)(sh2 + b * D + lane * 16 + q4 * 4); s += wv[q4 * 4] * sv[0] + wv[q4 * 4 + 1] * sv[1] + wv[q4 * 4 + 2] * sv[2] + wv[q4 * 4 + 3] * sv[3]; }
                s = wsum64(s); if (lane == 0) BIAS2[b * NGU + n] = s; }
        }
        __syncthreads();
    }
    xcd_barrier(bar);

    {
        pg8::Gemm g{MIXIN, WOUT_T, T, D, D}; pg8::StaticOrder So; So.init(T, D, G, bx);
        EpiOut E{P_x, P_out, A2, SSQ1, MOD, P_g2};
        pg8::gemm_phase<EpiOut, pg8::StaticOrder, true, true>(lds, g, So, E, wave);
    }
    xcd_barrier(bar);

    {
        pg8::Gemm g{A2, WGU_T, T, NGU, D}; pg8::StaticOrder So; So.init(T, NGU, G, bx);
        EpiGU E{HID, SSQ1, BIAS2};
        pg8::gemm_phase<EpiGU, pg8::StaticOrder, true, true>(lds, g, So, E, wave);
    }
    xcd_barrier(bar);

    {
        pg8::Gemm g{HID, WD_T, T, D, DFF}; pg8::StaticOrder So; So.init(T, D, G, bx);
        EpiDown E{P_out, MOD};
        pg8::gemm_phase<EpiDown, pg8::StaticOrder, true, true>(lds, g, So, E, wave);
    }
    xcd_barrier(bar);

    PHASE_TID();
    for (int row = gw; row < T; row += NGW) {
        GAS f32x4* xr = (GAS f32x4*)(P_out + (size_t)row * D) + lane;
        f32x4 v[4]; float s = 0.f;
#pragma unroll
        for (int j = 0; j < 4; ++j) { v[j] = xr[64 * j]; s += (v[j].x * v[j].x + v[j].y * v[j].y) + (v[j].z * v[j].z + v[j].w * v[j].w); }
        const float rstd = rsq(wsum64(s) * (1.f / D) + EPS);
#pragma unroll
        for (int j = 0; j < 4; ++j) { const f32x4 g4 = *(const f32x4*)(P_gf + 256 * j + 4 * lane); xr[64 * j] = v[j] * rstd * g4; }
    }
}
}

extern "C" void kernel_launch(void* const* d_in, const int* in_sizes, int n_in, void* d_out, int out_size, void* d_ws, size_t ws_size, hipStream_t stream) {
    using namespace mk;
    static int grid = 0;
    if (grid == 0) {
        if (n_in != 14 || in_sizes[0] != T * D || out_size != T * D || ws_size < WS_END) { fprintf(stderr, "kernel_launch: unexpected shapes (n_in %d, in0 %d, out %d, ws %zu); nothing launched\n", n_in, n_in > 0 ? in_sizes[0] : -1, out_size, ws_size); grid = -1; return; }
        int dev = 0, cus = 0, per_cu = 0;
        if (hipGetDevice(&dev) != hipSuccess || hipDeviceGetAttribute(&cus, hipDeviceAttributeMultiprocessorCount, dev) != hipSuccess) { grid = -1; return; }
        if (hipFuncSetAttribute((const void*)mk_fwd, hipFuncAttributeMaxDynamicSharedMemorySize, LDS_BYTES) != hipSuccess) { fprintf(stderr, "kernel_launch: hipFuncSetAttribute failed\n"); grid = -1; return; }
        if (hipOccupancyMaxActiveBlocksPerMultiprocessor(&per_cu, (const void*)mk_fwd, NWAVES * 64, LDS_BYTES) != hipSuccess || per_cu < 1) { fprintf(stderr, "kernel_launch: occupancy query says %d blocks per CU\n", per_cu); per_cu = 1; }
        (void)hipGetLastError();
        grid = cus;
        if (grid != 256) { fprintf(stderr, "kernel_launch: this kernel is laid out for a 256-CU device, found %d CUs; nothing launched\n", grid); grid = -1; return; }
    }
    if (grid < 0) return;
    if (hipMemsetAsync((char*)d_ws + WS_CTL, 0, CTL_ZERO_BYTES, stream) != hipSuccess) { fprintf(stderr, "kernel_launch: hipMemsetAsync failed\n"); return; }
    Args a{};
    for (int i = 0; i < 14; ++i) a.in[i] = (const float*)d_in[i];
    a.out = (float*)d_out; a.ws = (unsigned char*)d_ws;
    hipLaunchKernelGGL(mk_fwd, dim3(grid), dim3(NWAVES * 64), LDS_BYTES, stream, a);
    const hipError_t le = hipPeekAtLastError();
    if (le != hipSuccess) fprintf(stderr, "kernel_launch: launch failed: %s\n", hipGetErrorName(le));
}
```
